# Optimizing an MI355X kernel written in HIP

```python
import math
import jax, jax.numpy as jnp
from jax import lax
import numpy as np


D_MODEL = 1024
BATCH = 8
SEQ = 4096
DEPTH = 1

CHUNK = 64
Q_BLOCK = 128
D_MIX = D_MODEL
GLA_WIDTH = D_MIX // 2
GLA_HEADS = 4
GLA_DV = GLA_WIDTH // GLA_HEADS
GLA_DK = GLA_DV // 2
GLA_LOWRANK = 16
GLA_TAU = 16.0
DIFF_WIDTH = D_MIX - GLA_WIDTH
DIFF_HEADS = 4
DIFF_DV = DIFF_WIDTH // DIFF_HEADS
DIFF_DQK = DIFF_DV // 2
ROPE_DIM = DIFF_DQK // 4
ROPE_THETA = 500000.0
MEM_LEN = 256
CROSS_HEADS = 4
CROSS_DH = D_MODEL // CROSS_HEADS
EPS = 1e-6

GLA_QK = GLA_HEADS * GLA_DK
DIFF_QK = DIFF_HEADS * 2 * DIFF_DQK
IN_SPLITS = (GLA_QK, GLA_QK, GLA_WIDTH, GLA_WIDTH, GLA_LOWRANK,
             DIFF_QK, DIFF_QK, DIFF_WIDTH, DIFF_WIDTH)
D_IN = 2 * GLA_QK + 2 * GLA_WIDTH + GLA_LOWRANK + 2 * DIFF_QK + 2 * DIFF_WIDTH

kernel_name = "hybrid_gla_diffattn_parallel_heads"


def rmsnorm(x, w):
    xf = x.astype(jnp.float32)
    y = xf * lax.rsqrt(jnp.mean(xf * xf, axis=-1, keepdims=True) + EPS)
    return (y * w.astype(jnp.float32)).astype(x.dtype)


def head_rmsnorm(o, w):
    o = o.astype(jnp.float32)
    return o * lax.rsqrt(jnp.mean(o * o, axis=-1, keepdims=True) + EPS) * w.astype(jnp.float32)


def split_cols(proj):
    outs, start = [], 0
    for width in IN_SPLITS:
        outs.append(proj[..., start:start + width])
        start += width
    return outs


def rope_tables(positions):
    pos = positions.astype(jnp.float32)
    inv_freq = ROPE_THETA ** (-(jnp.arange(0, ROPE_DIM, 2, dtype=jnp.float32) / ROPE_DIM))
    ang = pos[..., None] * inv_freq
    cos = jnp.concatenate([jnp.cos(ang), jnp.cos(ang)], axis=-1)
    sin = jnp.concatenate([jnp.sin(ang), jnp.sin(ang)], axis=-1)
    return cos, sin


def partial_rope(t, cos, sin):
    t = t.astype(jnp.float32)
    rot, rest = t[..., :ROPE_DIM], t[..., ROPE_DIM:]
    half = ROPE_DIM // 2
    r1, r2 = rot[..., :half], rot[..., half:]
    c = cos[:, :, None, None, :]
    s = sin[:, :, None, None, :]
    rotated = rot * c + jnp.concatenate([-r2, r1], axis=-1) * s
    return jnp.concatenate([rotated, rest], axis=-1)


def gla_chunked(q, k, v, g):
    B, S = q.shape[0], q.shape[1]
    N = S // CHUNK

    def to_chunks(t):
        return t.astype(jnp.float32).reshape(B, N, CHUNK, GLA_HEADS, -1).transpose(0, 3, 1, 2, 4)

    q, k, v, g = to_chunks(q), to_chunks(k), to_chunks(v), to_chunks(g)
    q = q * (GLA_DK ** -0.5)
    G = jnp.cumsum(g, axis=3)
    q_dec = q * jnp.exp(G)
    k_inv = k * jnp.exp(-G)
    causal = jnp.tril(jnp.ones((CHUNK, CHUNK), dtype=bool))
    scores = jnp.einsum('bhncd,bhnsd->bhncs', q_dec, k_inv)
    scores = jnp.where(causal, scores, 0.0)
    o_intra = jnp.einsum('bhncs,bhnse->bhnce', scores, v)

    G_last = G[:, :, :, -1:, :]
    kv_chunk = jnp.einsum('bhncd,bhnce->bhnde', k * jnp.exp(G_last - G), v)
    decay = jnp.exp(G_last[:, :, :, 0, :])

    def step(state, inp):
        dec, kv = inp
        return dec[..., None] * state + kv, state

    init = jnp.zeros((B, GLA_HEADS, GLA_DK, GLA_DV), jnp.float32)
    _, states = lax.scan(step, init, (decay.transpose(2, 0, 1, 3), kv_chunk.transpose(2, 0, 1, 3, 4)))
    states = states.transpose(1, 2, 0, 3, 4)
    o_inter = jnp.einsum('bhncd,bhnde->bhnce', q_dec, states)
    o = o_intra + o_inter
    return o.transpose(0, 2, 3, 1, 4).reshape(B, S, GLA_HEADS, GLA_DV)


def diff_attention(q, k, v, lam):
    B, S = q.shape[0], q.shape[1]
    NB = S // Q_BLOCK
    qh = q.astype(jnp.float32).transpose(0, 2, 3, 1, 4)
    kh = k.astype(jnp.float32).transpose(0, 2, 3, 1, 4)
    vh = v.astype(jnp.float32).transpose(0, 2, 1, 3)
    key_chunk = jnp.arange(S) // CHUNK
    q_blocks = qh.reshape(B, DIFF_HEADS, 2, NB, Q_BLOCK, DIFF_DQK).transpose(3, 0, 1, 2, 4, 5)
    scale = DIFF_DQK ** -0.5

    def one_block(args):
        qb, bi = args
        qpos = bi * Q_BLOCK + jnp.arange(Q_BLOCK)
        allowed = key_chunk[None, :] <= (qpos // CHUNK)[:, None]
        s = jnp.einsum('bhmqd,bhmkd->bhmqk', qb, kh) * scale
        s = jnp.where(allowed, s, -jnp.inf)
        p = jax.nn.softmax(s, axis=-1)
        a = p[:, :, 0] - lam * p[:, :, 1]
        return jnp.einsum('bhqk,bhke->bhqe', a, vh)

    o = lax.map(one_block, (q_blocks, jnp.arange(NB)))
    return o.transpose(1, 0, 3, 2, 4).reshape(B, S, DIFF_HEADS, DIFF_DV)


def cross_attention(h, mem_n, w_q, w_kv, w_o):
    B, S, _ = h.shape
    M = mem_n.shape[1]
    q = (h @ w_q).reshape(B, S, CROSS_HEADS, CROSS_DH)
    kv = mem_n @ w_kv
    k = kv[..., :D_MODEL].reshape(B, M, CROSS_HEADS, CROSS_DH)
    v = kv[..., D_MODEL:].reshape(B, M, CROSS_HEADS, CROSS_DH)
    s = jnp.einsum('bqhd,bkhd->bhqk', q, k).astype(jnp.float32) * (CROSS_DH ** -0.5)
    p = jax.nn.softmax(s, axis=-1).astype(v.dtype)
    o = jnp.einsum('bhqk,bkhd->bqhd', p, v).reshape(B, S, D_MODEL)
    return o @ w_o


def setup_inputs(seed: int = 0) -> dict:
    key = jax.random.key(seed)
    ks = jax.random.split(key, 24)
    f32 = jnp.float32
    nrm = lambda k, shape, scale: jax.random.normal(k, shape, f32) * scale
    x = jax.random.normal(ks[0], (BATCH, SEQ, D_MODEL), f32)
    mem = jax.random.normal(ks[1], (BATCH, MEM_LEN, D_MODEL), f32)
    start = jax.random.randint(ks[2], (BATCH, 1), 0, 1024, dtype=jnp.int32)
    positions = (start + jnp.arange(SEQ, dtype=jnp.int32)[None, :]).astype(jnp.int32)
    return {
        "x": x,
        "mem": mem,
        "positions": positions,
        "norm_mix_w": 1.0 + nrm(ks[3], (DEPTH, D_MODEL), 0.02),
        "w_in": nrm(ks[4], (DEPTH, D_MODEL, D_IN), D_MODEL ** -0.5),
        "w_alpha2": nrm(ks[5], (DEPTH, GLA_LOWRANK, GLA_QK), GLA_LOWRANK ** -0.5),
        "b_alpha2": nrm(ks[6], (DEPTH, GLA_QK), 0.1),
        "gla_norm_w": 1.0 + nrm(ks[7], (DEPTH, GLA_DV), 0.02),
        "lam_q1": nrm(ks[8], (DEPTH, DIFF_DQK), 0.1),
        "lam_k1": nrm(ks[9], (DEPTH, DIFF_DQK), 0.1),
        "lam_q2": nrm(ks[10], (DEPTH, DIFF_DQK), 0.1),
        "lam_k2": nrm(ks[11], (DEPTH, DIFF_DQK), 0.1),
        "diff_norm_w": 1.0 + nrm(ks[12], (DEPTH, DIFF_DV), 0.02),
        "w_out": nrm(ks[13], (DEPTH, D_MIX, D_MODEL), D_MIX ** -0.5),
        "norm_cross_w": 1.0 + nrm(ks[14], (DEPTH, D_MODEL), 0.02),
        "norm_mem_w": 1.0 + nrm(ks[15], (DEPTH, D_MODEL), 0.02),
        "w_cq": nrm(ks[16], (DEPTH, D_MODEL, D_MODEL), D_MODEL ** -0.5),
        "w_ckv": nrm(ks[17], (DEPTH, D_MODEL, 2 * D_MODEL), D_MODEL ** -0.5),
        "w_co": nrm(ks[18], (DEPTH, D_MODEL, D_MODEL), D_MODEL ** -0.5),
        "final_norm_w": 1.0 + nrm(ks[19], (D_MODEL,), 0.02),
    }


def reference(x, mem, positions, norm_mix_w, w_in, w_alpha2, b_alpha2, gla_norm_w,
              lam_q1, lam_k1, lam_q2, lam_k2, diff_norm_w, w_out,
              norm_cross_w, norm_mem_w, w_cq, w_ckv, w_co, final_norm_w):
    B, S, _ = x.shape
    f32 = jnp.float32
    cos, sin = rope_tables(positions)
    for l in range(DEPTH):
        h = rmsnorm(x, norm_mix_w[l])
        proj = h @ w_in[l]
        gq, gk, gv, ggate, ga, dq, dk, dv, dgate = split_cols(proj)

        g_logit = (ga @ w_alpha2[l] + b_alpha2[l]).astype(f32)
        g = jax.nn.log_sigmoid(g_logit) / GLA_TAU
        o_gla = gla_chunked(gq.reshape(B, S, GLA_HEADS, GLA_DK),
                            gk.reshape(B, S, GLA_HEADS, GLA_DK),
                            gv.reshape(B, S, GLA_HEADS, GLA_DV),
                            g.reshape(B, S, GLA_HEADS, GLA_DK))
        o_gla = head_rmsnorm(o_gla, gla_norm_w[l]) * jax.nn.silu(
            ggate.astype(f32).reshape(B, S, GLA_HEADS, GLA_DV))

        lam_init = 0.8 - 0.6 * math.exp(-0.3 * l)
        lam = (jnp.exp(jnp.sum(lam_q1[l].astype(f32) * lam_k1[l].astype(f32)))
               - jnp.exp(jnp.sum(lam_q2[l].astype(f32) * lam_k2[l].astype(f32))) + lam_init)
        q = partial_rope(dq.reshape(B, S, DIFF_HEADS, 2, DIFF_DQK), cos, sin)
        k = partial_rope(dk.reshape(B, S, DIFF_HEADS, 2, DIFF_DQK), cos, sin)
        o_diff = diff_attention(q, k, dv.reshape(B, S, DIFF_HEADS, DIFF_DV), lam)
        o_diff = head_rmsnorm(o_diff, diff_norm_w[l]) * (1.0 - lam_init) * jax.nn.silu(
            dgate.astype(f32).reshape(B, S, DIFF_HEADS, DIFF_DV))

        mixed = jnp.concatenate([o_gla.reshape(B, S, GLA_WIDTH),
                                 o_diff.reshape(B, S, DIFF_WIDTH)], axis=-1).astype(x.dtype)
        x = x + mixed @ w_out[l]

        hc = rmsnorm(x, norm_cross_w[l])
        mem_n = rmsnorm(mem, norm_mem_w[l])
        x = x + cross_attention(hc, mem_n, w_cq[l], w_ckv[l], w_co[l])
    return rmsnorm(x, final_norm_w)
```

```cpp
#include <hip/hip_runtime.h>
#include <cstdio>
#include <cstdint>

typedef unsigned short bf16_t;
typedef short bf16x8 __attribute__((ext_vector_type(8)));
typedef float f32x4 __attribute__((ext_vector_type(4)));

constexpr int BATCH = 8, SEQ = 4096, D = 1024, T = BATCH * SEQ;
constexpr int MEM_LEN = 256, TM = BATCH * MEM_LEN;
constexpr int D_IN = 3600, NP = 3840, PP = 3584;
constexpr float EPS = 1e-6f;
constexpr int C_GQ = 0, C_GK = 256, C_GV = 512, C_GG = 1024, C_DQ = 1536, C_DK = 2048, C_DV = 2560, C_DG = 3072, C_GA = 3584;

constexpr size_t MiB = 1u << 20;
constexpr size_t WS_CTL = 0;
constexpr size_t WS_WIN = 1 * MiB;
constexpr size_t WS_WOUT = 9 * MiB;
constexpr size_t WS_WCQ = 11 * MiB;
constexpr size_t WS_WCO = 13 * MiB;
constexpr size_t WS_WCKV = 15 * MiB;
constexpr size_t WS_MEMN = 20 * MiB;
constexpr size_t WS_KVM = 24 * MiB;
constexpr size_t WS_GA = 32 * MiB;
constexpr size_t WS_ROPE = 34 * MiB;
constexpr size_t WS_MISC = 36 * MiB;
constexpr size_t WS_XN = 40 * MiB;
constexpr size_t WS_MIXED = WS_XN;
constexpr size_t WS_PROJ = 104 * MiB;
constexpr size_t WS_X1B = WS_PROJ, WS_QC = WS_PROJ + 64 * MiB, WS_OC = WS_PROJ + 128 * MiB;
constexpr size_t WS_OD = 328 * MiB;
constexpr size_t WS_KVC = 392 * MiB;
constexpr size_t WS_ST = 456 * MiB;
constexpr size_t WS_END = 488 * MiB;

__device__ __forceinline__ bf16_t f2bf(float f) { unsigned u = __float_as_uint(f); return (bf16_t)((u + 0x7fffu + ((u >> 16) & 1u)) >> 16); }
__device__ __forceinline__ float bf2f(bf16_t h) { return __uint_as_float(((unsigned)h) << 16); }
__device__ __forceinline__ float wave_sum(float v) {
#pragma unroll
    for (int o = 1; o < 64; o <<= 1) v += __shfl_xor(v, o);
    return v;
}
__device__ __forceinline__ float silu(float x) { return x / (1.f + __expf(-x)); }

__device__ __forceinline__ int win_src_col(int n) { return n < 1536 ? n : (n < 3584 ? n + 16 : (n < 3600 ? n - 3584 + 1536 : -1)); }
__global__ void k_prep_w(const float* __restrict__ W, int K, int Nsrc, bf16_t* __restrict__ Wt, int Nout, const float* __restrict__ kscale, int mode) {
    const size_t i = (size_t)blockIdx.x * blockDim.x + threadIdx.x;
    if (i >= (size_t)Nout * K) return;
    const int n = (int)(i / K), k = (int)(i % K);
    const int c = mode == 1 ? win_src_col(n) : n;
    float v = 0.f;
    if (c >= 0) { v = W[(size_t)k * Nsrc + c]; if (kscale) v *= kscale[k]; }
    Wt[i] = f2bf(v);
}
__global__ void k_rmsnorm_rows(const float* __restrict__ x, const float* __restrict__ w, bf16_t* __restrict__ out, int rows) {
    const int row = blockIdx.x * (blockDim.x / 64) + (threadIdx.x >> 6), lane = threadIdx.x & 63;
    if (row >= rows) return;
    const f32x4* xr = (const f32x4*)(x + (size_t)row * D);
    f32x4 v[4]; float s = 0.f;
#pragma unroll
    for (int j = 0; j < 4; ++j) { v[j] = xr[lane + 64 * j]; s += v[j].x * v[j].x + v[j].y * v[j].y + v[j].z * v[j].z + v[j].w * v[j].w; }
    const float r = rsqrtf(wave_sum(s) * (1.f / D) + EPS);
#pragma unroll
    for (int j = 0; j < 4; ++j) {
        const f32x4 ww = ((const f32x4*)w)[lane + 64 * j];
        bf16_t* o = out + (size_t)row * D + 4 * (lane + 64 * j);
        o[0] = f2bf(v[j].x * r * ww.x); o[1] = f2bf(v[j].y * r * ww.y); o[2] = f2bf(v[j].z * r * ww.z); o[3] = f2bf(v[j].w * r * ww.w);
    }
}
__device__ __forceinline__ void sincos_d(double a, float& c, float& s) {
    const double q = rint(a * 0.63661977236758134308);
    double r = fma(-q, 1.5707963267948966, a); r = fma(-q, 6.123233995736766e-17, r);
    const double r2 = r * r;
    double sp = r * (1.0 + r2 * (-1.0 / 6 + r2 * (1.0 / 120 + r2 * (-1.0 / 5040 + r2 * (1.0 / 362880 + r2 * (-1.0 / 39916800 + r2 * (1.0 / 6227020800.0)))))));
    double cp = 1.0 + r2 * (-0.5 + r2 * (1.0 / 24 + r2 * (-1.0 / 720 + r2 * (1.0 / 40320 + r2 * (-1.0 / 3628800 + r2 * (1.0 / 479001600.0 + r2 * (-1.0 / 87178291200.0)))))));
    const int qi = ((int)(long long)q) & 3;
    double cc = (qi == 0) ? cp : (qi == 1) ? -sp : (qi == 2) ? -cp : sp;
    double ss = (qi == 0) ? sp : (qi == 1) ? cp : (qi == 2) ? -sp : -cp;
    c = (float)cc; s = (float)ss;
}
__global__ void k_rope_tab(const int* __restrict__ pos, float* __restrict__ cs, float* __restrict__ sn, float* __restrict__ lam,
                           const float* q1, const float* k1, const float* q2, const float* k2, float* rss) {
    const int i = blockIdx.x * blockDim.x + threadIdx.x;
    if (i < T * 8) {
        const int t = i >> 3, j = i & 7;
        const double invf[8] = {1.0, 0.19392274474868576, 0.03760603093086393, 0.007292664737217109, 0.001414213562373095, 0.0002742481756762073, 5.318295896944988e-05, 1.031338537721246e-05};
        double f = invf[0];
#pragma unroll
        for (int u = 1; u < 8; ++u) f = (j == u) ? invf[u] : f;
        float c, s; sincos_d((double)pos[t] * f, c, s);
        cs[i] = c; sn[i] = s;
    }
    if (i < 2 * T) rss[i] = 0.f;
    if (i == 0) {
        float a = 0.f, b = 0.f;
        for (int u = 0; u < 64; ++u) { a += q1[u] * k1[u]; b += q2[u] * k2[u]; }
        lam[0] = expf(a) - expf(b) + 0.2f;
    }
}

template <class Epi>
__global__ void __launch_bounds__(256) k_gemm(const bf16_t* __restrict__ A, const bf16_t* __restrict__ Bt, int M, int N, int K, Epi epi) {
    const int lane = threadIdx.x & 63, wid = threadIdx.x >> 6, wr = wid >> 1, wc = wid & 1;
    const int m0 = blockIdx.y * 64 + wr * 32, n0 = blockIdx.x * 64 + wc * 32;
    const int fr = lane & 15, fq = lane >> 4;
    f32x4 acc[2][2];
#pragma unroll
    for (int i = 0; i < 2; ++i)
#pragma unroll
        for (int j = 0; j < 2; ++j) acc[i][j] = (f32x4){0.f, 0.f, 0.f, 0.f};
    const bf16_t* ap = A + (size_t)(m0 + fr) * K + 8 * fq;
    const bf16_t* bp = Bt + (size_t)(n0 + fr) * K + 8 * fq;
    for (int k0 = 0; k0 < K; k0 += 32) {
        bf16x8 a[2], b[2];
#pragma unroll
        for (int i = 0; i < 2; ++i) { a[i] = *(const bf16x8*)(ap + (size_t)i * 16 * K + k0); b[i] = *(const bf16x8*)(bp + (size_t)i * 16 * K + k0); }
#pragma unroll
        for (int i = 0; i < 2; ++i)
#pragma unroll
            for (int j = 0; j < 2; ++j) acc[i][j] = __builtin_amdgcn_mfma_f32_16x16x32_bf16(a[i], b[j], acc[i][j], 0, 0, 0);
    }
#pragma unroll
    for (int i = 0; i < 2; ++i)
#pragma unroll
        for (int j = 0; j < 2; ++j)
#pragma unroll
            for (int r = 0; r < 4; ++r) epi(m0 + i * 16 + fq * 4 + r, n0 + j * 16 + fr, acc[i][j][r]);
}
struct EpiInProj { bf16_t* proj; float* ga;
    __device__ __forceinline__ void operator()(int m, int n, float v) const { if (n < PP) proj[(size_t)m * PP + n] = f2bf(v); else if (n < PP + 16) ga[m * 16 + n - PP] = v; } };
struct EpiBf16Plain { bf16_t* o; int ld;
    __device__ __forceinline__ void operator()(int m, int n, float v) const { o[(size_t)m * ld + n] = f2bf(v); } };
struct EpiOutProj { const float* x; float* x1; bf16_t* x1b; float* rss;
    __device__ __forceinline__ void operator()(int m, int n, float v) const { const size_t i = (size_t)m * D + n; const float y = x[i] + v; x1[i] = y; x1b[i] = f2bf(y); atomicAdd(rss + m, y * y); } };
struct EpiCq { bf16_t* qc; const float* rss;
    __device__ __forceinline__ void operator()(int m, int n, float v) const { qc[(size_t)m * D + n] = f2bf(v * rsqrtf(rss[m] * (1.f / D) + EPS) * (0.0625f * 1.4426950408889634f)); } };
struct EpiCo { float* x12; float* rss2;
    __device__ __forceinline__ void operator()(int m, int n, float v) const { const size_t i = (size_t)m * D + n; const float y = x12[i] + v; x12[i] = y; atomicAdd(rss2 + m, y * y); } };

__global__ void k_rope(bf16_t* __restrict__ proj, const float* __restrict__ cs, const float* __restrict__ sn) {
    const int i = blockIdx.x * blockDim.x + threadIdx.x;
    if (i >= T * 128) return;
    const int j = i & 7, hm = (i >> 3) & 7, wh = (i >> 6) & 1, t = i >> 7;
    bf16_t* b = proj + (size_t)t * PP + (wh ? C_DK : C_DQ) + hm * 64;
    const float r1 = bf2f(b[j]), r2 = bf2f(b[j + 8]), c = cs[t * 8 + j], s = sn[t * 8 + j];
    b[j] = f2bf(r1 * c - r2 * s); b[j + 8] = f2bf(r2 * c + r1 * s);
}

__global__ void k_gla_gate(const float* __restrict__ ga, const float* __restrict__ w2, const float* __restrict__ b2, float* __restrict__ G) {
    const int i = blockIdx.x * blockDim.x + threadIdx.x;
    if (i >= T * 256) return;
    const int c = i & 255, t = i >> 8;
    float z = b2[c];
#pragma unroll
    for (int r = 0; r < 16; ++r) z += ga[t * 16 + r] * w2[r * 256 + c];
    const float ls = fminf(z, 0.f) - log1pf(expf(-fabsf(z)));
    G[i] = ls * (1.f / 16.f);
}
__global__ void __launch_bounds__(128) k_gla_rec(const bf16_t* __restrict__ proj, const float* __restrict__ G, float* __restrict__ GO) {
    const int e = threadIdx.x, h = blockIdx.x & 3, b = blockIdx.x >> 2;
    float S[64];
#pragma unroll
    for (int c = 0; c < 64; ++c) S[c] = 0.f;
    for (int s = 0; s < SEQ; ++s) {
        const size_t t = (size_t)b * SEQ + s;
        const bf16x8* q8 = (const bf16x8*)(proj + t * PP + C_GQ + h * 64);
        const bf16x8* k8 = (const bf16x8*)(proj + t * PP + C_GK + h * 64);
        const float v = bf2f(proj[t * PP + C_GV + h * 128 + e]);
        const f32x4* g4 = (const f32x4*)(G + t * 256 + h * 64);
        float o = 0.f;
#pragma unroll
        for (int c8 = 0; c8 < 8; ++c8) {
            const bf16x8 qq = q8[c8], kk = k8[c8]; const f32x4 ga = g4[2 * c8], gb = g4[2 * c8 + 1];
#pragma unroll
            for (int j = 0; j < 8; ++j) { const int c = c8 * 8 + j; const float g = j < 4 ? ga[j] : gb[j - 4];
                S[c] = __expf(g) * S[c] + bf2f((bf16_t)kk[j]) * v; o += bf2f((bf16_t)qq[j]) * S[c]; }
        }
        GO[t * 512 + h * 128 + e] = o * 0.125f;
    }
}
__global__ void k_gla_out(const float* __restrict__ GO, const bf16_t* __restrict__ proj, const float* __restrict__ w, bf16_t* __restrict__ mixed) {
    const int gw = blockIdx.x * (blockDim.x / 64) + (threadIdx.x >> 6), lane = threadIdx.x & 63;
    if (gw >= T * 4) return;
    const int h = gw & 3; const size_t t = gw >> 2;
    const float o0 = GO[t * 512 + h * 128 + lane], o1 = GO[t * 512 + h * 128 + 64 + lane];
    const float r = rsqrtf(wave_sum(o0 * o0 + o1 * o1) * (1.f / 128) + EPS);
    const float g0 = bf2f(proj[t * PP + C_GG + h * 128 + lane]), g1 = bf2f(proj[t * PP + C_GG + h * 128 + 64 + lane]);
    mixed[t * D + h * 128 + lane] = f2bf(o0 * r * w[lane] * silu(g0));
    mixed[t * D + h * 128 + 64 + lane] = f2bf(o1 * r * w[64 + lane] * silu(g1));
}

__global__ void __launch_bounds__(256) k_diff_attn(const bf16_t* __restrict__ proj, bf16_t* __restrict__ od) {
    const int tid = threadIdx.x, qtr = tid & 3, rl = tid >> 2;
    const int hm = blockIdx.x & 7, chunk = (blockIdx.x >> 3) & 63, b = blockIdx.x >> 9;
    const int h = hm >> 1;
    const size_t t = (size_t)b * SEQ + chunk * 64 + rl;
    float q[64];
    { const bf16x8* qp = (const bf16x8*)(proj + t * PP + C_DQ + hm * 64);
#pragma unroll
      for (int c = 0; c < 8; ++c) { const bf16x8 qq = qp[c];
#pragma unroll
          for (int j = 0; j < 8; ++j) q[c * 8 + j] = bf2f((bf16_t)qq[j]) * 0.125f; } }
    float o[32];
#pragma unroll
    for (int i = 0; i < 32; ++i) o[i] = 0.f;
    float m = -INFINITY, l = 0.f;
    const int nk = (chunk + 1) * 64;
    for (int j = 0; j < nk; ++j) {
        const size_t tk = (size_t)b * SEQ + j;
        const bf16x8* kp = (const bf16x8*)(proj + tk * PP + C_DK + hm * 64);
        float s = 0.f;
#pragma unroll
        for (int c = 0; c < 8; ++c) { const bf16x8 kk = kp[c];
#pragma unroll
            for (int j = 0; j < 8; ++j) s += q[c * 8 + j] * bf2f((bf16_t)kk[j]); }
        const float mn = fmaxf(m, s), al = __expf(m - mn), p = __expf(s - mn);
        l = l * al + p; m = mn;
        const bf16x8* vp = (const bf16x8*)(proj + tk * PP + C_DV + h * 128 + qtr * 32);
#pragma unroll
        for (int c = 0; c < 4; ++c) { const bf16x8 vv = vp[c];
#pragma unroll
            for (int j = 0; j < 8; ++j) o[c * 8 + j] = o[c * 8 + j] * al + p * bf2f((bf16_t)vv[j]); }
    }
    const float rl_ = 1.f / l;
#pragma unroll
    for (int i = 0; i < 32; ++i) od[t * D + hm * 128 + qtr * 32 + i] = f2bf(o[i] * rl_);
}
__global__ void k_diff_out(const bf16_t* __restrict__ od, const bf16_t* __restrict__ proj, const float* __restrict__ w, const float* __restrict__ lam, bf16_t* __restrict__ mixed) {
    const int gw = blockIdx.x * (blockDim.x / 64) + (threadIdx.x >> 6), lane = threadIdx.x & 63;
    if (gw >= T * 4) return;
    const int h = gw & 3; const size_t t = gw >> 2;
    const float lm = lam[0];
    const bf16_t* o1 = od + t * D + (2 * h) * 128; const bf16_t* o2 = o1 + 128;
    const float d0 = bf2f(o1[lane]) - lm * bf2f(o2[lane]), d1 = bf2f(o1[64 + lane]) - lm * bf2f(o2[64 + lane]);
    const float r = rsqrtf(wave_sum(d0 * d0 + d1 * d1) * (1.f / 128) + EPS);
    const float g0 = bf2f(proj[t * PP + C_DG + h * 128 + lane]), g1 = bf2f(proj[t * PP + C_DG + h * 128 + 64 + lane]);
    mixed[t * D + 512 + h * 128 + lane] = f2bf(d0 * r * w[lane] * 0.8f * silu(g0));
    mixed[t * D + 512 + h * 128 + 64 + lane] = f2bf(d1 * r * w[64 + lane] * 0.8f * silu(g1));
}

__global__ void __launch_bounds__(256) k_cross_attn(const bf16_t* __restrict__ qc, const bf16_t* __restrict__ kvm, bf16_t* __restrict__ oc) {
    __shared__ float sp[16][257];
    __shared__ float sl[16];
    const int tid = threadIdx.x, head = blockIdx.x & 3, tile = blockIdx.x >> 2;
    const size_t t0 = (size_t)tile * 16; const int b = (int)(t0 / SEQ);
    const bf16_t* kp = kvm + (size_t)(b * MEM_LEN + tid) * 2048 + head * 256;
    float acc[16];
#pragma unroll
    for (int r = 0; r < 16; ++r) acc[r] = 0.f;
    for (int d = 0; d < 256; ++d) {
        const float kv = bf2f(kp[d]);
#pragma unroll
        for (int r = 0; r < 16; ++r) acc[r] += kv * bf2f(qc[(t0 + r) * D + head * 256 + d]);
    }
#pragma unroll
    for (int r = 0; r < 16; ++r) sp[r][tid] = acc[r];
    __syncthreads();
    { const int w = tid >> 6, lane = tid & 63;
      for (int r = w * 4; r < w * 4 + 4; ++r) {
          float mx = -INFINITY;
          for (int j = lane; j < 256; j += 64) mx = fmaxf(mx, sp[r][j]);
#pragma unroll
          for (int o = 1; o < 64; o <<= 1) mx = fmaxf(mx, __shfl_xor(mx, o));
          float sum = 0.f;
          for (int j = lane; j < 256; j += 64) { const float p = exp2f(sp[r][j] - mx); sp[r][j] = p; sum += p; }
          sum = wave_sum(sum);
          if (lane == 0) sl[r] = sum;
      } }
    __syncthreads();
#pragma unroll
    for (int r = 0; r < 16; ++r) acc[r] = 0.f;
    const bf16_t* vp = kvm + (size_t)(b * MEM_LEN) * 2048 + 1024 + head * 256 + tid;
    for (int j = 0; j < 256; ++j) {
        const float v = bf2f(vp[(size_t)j * 2048]);
#pragma unroll
        for (int r = 0; r < 16; ++r) acc[r] += sp[r][j] * v;
    }
#pragma unroll
    for (int r = 0; r < 16; ++r) oc[(t0 + r) * D + head * 256 + tid] = f2bf(acc[r] / sl[r]);
}
__global__ void k_final_norm(float* __restrict__ x2, const float* __restrict__ rss2, const float* __restrict__ w) {
    const int row = blockIdx.x * (blockDim.x / 64) + (threadIdx.x >> 6), lane = threadIdx.x & 63;
    if (row >= T) return;
    const float r = rsqrtf(rss2[row] * (1.f / D) + EPS);
    f32x4* xr = (f32x4*)(x2 + (size_t)row * D);
#pragma unroll
    for (int j = 0; j < 4; ++j) { f32x4 v = xr[lane + 64 * j]; const f32x4 ww = ((const f32x4*)w)[lane + 64 * j]; v.x *= r * ww.x; v.y *= r * ww.y; v.z *= r * ww.z; v.w *= r * ww.w; xr[lane + 64 * j] = v; }
}

extern "C" void kernel_launch(void* const* d_in, const int* in_sizes, int n_in, void* d_out, int out_size, void* d_ws, size_t ws_size, hipStream_t stream) {
    if (n_in != 20 || in_sizes[0] != T * D || out_size != T * D || ws_size < WS_END) { fprintf(stderr, "kernel_launch: unexpected shapes / workspace (%d inputs, ws %zu)\n", n_in, ws_size); return; }
    const float* x = (const float*)d_in[0]; const float* mem = (const float*)d_in[1]; const int* pos = (const int*)d_in[2];
    const float* norm_mix_w = (const float*)d_in[3]; const float* w_in = (const float*)d_in[4]; const float* w_alpha2 = (const float*)d_in[5];
    const float* b_alpha2 = (const float*)d_in[6]; const float* gla_norm_w = (const float*)d_in[7];
    const float* lq1 = (const float*)d_in[8]; const float* lk1 = (const float*)d_in[9]; const float* lq2 = (const float*)d_in[10]; const float* lk2 = (const float*)d_in[11];
    const float* diff_norm_w = (const float*)d_in[12]; const float* w_out = (const float*)d_in[13]; const float* norm_cross_w = (const float*)d_in[14];
    const float* norm_mem_w = (const float*)d_in[15]; const float* w_cq = (const float*)d_in[16]; const float* w_ckv = (const float*)d_in[17];
    const float* w_co = (const float*)d_in[18]; const float* final_norm_w = (const float*)d_in[19];
    float* out = (float*)d_out; unsigned char* ws = (unsigned char*)d_ws;
    bf16_t* WIN = (bf16_t*)(ws + WS_WIN); bf16_t* WOUT = (bf16_t*)(ws + WS_WOUT); bf16_t* WCQ = (bf16_t*)(ws + WS_WCQ); bf16_t* WCO = (bf16_t*)(ws + WS_WCO); bf16_t* WCKV = (bf16_t*)(ws + WS_WCKV);
    bf16_t* MEMN = (bf16_t*)(ws + WS_MEMN); bf16_t* KVM = (bf16_t*)(ws + WS_KVM); float* GA = (float*)(ws + WS_GA);
    float* CS = (float*)(ws + WS_ROPE); float* SN = CS + T * 8; float* RSS = (float*)(ws + WS_MISC); float* RSS2 = RSS + T; float* LAM = RSS + 2 * T;
    bf16_t* XN = (bf16_t*)(ws + WS_XN); bf16_t* MIXED = (bf16_t*)(ws + WS_MIXED); bf16_t* PROJ = (bf16_t*)(ws + WS_PROJ);
    bf16_t* X1B = (bf16_t*)(ws + WS_X1B); bf16_t* QC = (bf16_t*)(ws + WS_QC); bf16_t* OC = (bf16_t*)(ws + WS_OC); bf16_t* OD = (bf16_t*)(ws + WS_OD);
    float* GO = (float*)(ws + WS_KVC); float* G = (float*)(ws + WS_ST);

    auto nb = [](size_t n, int b) { return (unsigned)((n + b - 1) / b); };
    k_prep_w<<<nb((size_t)NP * D, 256), 256, 0, stream>>>(w_in, D, D_IN, WIN, NP, nullptr, 1);
    k_prep_w<<<nb((size_t)D * D, 256), 256, 0, stream>>>(w_out, D, D, WOUT, D, nullptr, 0);
    k_prep_w<<<nb((size_t)D * D, 256), 256, 0, stream>>>(w_cq, D, D, WCQ, D, norm_cross_w, 0);
    k_prep_w<<<nb((size_t)D * D, 256), 256, 0, stream>>>(w_co, D, D, WCO, D, nullptr, 0);
    k_prep_w<<<nb((size_t)2 * D * D, 256), 256, 0, stream>>>(w_ckv, D, 2 * D, WCKV, 2 * D, nullptr, 0);
    k_rmsnorm_rows<<<T / 4, 256, 0, stream>>>(x, norm_mix_w, XN, T);
    k_rmsnorm_rows<<<TM / 4, 256, 0, stream>>>(mem, norm_mem_w, MEMN, TM);
    k_rope_tab<<<nb((size_t)T * 8, 256), 256, 0, stream>>>(pos, CS, SN, LAM, lq1, lk1, lq2, lk2, RSS);
    k_gemm<EpiInProj><<<dim3(NP / 64, T / 64), 256, 0, stream>>>(XN, WIN, T, NP, D, EpiInProj{PROJ, GA});
    k_gemm<EpiBf16Plain><<<dim3(2 * D / 64, TM / 64), 256, 0, stream>>>(MEMN, WCKV, TM, 2 * D, D, EpiBf16Plain{KVM, 2 * D});
    k_rope<<<nb((size_t)T * 128, 256), 256, 0, stream>>>(PROJ, CS, SN);
    k_gla_gate<<<nb((size_t)T * 256, 256), 256, 0, stream>>>(GA, w_alpha2, b_alpha2, G);
    k_gla_rec<<<BATCH * 4, 128, 0, stream>>>(PROJ, G, GO);
    k_gla_out<<<T * 4 / 4, 256, 0, stream>>>(GO, PROJ, gla_norm_w, MIXED);
    k_diff_attn<<<BATCH * 64 * 8, 256, 0, stream>>>(PROJ, OD);
    k_diff_out<<<T * 4 / 4, 256, 0, stream>>>(OD, PROJ, diff_norm_w, LAM, MIXED);
    k_gemm<EpiOutProj><<<dim3(D / 64, T / 64), 256, 0, stream>>>(MIXED, WOUT, T, D, D, EpiOutProj{x, out, X1B, RSS});
    k_gemm<EpiCq><<<dim3(D / 64, T / 64), 256, 0, stream>>>(X1B, WCQ, T, D, D, EpiCq{QC, RSS});
    k_cross_attn<<<(T / 16) * 4, 256, 0, stream>>>(QC, KVM, OC);
    k_gemm<EpiCo><<<dim3(D / 64, T / 64), 256, 0, stream>>>(OC, WCO, T, D, D, EpiCo{out, RSS2});
    k_final_norm<<<T / 4, 256, 0, stream>>>(out, RSS2, final_norm_w);
}
```

```cpp
#include <hip/hip_runtime.h>
#include <cstdio>
#include <cstdint>

typedef unsigned short bf16_t;
typedef short bf16x8 __attribute__((ext_vector_type(8)));
typedef float f32x4 __attribute__((ext_vector_type(4)));

constexpr int BATCH = 8, SEQ = 4096, D = 1024, T = BATCH * SEQ;
constexpr int MEM_LEN = 256, TM = BATCH * MEM_LEN;
constexpr int D_IN = 3600, NP = 3840, PP = 3584;
constexpr float EPS = 1e-6f;
constexpr int C_GQ = 0, C_GK = 256, C_GV = 512, C_GG = 1024, C_DQ = 1536, C_DK = 2048, C_DV = 2560, C_DG = 3072, C_GA = 3584;

constexpr size_t MiB = 1u << 20;
constexpr size_t WS_CTL = 0;
constexpr size_t WS_WIN = 1 * MiB;
constexpr size_t WS_WOUT = 9 * MiB;
constexpr size_t WS_WCQ = 11 * MiB;
constexpr size_t WS_WCO = 13 * MiB;
constexpr size_t WS_WCKV = 15 * MiB;
constexpr size_t WS_MEMN = 20 * MiB;
constexpr size_t WS_KVM = 24 * MiB;
constexpr size_t WS_GA = 32 * MiB;
constexpr size_t WS_ROPE = 34 * MiB;
constexpr size_t WS_MISC = 36 * MiB;
constexpr size_t WS_XN = 40 * MiB;
constexpr size_t WS_MIXED = WS_XN;
constexpr size_t WS_PROJ = 104 * MiB;
constexpr size_t WS_X1B = WS_PROJ, WS_QC = WS_PROJ + 64 * MiB, WS_OC = WS_PROJ + 128 * MiB;
constexpr size_t WS_OD = 328 * MiB;
constexpr size_t WS_KVC = 392 * MiB;
constexpr size_t WS_ST = 456 * MiB;
constexpr size_t WS_END = 488 * MiB;

__device__ __forceinline__ bf16_t f2bf(float f) { unsigned u = __float_as_uint(f); return (bf16_t)((u + 0x7fffu + ((u >> 16) & 1u)) >> 16); }
__device__ __forceinline__ float bf2f(bf16_t h) { return __uint_as_float(((unsigned)h) << 16); }
__device__ __forceinline__ float wave_sum(float v) {
#pragma unroll
    for (int o = 1; o < 64; o <<= 1) v += __shfl_xor(v, o);
    return v;
}
__device__ __forceinline__ float silu(float x) { return x / (1.f + __expf(-x)); }

__device__ __forceinline__ int win_src_col(int n) { return n < 1536 ? n : (n < 3584 ? n + 16 : (n < 3600 ? n - 3584 + 1536 : -1)); }
__global__ void k_prep_w(const float* __restrict__ W, int K, int Nsrc, bf16_t* __restrict__ Wt, int Nout, const float* __restrict__ kscale, int mode) {
    const size_t i = (size_t)blockIdx.x * blockDim.x + threadIdx.x;
    if (i >= (size_t)Nout * K) return;
    const int n = (int)(i / K), k = (int)(i % K);
    const int c = mode == 1 ? win_src_col(n) : n;
    float v = 0.f;
    if (c >= 0) { v = W[(size_t)k * Nsrc + c]; if (kscale) v *= kscale[k]; }
    Wt[i] = f2bf(v);
}
__global__ void k_rmsnorm_rows(const float* __restrict__ x, const float* __restrict__ w, bf16_t* __restrict__ out, int rows) {
    const int row = blockIdx.x * (blockDim.x / 64) + (threadIdx.x >> 6), lane = threadIdx.x & 63;
    if (row >= rows) return;
    const f32x4* xr = (const f32x4*)(x + (size_t)row * D);
    f32x4 v[4]; float s = 0.f;
#pragma unroll
    for (int j = 0; j < 4; ++j) { v[j] = xr[lane + 64 * j]; s += v[j].x * v[j].x + v[j].y * v[j].y + v[j].z * v[j].z + v[j].w * v[j].w; }
    const float r = rsqrtf(wave_sum(s) * (1.f / D) + EPS);
#pragma unroll
    for (int j = 0; j < 4; ++j) {
        const f32x4 ww = ((const f32x4*)w)[lane + 64 * j];
        bf16_t* o = out + (size_t)row * D + 4 * (lane + 64 * j);
        o[0] = f2bf(v[j].x * r * ww.x); o[1] = f2bf(v[j].y * r * ww.y); o[2] = f2bf(v[j].z * r * ww.z); o[3] = f2bf(v[j].w * r * ww.w);
    }
}
__device__ __forceinline__ void sincos_d(double a, float& c, float& s) {
    const double q = rint(a * 0.63661977236758134308);
    double r = fma(-q, 1.5707963267948966, a); r = fma(-q, 6.123233995736766e-17, r);
    const double r2 = r * r;
    double sp = r * (1.0 + r2 * (-1.0 / 6 + r2 * (1.0 / 120 + r2 * (-1.0 / 5040 + r2 * (1.0 / 362880 + r2 * (-1.0 / 39916800 + r2 * (1.0 / 6227020800.0)))))));
    double cp = 1.0 + r2 * (-0.5 + r2 * (1.0 / 24 + r2 * (-1.0 / 720 + r2 * (1.0 / 40320 + r2 * (-1.0 / 3628800 + r2 * (1.0 / 479001600.0 + r2 * (-1.0 / 87178291200.0)))))));
    const int qi = ((int)(long long)q) & 3;
    double cc = (qi == 0) ? cp : (qi == 1) ? -sp : (qi == 2) ? -cp : sp;
    double ss = (qi == 0) ? sp : (qi == 1) ? cp : (qi == 2) ? -sp : -cp;
    c = (float)cc; s = (float)ss;
}
__global__ void k_rope_tab(const int* __restrict__ pos, float* __restrict__ cs, float* __restrict__ sn, float* __restrict__ lam,
                           const float* q1, const float* k1, const float* q2, const float* k2, float* rss) {
    const int i = blockIdx.x * blockDim.x + threadIdx.x;
    if (i < T * 8) {
        const int t = i >> 3, j = i & 7;
        const double invf[8] = {1.0, 0.19392274474868576, 0.03760603093086393, 0.007292664737217109, 0.001414213562373095, 0.0002742481756762073, 5.318295896944988e-05, 1.031338537721246e-05};
        double f = invf[0];
#pragma unroll
        for (int u = 1; u < 8; ++u) f = (j == u) ? invf[u] : f;
        float c, s; sincos_d((double)pos[t] * f, c, s);
        cs[i] = c; sn[i] = s;
    }
    if (i < 2 * T) rss[i] = 0.f;
    if (i == 0) {
        float a = 0.f, b = 0.f;
        for (int u = 0; u < 64; ++u) { a += q1[u] * k1[u]; b += q2[u] * k2[u]; }
        lam[0] = expf(a) - expf(b) + 0.2f;
    }
}

template <class Epi>
__global__ void __launch_bounds__(256) k_gemm(const bf16_t* __restrict__ A, const bf16_t* __restrict__ Bt, int M, int N, int K, Epi epi) {
    const int lane = threadIdx.x & 63, wid = threadIdx.x >> 6, wr = wid >> 1, wc = wid & 1;
    const int m0 = blockIdx.y * 64 + wr * 32, n0 = blockIdx.x * 64 + wc * 32;
    const int fr = lane & 15, fq = lane >> 4;
    f32x4 acc[2][2];
#pragma unroll
    for (int i = 0; i < 2; ++i)
#pragma unroll
        for (int j = 0; j < 2; ++j) acc[i][j] = (f32x4){0.f, 0.f, 0.f, 0.f};
    const bf16_t* ap = A + (size_t)(m0 + fr) * K + 8 * fq;
    const bf16_t* bp = Bt + (size_t)(n0 + fr) * K + 8 * fq;
    for (int k0 = 0; k0 < K; k0 += 32) {
        bf16x8 a[2], b[2];
#pragma unroll
        for (int i = 0; i < 2; ++i) { a[i] = *(const bf16x8*)(ap + (size_t)i * 16 * K + k0); b[i] = *(const bf16x8*)(bp + (size_t)i * 16 * K + k0); }
#pragma unroll
        for (int i = 0; i < 2; ++i)
#pragma unroll
            for (int j = 0; j < 2; ++j) acc[i][j] = __builtin_amdgcn_mfma_f32_16x16x32_bf16(a[i], b[j], acc[i][j], 0, 0, 0);
    }
#pragma unroll
    for (int i = 0; i < 2; ++i)
#pragma unroll
        for (int j = 0; j < 2; ++j)
#pragma unroll
            for (int r = 0; r < 4; ++r) epi(m0 + i * 16 + fq * 4 + r, n0 + j * 16 + fr, acc[i][j][r]);
}
struct EpiInProj { bf16_t* proj; float* ga;
    __device__ __forceinline__ void operator()(int m, int n, float v) const { if (n < PP) proj[(size_t)m * PP + n] = f2bf(v); else if (n < PP + 16) ga[m * 16 + n - PP] = v; } };
struct EpiBf16Plain { bf16_t* o; int ld;
    __device__ __forceinline__ void operator()(int m, int n, float v) const { o[(size_t)m * ld + n] = f2bf(v); } };
struct EpiOutProj { const float* x; float* x1; bf16_t* x1b; float* rss;
    __device__ __forceinline__ void operator()(int m, int n, float v) const { const size_t i = (size_t)m * D + n; const float y = x[i] + v; x1[i] = y; x1b[i] = f2bf(y); atomicAdd(rss + m, y * y); } };
struct EpiCq { bf16_t* qc; const float* rss;
    __device__ __forceinline__ void operator()(int m, int n, float v) const { qc[(size_t)m * D + n] = f2bf(v * rsqrtf(rss[m] * (1.f / D) + EPS) * (0.0625f * 1.4426950408889634f)); } };
struct EpiCo { float* x12; float* rss2;
    __device__ __forceinline__ void operator()(int m, int n, float v) const { const size_t i = (size_t)m * D + n; const float y = x12[i] + v; x12[i] = y; atomicAdd(rss2 + m, y * y); } };

__global__ void k_rope(bf16_t* __restrict__ proj, const float* __restrict__ cs, const float* __restrict__ sn) {
    const int i = blockIdx.x * blockDim.x + threadIdx.x;
    if (i >= T * 128) return;
    const int j = i & 7, hm = (i >> 3) & 7, wh = (i >> 6) & 1, t = i >> 7;
    bf16_t* b = proj + (size_t)t * PP + (wh ? C_DK : C_DQ) + hm * 64;
    const float r1 = bf2f(b[j]), r2 = bf2f(b[j + 8]), c = cs[t * 8 + j], s = sn[t * 8 + j];
    b[j] = f2bf(r1 * c - r2 * s); b[j + 8] = f2bf(r2 * c + r1 * s);
}

__global__ void k_gla_gate(const float* __restrict__ ga, const float* __restrict__ w2, const float* __restrict__ b2, float* __restrict__ G) {
    const int i = blockIdx.x * blockDim.x + threadIdx.x;
    if (i >= T * 256) return;
    const int c = i & 255, t = i >> 8;
    float z = b2[c];
#pragma unroll
    for (int r = 0; r < 16; ++r) z += ga[t * 16 + r] * w2[r * 256 + c];
    const float ls = fminf(z, 0.f) - log1pf(expf(-fabsf(z)));
    G[i] = ls * (1.f / 16.f);
}
__global__ void __launch_bounds__(128) k_gla_rec(const bf16_t* __restrict__ proj, const float* __restrict__ G, float* __restrict__ GO) {
    const int e = threadIdx.x, h = blockIdx.x & 3, b = blockIdx.x >> 2;
    float S[64];
#pragma unroll
    for (int c = 0; c < 64; ++c) S[c] = 0.f;
    for (int s = 0; s < SEQ; ++s) {
        const size_t t = (size_t)b * SEQ + s;
        const bf16x8* q8 = (const bf16x8*)(proj + t * PP + C_GQ + h * 64);
        const bf16x8* k8 = (const bf16x8*)(proj + t * PP + C_GK + h * 64);
        const float v = bf2f(proj[t * PP + C_GV + h * 128 + e]);
        const f32x4* g4 = (const f32x4*)(G + t * 256 + h * 64);
        float o = 0.f;
#pragma unroll
        for (int c8 = 0; c8 < 8; ++c8) {
            const bf16x8 qq = q8[c8], kk = k8[c8]; const f32x4 ga = g4[2 * c8], gb = g4[2 * c8 + 1];
#pragma unroll
            for (int j = 0; j < 8; ++j) { const int c = c8 * 8 + j; const float g = j < 4 ? ga[j] : gb[j - 4];
                S[c] = __expf(g) * S[c] + bf2f((bf16_t)kk[j]) * v; o += bf2f((bf16_t)qq[j]) * S[c]; }
        }
        GO[t * 512 + h * 128 + e] = o * 0.125f;
    }
}
__global__ void k_gla_out(const float* __restrict__ GO, const bf16_t* __restrict__ proj, const float* __restrict__ w, bf16_t* __restrict__ mixed) {
    const int gw = blockIdx.x * (blockDim.x / 64) + (threadIdx.x >> 6), lane = threadIdx.x & 63;
    if (gw >= T * 4) return;
    const int h = gw & 3; const size_t t = gw >> 2;
    const float o0 = GO[t * 512 + h * 128 + lane], o1 = GO[t * 512 + h * 128 + 64 + lane];
    const float r = rsqrtf(wave_sum(o0 * o0 + o1 * o1) * (1.f / 128) + EPS);
    const float g0 = bf2f(proj[t * PP + C_GG + h * 128 + lane]), g1 = bf2f(proj[t * PP + C_GG + h * 128 + 64 + lane]);
    mixed[t * D + h * 128 + lane] = f2bf(o0 * r * w[lane] * silu(g0));
    mixed[t * D + h * 128 + 64 + lane] = f2bf(o1 * r * w[64 + lane] * silu(g1));
}

__global__ void __launch_bounds__(256) k_diff_attn(const bf16_t* __restrict__ proj, bf16_t* __restrict__ od) {
    const int tid = threadIdx.x, qtr = tid & 3, rl = tid >> 2;
    const int hm = blockIdx.x & 7, chunk = (blockIdx.x >> 3) & 63, b = blockIdx.x >> 9;
    const int h = hm >> 1;
    const size_t t = (size_t)b * SEQ + chunk * 64 + rl;
    float q[64];
    { const bf16x8* qp = (const bf16x8*)(proj + t * PP + C_DQ + hm * 64);
#pragma unroll
      for (int c = 0; c < 8; ++c) { const bf16x8 qq = qp[c];
#pragma unroll
          for (int j = 0; j < 8; ++j) q[c * 8 + j] = bf2f((bf16_t)qq[j]); } }
    float o[32];
#pragma unroll
    for (int i = 0; i < 32; ++i) o[i] = 0.f;
    float m = -INFINITY, l = 0.f;
    const int nk = (chunk + 1) * 64;
    for (int j = 0; j < nk; ++j) {
        const size_t tk = (size_t)b * SEQ + j;
        const bf16x8* kp = (const bf16x8*)(proj + tk * PP + C_DK + hm * 64);
        float s = 0.f;
#pragma unroll
        for (int c = 0; c < 8; ++c) { const bf16x8 kk = kp[c];
#pragma unroll
            for (int j = 0; j < 8; ++j) s += q[c * 8 + j] * bf2f((bf16_t)kk[j]); }
        const float mn = fmaxf(m, s), al = exp2f(m - mn), p = exp2f(s - mn);
        l = l * al + p; m = mn;
        const bf16x8* vp = (const bf16x8*)(proj + tk * PP + C_DV + h * 128 + qtr * 32);
#pragma unroll
        for (int c = 0; c < 4; ++c) { const bf16x8 vv = vp[c];
#pragma unroll
            for (int j = 0; j < 8; ++j) o[c * 8 + j] = o[c * 8 + j] * al + p * bf2f((bf16_t)vv[j]); }
    }
    const float rl_ = 1.f / l;
#pragma unroll
    for (int i = 0; i < 32; ++i) od[t * D + hm * 128 + qtr * 32 + i] = f2bf(o[i] * rl_);
}
__global__ void k_diff_out(const bf16_t* __restrict__ od, const bf16_t* __restrict__ proj, const float* __restrict__ w, const float* __restrict__ lam, bf16_t* __restrict__ mixed) {
    const int gw = blockIdx.x * (blockDim.x / 64) + (threadIdx.x >> 6), lane = threadIdx.x & 63;
    if (gw >= T * 4) return;
    const int h = gw & 3; const size_t t = gw >> 2;
    const float lm = lam[0];
    const bf16_t* o1 = od + t * D + (2 * h) * 128; const bf16_t* o2 = o1 + 128;
    const float d0 = bf2f(o1[lane]) - lm * bf2f(o2[lane]), d1 = bf2f(o1[64 + lane]) - lm * bf2f(o2[64 + lane]);
    const float r = rsqrtf(wave_sum(d0 * d0 + d1 * d1) * (1.f / 128) + EPS);
    const float g0 = bf2f(proj[t * PP + C_DG + h * 128 + lane]), g1 = bf2f(proj[t * PP + C_DG + h * 128 + 64 + lane]);
    mixed[t * D + 512 + h * 128 + lane] = f2bf(d0 * r * w[lane] * 0.8f * silu(g0));
    mixed[t * D + 512 + h * 128 + 64 + lane] = f2bf(d1 * r * w[64 + lane] * 0.8f * silu(g1));
}

__global__ void __launch_bounds__(256) k_cross_attn(const bf16_t* __restrict__ qc, const bf16_t* __restrict__ kvm, bf16_t* __restrict__ oc) {
    __shared__ float sp[16][257];
    __shared__ float sl[16];
    const int tid = threadIdx.x, head = blockIdx.x & 3, tile = blockIdx.x >> 2;
    const size_t t0 = (size_t)tile * 16; const int b = (int)(t0 / SEQ);
    const bf16_t* kp = kvm + (size_t)(b * MEM_LEN + tid) * 2048 + head * 256;
    float acc[16];
#pragma unroll
    for (int r = 0; r < 16; ++r) acc[r] = 0.f;
    for (int d = 0; d < 256; ++d) {
        const float kv = bf2f(kp[d]);
#pragma unroll
        for (int r = 0; r < 16; ++r) acc[r] += kv * bf2f(qc[(t0 + r) * D + head * 256 + d]);
    }
#pragma unroll
    for (int r = 0; r < 16; ++r) sp[r][tid] = acc[r];
    __syncthreads();
    { const int w = tid >> 6, lane = tid & 63;
      for (int r = w * 4; r < w * 4 + 4; ++r) {
          float mx = -INFINITY;
          for (int j = lane; j < 256; j += 64) mx = fmaxf(mx, sp[r][j]);
#pragma unroll
          for (int o = 1; o < 64; o <<= 1) mx = fmaxf(mx, __shfl_xor(mx, o));
          float sum = 0.f;
          for (int j = lane; j < 256; j += 64) { const float p = exp2f(sp[r][j] - mx); sp[r][j] = p; sum += p; }
          sum = wave_sum(sum);
          if (lane == 0) sl[r] = sum;
      } }
    __syncthreads();
#pragma unroll
    for (int r = 0; r < 16; ++r) acc[r] = 0.f;
    const bf16_t* vp = kvm + (size_t)(b * MEM_LEN) * 2048 + 1024 + head * 256 + tid;
    for (int j = 0; j < 256; ++j) {
        const float v = bf2f(vp[(size_t)j * 2048]);
#pragma unroll
        for (int r = 0; r < 16; ++r) acc[r] += sp[r][j] * v;
    }
#pragma unroll
    for (int r = 0; r < 16; ++r) oc[(t0 + r) * D + head * 256 + tid] = f2bf(acc[r] / sl[r]);
}
__global__ void k_final_norm(float* __restrict__ x2, const float* __restrict__ rss2, const float* __restrict__ w) {
    const int row = blockIdx.x * (blockDim.x / 64) + (threadIdx.x >> 6), lane = threadIdx.x & 63;
    if (row >= T) return;
    const float r = rsqrtf(rss2[row] * (1.f / D) + EPS);
    f32x4* xr = (f32x4*)(x2 + (size_t)row * D);
#pragma unroll
    for (int j = 0; j < 4; ++j) { f32x4 v = xr[lane + 64 * j]; const f32x4 ww = ((const f32x4*)w)[lane + 64 * j]; v.x *= r * ww.x; v.y *= r * ww.y; v.z *= r * ww.z; v.w *= r * ww.w; xr[lane + 64 * j] = v; }
}


namespace pg8 {
#define PG8_LAS __attribute__((address_space(3)))
typedef unsigned short bf16_t;
typedef short bf16x8 __attribute__((ext_vector_type(8)));
typedef float f32x4 __attribute__((ext_vector_type(4)));
typedef unsigned u32x4 __attribute__((ext_vector_type(4)));
constexpr int BM = 256, BK = 64, HALF = 128, HTB = HALF * BK * 2  , STAGE_BYTES = 8 * HTB, NXCD = 8, WGM = 8;

__host__ __device__ __forceinline__ int lds_byte(int r, int c) { const int st = (r >> 4) * 2 + (c >> 5), rr = r & 15, cc = c & 31, ob = rr * 64 + cc * 2; return st * 1024 + (ob ^ (((ob >> 9) & 1) << 5)); }
__host__ __device__ __forceinline__ void stage_rc(int b, int& R, int& C) { const int st = b / 1024, sb = b % 1024, swz = sb ^ (((sb >> 9) & 1) << 5); R = (st >> 1) * 16 + swz / 64; C = (st & 1) * 32 + (swz % 64) / 2; }
__host__ __device__ __forceinline__ int perm32(int rho) { const int n = rho >> 4, i = rho & 15; return 8 * (i >> 2) + 4 * n + (i & 3); }

struct Unit { int pm, pn; };
struct Gemm { const bf16_t* A; const bf16_t* Bt; int M, N, K; };

struct StaticOrder {
    int nM, nN, nwg, G, c;
    __host__ __device__ void init(int M, int N, int G_, int c_) { nM = M / BM; nN = N / BM; nwg = nM * nN; G = G_; c = c_; }
    __host__ __device__ bool next(int i, Unit& u) const {
        const long L = (long)i * G + c; if (L >= nwg) return false;
        int wgid = (int)L; { const int q = nwg / NXCD, r = nwg % NXCD, xcd = wgid % NXCD, off = wgid / NXCD; wgid = (xcd < r ? xcd * (q + 1) : r * (q + 1) + (xcd - r) * q) + off; }
        const int nig = WGM * nN, gid = wgid / nig, fm = gid * WGM, gsz = (nM - fm) < WGM ? (nM - fm) : WGM;
        u.pm = fm + ((wgid % nig) % gsz); u.pn = (wgid % nig) / gsz; return true;
    }
    __device__ __forceinline__ void a_ready(const Unit&) const {}
    __device__ __forceinline__ void done(const Unit&) const {}
};

__device__ __forceinline__ unsigned cvt_pk_bf16(float lo, float hi) { unsigned r; asm volatile("v_cvt_pk_bf16_f32 %0, %1, %2" : "=v"(r) : "v"(lo), "v"(hi)); return r; }
typedef float f32x2 __attribute__((ext_vector_type(2)));
__device__ __forceinline__ f32x2 gelu_pk(f32x2 v) {
    const f32x2 av = __builtin_elementwise_abs(v), d = av * 0.2316418882f + 1.0f;
    f32x2 t; t.x = __builtin_amdgcn_rcpf(d.x); t.y = __builtin_amdgcn_rcpf(d.y);
    f32x2 q = t * 0.5307027145f + (-0.7265760135f); q = q * t + 0.7107068705f; q = q * t + (-0.142248368f); q = q * t + 0.127414796f; q = q * t;
    const f32x2 s = (v * v) * (-0.72134752044f);
    f32x2 e; e.x = __builtin_amdgcn_exp2f(s.x); e.y = __builtin_amdgcn_exp2f(s.y);
    const f32x2 m = v * (q * e), r = v - m;
    f32x2 o; o.x = v.x < 0.f ? m.x : r.x; o.y = v.y < 0.f ? m.y : r.y; return o;
}

template <int ACT  > struct EpiBf16 {
    static constexpr bool PERM = true, AFTER_DRAIN = false; static_assert(ACT == 0 || ACT == 1, "EpiBf16: ACT is 0 (none) or 1 (gelu_pk)");
    bf16_t* O; int ldc; const float* bias; int split_cols; size_t split_stride; float scale0;
    __device__ __forceinline__ void operator()(const f32x4 (&acc)[2][2][4][2], const Unit& u, int wr, int wc, int fr, int fq) const {
        asm volatile("" : "+v"(fr), "+v"(fq));
        const int row0 = u.pm * BM + wr * 64 + fr; int colt = u.pn * BM; bf16_t* base = O;
        float sc = 1.f; if (split_cols) { const int t = colt / split_cols; base += (size_t)t * split_stride; colt -= t * split_cols; if (t == 0) sc = scale0; }
        const int col0 = colt + wc * 32 + 8 * fq, bcol0 = u.pn * BM + wc * 32 + 8 * fq;
        f32x4 bv[2][2];
#pragma unroll
        for (int bj = 0; bj < 2; ++bj)
#pragma unroll
            for (int n = 0; n < 2; ++n) bv[bj][n] = bias ? *(const f32x4*)(bias + bcol0 + bj * HALF + 4 * n) : (f32x4){0.f, 0.f, 0.f, 0.f};
#pragma unroll
        for (int ai = 0; ai < 2; ++ai)
#pragma unroll
            for (int m = 0; m < 4; ++m) { bf16_t* rowp = base + (size_t)(row0 + ai * HALF + m * 16) * ldc + col0;
#pragma unroll
                for (int bj = 0; bj < 2; ++bj) { f32x4 v0 = acc[ai][bj][m][0] + bv[bj][0], v1 = acc[ai][bj][m][1] + bv[bj][1];
                    if (ACT == 1) { f32x2 a = gelu_pk((f32x2){v0[0], v0[1]}), b = gelu_pk((f32x2){v0[2], v0[3]}), c = gelu_pk((f32x2){v1[0], v1[1]}), d = gelu_pk((f32x2){v1[2], v1[3]});
                        v0 = (f32x4){a.x, a.y, b.x, b.y}; v1 = (f32x4){c.x, c.y, d.x, d.y}; }
                    v0 = v0 * sc; v1 = v1 * sc; u32x4 w; w.x = cvt_pk_bf16(v0[0], v0[1]); w.y = cvt_pk_bf16(v0[2], v0[3]); w.z = cvt_pk_bf16(v1[0], v1[1]); w.w = cvt_pk_bf16(v1[2], v1[3]);
                    *(u32x4*)(rowp + bj * HALF) = w; } }
    }
};

constexpr float QC2 = 0.125f * 1.4426950408889634f;
constexpr float QC3 = 0.0625f * 1.4426950408889634f;
constexpr int PPITCH = 3584;
__device__ __forceinline__ u32x4 pack8(const f32x4& v0, const f32x4& v1) { u32x4 w; w.x = cvt_pk_bf16(v0[0], v0[1]); w.y = cvt_pk_bf16(v0[2], v0[3]); w.z = cvt_pk_bf16(v1[0], v1[1]); w.w = cvt_pk_bf16(v1[2], v1[3]); return w; }
struct EpiInProj {
    static constexpr bool PERM = true, AFTER_DRAIN = false;
    bf16_t* proj; float* ga; const float* cs; const float* sn;
    __device__ __forceinline__ void operator()(const f32x4 (&acc)[2][2][4][2], const Unit& u, int wr, int wc, int fr, int fq) const {
        asm volatile("" : "+v"(fr), "+v"(fq));
        const int row0 = u.pm * BM + wr * 64 + fr;
        if (u.pn == 14) {
            if (wc == 0 && fq < 2) {
#pragma unroll
                for (int ai = 0; ai < 2; ++ai)
#pragma unroll
                    for (int m = 0; m < 4; ++m) { float* g = ga + (size_t)(row0 + ai * HALF + m * 16) * 16 + 8 * fq; *(f32x4*)g = acc[ai][0][m][0]; *(f32x4*)(g + 4) = acc[ai][0][m][1]; }
            }
            return;
        }
#ifdef NO_ROPE
        const bool rope = false;
#else
        const bool rope = (u.pn >= 6) && (u.pn <= 9) && ((wc & 1) == 0);
#endif
        const float sc = (u.pn == 6 || u.pn == 7) ? QC2 : 1.f;
        const float sg = (fq == 0) ? -1.f : 1.f;
        const bool rl = fq < 2;
        bf16_t* base = proj + u.pn * BM + wc * 32 + 8 * fq;
#pragma unroll
        for (int ai = 0; ai < 2; ++ai)
#pragma unroll
            for (int m = 0; m < 4; ++m) {
                const int row = row0 + ai * HALF + m * 16;
                f32x4 c0 = (f32x4){1.f, 1.f, 1.f, 1.f}, c1 = c0, s0 = (f32x4){0.f, 0.f, 0.f, 0.f}, s1 = s0;
                if (rope) { c0 = *(const f32x4*)(cs + (size_t)row * 8); c1 = *(const f32x4*)(cs + (size_t)row * 8 + 4); s0 = *(const f32x4*)(sn + (size_t)row * 8); s1 = *(const f32x4*)(sn + (size_t)row * 8 + 4); }
#pragma unroll
                for (int bj = 0; bj < 2; ++bj) {
                    f32x4 v0 = acc[ai][bj][m][0], v1 = acc[ai][bj][m][1];
                    if (rope) {
                        f32x4 p0, p1;
#pragma unroll
                        for (int i = 0; i < 4; ++i) { p0[i] = __shfl_xor(v0[i], 16); p1[i] = __shfl_xor(v1[i], 16); }
                        if (rl) { v0 = v0 * c0 + (p0 * s0) * sg; v1 = v1 * c1 + (p1 * s1) * sg; }
                    }
                    v0 = v0 * sc; v1 = v1 * sc;
                    *(u32x4*)(base + (size_t)row * PPITCH + bj * HALF) = pack8(v0, v1);
                }
                asm volatile("" ::: "memory");
            }
    }
};
struct EpiOutProj {
    static constexpr bool PERM = true, AFTER_DRAIN = false;
    const float* x; float* x1; bf16_t* x1b; float* rss;
    __device__ __forceinline__ void operator()(const f32x4 (&acc)[2][2][4][2], const Unit& u, int wr, int wc, int fr, int fq) const {
        asm volatile("" : "+v"(fr), "+v"(fq));
        const int row0 = u.pm * BM + wr * 64 + fr, col0 = u.pn * BM + wc * 32 + 8 * fq;
#pragma unroll
        for (int ai = 0; ai < 2; ++ai)
#pragma unroll
            for (int m = 0; m < 4; ++m) {
                const int row = row0 + ai * HALF + m * 16; const size_t off = (size_t)row * 1024 + col0; float ss = 0.f;
#pragma unroll
                for (int bj = 0; bj < 2; ++bj) {
                    const f32x4 v0 = acc[ai][bj][m][0] + *(const f32x4*)(x + off + bj * HALF), v1 = acc[ai][bj][m][1] + *(const f32x4*)(x + off + bj * HALF + 4);
                    *(f32x4*)(x1 + off + bj * HALF) = v0; *(f32x4*)(x1 + off + bj * HALF + 4) = v1;
                    *(u32x4*)(x1b + off + bj * HALF) = pack8(v0, v1);
                    ss += (v0[0] * v0[0] + v0[1] * v0[1]) + (v0[2] * v0[2] + v0[3] * v0[3]) + (v1[0] * v1[0] + v1[1] * v1[1]) + (v1[2] * v1[2] + v1[3] * v1[3]);
                }
                ss += __shfl_xor(ss, 16); ss += __shfl_xor(ss, 32);
                if (fq == 0) atomicAdd(rss + row, ss);
                asm volatile("" ::: "memory");
            }
    }
};
struct EpiCq {
    static constexpr bool PERM = true, AFTER_DRAIN = false;
    bf16_t* qc; const float* rss;
    __device__ __forceinline__ void operator()(const f32x4 (&acc)[2][2][4][2], const Unit& u, int wr, int wc, int fr, int fq) const {
        asm volatile("" : "+v"(fr), "+v"(fq));
        const int row0 = u.pm * BM + wr * 64 + fr, col0 = u.pn * BM + wc * 32 + 8 * fq;
#pragma unroll
        for (int ai = 0; ai < 2; ++ai)
#pragma unroll
            for (int m = 0; m < 4; ++m) {
                const int row = row0 + ai * HALF + m * 16; const float r = rsqrtf(rss[row] * (1.f / 1024.f) + 1e-6f) * QC3;
#pragma unroll
                for (int bj = 0; bj < 2; ++bj) *(u32x4*)(qc + (size_t)row * 1024 + col0 + bj * HALF) = pack8(acc[ai][bj][m][0] * r, acc[ai][bj][m][1] * r);
            }
    }
};
struct EpiCo {
    static constexpr bool PERM = true, AFTER_DRAIN = false;
    float* x12; float* rss2;
    __device__ __forceinline__ void operator()(const f32x4 (&acc)[2][2][4][2], const Unit& u, int wr, int wc, int fr, int fq) const {
        asm volatile("" : "+v"(fr), "+v"(fq));
        const int row0 = u.pm * BM + wr * 64 + fr, col0 = u.pn * BM + wc * 32 + 8 * fq;
#pragma unroll
        for (int ai = 0; ai < 2; ++ai)
#pragma unroll
            for (int m = 0; m < 4; ++m) {
                const int row = row0 + ai * HALF + m * 16; const size_t off = (size_t)row * 1024 + col0; float ss = 0.f;
#pragma unroll
                for (int bj = 0; bj < 2; ++bj) {
                    const f32x4 v0 = acc[ai][bj][m][0] + *(const f32x4*)(x12 + off + bj * HALF), v1 = acc[ai][bj][m][1] + *(const f32x4*)(x12 + off + bj * HALF + 4);
                    *(f32x4*)(x12 + off + bj * HALF) = v0; *(f32x4*)(x12 + off + bj * HALF + 4) = v1;
                    ss += (v0[0] * v0[0] + v0[1] * v0[1]) + (v0[2] * v0[2] + v0[3] * v0[3]) + (v1[0] * v1[0] + v1[1] * v1[1]) + (v1[2] * v1[2] + v1[3] * v1[3]);
                }
                ss += __shfl_xor(ss, 16); ss += __shfl_xor(ss, 32);
                if (fq == 0) atomicAdd(rss2 + row, ss);
                asm volatile("" ::: "memory");
            }
    }
};
template <class Epi, class Sched, bool ALIGN_EPI = false, bool SP2 = false>
__device__ __forceinline__ void gemm_phase(PG8_LAS unsigned char* lds, const Gemm g, const Sched& S, const Epi& E) {
    const int tid = threadIdx.x, wid = __builtin_amdgcn_readfirstlane(tid >> 6), lane = tid & 63, wr = wid >> 2, wc = wid & 3, fr = lane & 15, fq = lane >> 4;
    const int K = g.K, nt = K / BK;
    unsigned voffA[2], voffB[2];
#pragma unroll
    for (int i = 0; i < 2; ++i) { int R, C; stage_rc(tid * 16 + i * 8192, R, C); const int Rb = Epi::PERM ? ((R & ~31) + perm32(R & 31)) : R;
        voffA[i] = (unsigned)(R * K + C) * 2u; voffB[i] = (unsigned)(Rb * K + C) * 2u; }
    const size_t kstep = (size_t)(BK * 2);
    const size_t hstep = (size_t)HALF * K * 2;
    const size_t tstep = 2 * hstep;
    const unsigned ldsw = (unsigned)wid * 1024u;
    const int aoff = lds_byte(wr * 64 + fr, fq * 8), boff = lds_byte(wc * 32 + fr, fq * 8);
#define PG8_SA(b, h) (((b) * 2 + (h)) * HTB)
#define PG8_SB(b, h) ((4 + (b) * 2 + (h)) * HTB)
#define PG8_STAGE(bufoff, gbase, voff) do { _Pragma("unroll") for (int _i = 0; _i < 2; ++_i) \
        __builtin_amdgcn_global_load_lds((const unsigned*)((const char*)(gbase) + (voff)[_i]), (PG8_LAS unsigned*)(lds + (bufoff) + ldsw + _i * 8192), 16, 0, 0); } while (0)
#define PG8_LDA(dst, b, h) do { _Pragma("unroll") for (int m = 0; m < 4; ++m) _Pragma("unroll") for (int k = 0; k < 2; ++k) dst[m][k] = *(const PG8_LAS bf16x8*)(lds + PG8_SA(b, h) + aoff + m * 2048 + k * 1024); } while (0)
#define PG8_LDB(dst, b, h) do { _Pragma("unroll") for (int n = 0; n < 2; ++n) _Pragma("unroll") for (int k = 0; k < 2; ++k) dst[n][k] = *(const PG8_LAS bf16x8*)(lds + PG8_SB(b, h) + boff + n * 2048 + k * 1024); } while (0)
#define PG8_MMA(ai, bj, At, Bt) do { __builtin_amdgcn_s_setprio(1); _Pragma("unroll") for (int m = 0; m < 4; ++m) _Pragma("unroll") for (int n = 0; n < 2; ++n) _Pragma("unroll") for (int k = 0; k < 2; ++k) \
        acc[ai][bj][m][n] = __builtin_amdgcn_mfma_f32_16x16x32_bf16(Bt[n][k], At[m][k], acc[ai][bj][m][n], 0, 0, 0); __builtin_amdgcn_s_setprio(0); } while (0)
#define PG8_WAIT_V(n) asm volatile("s_waitcnt vmcnt(" #n ")" ::: "memory")
#define PG8_WAIT_L(n) asm volatile("s_waitcnt lgkmcnt(" #n ")" ::: "memory")
#define PG8_BAR __builtin_amdgcn_s_barrier()
#define PG8_SCHED __builtin_amdgcn_sched_barrier(0)
    Unit cur, nxt; int ui = 0;
    if (!S.next(0, cur)) return;
    f32x4 acc[2][2][4][2];
#pragma unroll
    for (int a = 0; a < 2; ++a)
#pragma unroll
        for (int b = 0; b < 2; ++b)
#pragma unroll
            for (int m = 0; m < 4; ++m)
#pragma unroll
                for (int n = 0; n < 2; ++n) acc[a][b][m][n] = (f32x4){0.f, 0.f, 0.f, 0.f};
    bf16x8 At[4][2], B0[2][2], B1[2][2];
    const char* cA = (const char*)g.A + (size_t)cur.pm * tstep; const char* cB = (const char*)g.Bt + (size_t)cur.pn * tstep;
    S.a_ready(cur);
    if constexpr (SP2) {
        PG8_STAGE(PG8_SB(0, 0), cB, voffB); PG8_STAGE(PG8_SB(0, 1), cB + hstep, voffB); PG8_STAGE(PG8_SA(0, 0), cA, voffA); PG8_STAGE(PG8_SA(0, 1), cA + hstep, voffA);
        if (wr == 1) PG8_BAR;
        PG8_WAIT_V(2); PG8_BAR;
        PG8_STAGE(PG8_SB(1, 0), cB + kstep, voffB); PG8_STAGE(PG8_SA(1, 0), cA + kstep, voffA); PG8_STAGE(PG8_SB(1, 1), cB + hstep + kstep, voffB);
        PG8_WAIT_V(6); PG8_BAR;
    } else {
        PG8_STAGE(PG8_SB(0, 0), cB, voffB); PG8_STAGE(PG8_SA(0, 0), cA, voffA); PG8_STAGE(PG8_SB(0, 1), cB + hstep, voffB); PG8_STAGE(PG8_SA(0, 1), cA + hstep, voffA);
        if (wr == 1) PG8_BAR;
        PG8_WAIT_V(4); PG8_BAR;
        PG8_STAGE(PG8_SB(1, 0), cB + kstep, voffB); PG8_STAGE(PG8_SA(1, 0), cA + kstep, voffA); PG8_STAGE(PG8_SB(1, 1), cB + hstep + kstep, voffB);
        PG8_WAIT_V(6); PG8_BAR;
    }
    for (;;) {
        const bool has_next = S.next(ui + 1, nxt);
        const char* nA = has_next ? (const char*)g.A + (size_t)nxt.pm * tstep : cA; const char* nB = has_next ? (const char*)g.Bt + (size_t)nxt.pn * tstep : cB;
        for (int t = 0; t < nt; t += 2) {
            const bool last = (t == nt - 2);
            const char* a1 = cA + (size_t)(t + 1) * kstep;
            const char* a2 = last ? nA : cA + (size_t)(t + 2) * kstep; const char* b2 = last ? nB : cB + (size_t)(t + 2) * kstep;
            const char* a3 = a2 + kstep; const char* b3 = b2 + kstep;
            if (last && has_next) S.a_ready(nxt);
            if constexpr (SP2) {
            PG8_LDB(B0, 0, 0); PG8_LDB(B1, 0, 1); PG8_SCHED; PG8_LDA(At, 0, 0); PG8_STAGE(PG8_SA(1, 1), a1 + hstep, voffA);
            PG8_WAIT_V(8); PG8_WAIT_L(0); PG8_BAR; PG8_MMA(0, 0, At, B0); PG8_MMA(0, 1, At, B1); PG8_BAR; PG8_SCHED;
            PG8_LDA(At, 0, 1); PG8_STAGE(PG8_SB(0, 0), b2, voffB); PG8_STAGE(PG8_SB(0, 1), b2 + hstep, voffB); PG8_STAGE(PG8_SA(0, 0), a2, voffA);
            PG8_WAIT_V(8); PG8_WAIT_L(0); PG8_BAR; PG8_MMA(1, 0, At, B0); PG8_MMA(1, 1, At, B1); PG8_BAR; PG8_SCHED;
            PG8_LDB(B0, 1, 0); PG8_LDB(B1, 1, 1); PG8_SCHED; PG8_LDA(At, 1, 0); PG8_STAGE(PG8_SA(0, 1), a2 + hstep, voffA);
            PG8_WAIT_V(8); PG8_WAIT_L(0); PG8_BAR; PG8_MMA(0, 0, At, B0); PG8_MMA(0, 1, At, B1); PG8_BAR; PG8_SCHED;
            PG8_LDA(At, 1, 1); PG8_STAGE(PG8_SB(1, 0), b3, voffB); PG8_STAGE(PG8_SB(1, 1), b3 + hstep, voffB); PG8_STAGE(PG8_SA(1, 0), a3, voffA);
            PG8_WAIT_V(8); PG8_WAIT_L(0); PG8_BAR; PG8_MMA(1, 0, At, B0); PG8_MMA(1, 1, At, B1); PG8_BAR; PG8_SCHED;
            } else {
            PG8_LDB(B0, 0, 0); PG8_SCHED; PG8_LDA(At, 0, 0); PG8_STAGE(PG8_SA(1, 1), a1 + hstep, voffA);
            PG8_WAIT_L(8); PG8_BAR; PG8_WAIT_L(0); PG8_MMA(0, 0, At, B0); PG8_BAR; PG8_SCHED;
            PG8_LDB(B1, 0, 1); PG8_STAGE(PG8_SB(0, 0), b2, voffB);
            PG8_BAR; PG8_WAIT_L(0); PG8_MMA(0, 1, At, B1); PG8_BAR;
            PG8_LDA(At, 0, 1); PG8_STAGE(PG8_SA(0, 0), a2, voffA);
            PG8_BAR; PG8_WAIT_L(0); PG8_MMA(1, 0, At, B0); PG8_BAR; PG8_SCHED;
            PG8_STAGE(PG8_SB(0, 1), b2 + hstep, voffB);
            PG8_WAIT_V(6); PG8_BAR; PG8_MMA(1, 1, At, B1); PG8_BAR;
            PG8_LDB(B0, 1, 0); PG8_SCHED; PG8_LDA(At, 1, 0); PG8_STAGE(PG8_SA(0, 1), a2 + hstep, voffA);
            PG8_WAIT_L(8); PG8_BAR; PG8_WAIT_L(0); PG8_MMA(0, 0, At, B0); PG8_BAR; PG8_SCHED;
            PG8_LDB(B1, 1, 1); PG8_STAGE(PG8_SB(1, 0), b3, voffB);
            PG8_BAR; PG8_WAIT_L(0); PG8_MMA(0, 1, At, B1); PG8_BAR;
            PG8_LDA(At, 1, 1); PG8_STAGE(PG8_SA(1, 0), a3, voffA);
            PG8_BAR; PG8_WAIT_L(0); PG8_MMA(1, 0, At, B0); PG8_BAR; PG8_SCHED;
            PG8_STAGE(PG8_SB(1, 1), b3 + hstep, voffB);
            PG8_WAIT_V(6); PG8_BAR; PG8_MMA(1, 1, At, B1); PG8_BAR;
            }
        }
        if constexpr (ALIGN_EPI) { if (wr == 0) PG8_BAR; }
        if constexpr (!Epi::AFTER_DRAIN) { E(acc, cur, wr, wc, fr, fq); S.done(cur); }
        if (!has_next) break;
#pragma unroll
        for (int a = 0; a < 2; ++a)
#pragma unroll
            for (int b = 0; b < 2; ++b)
#pragma unroll
                for (int m = 0; m < 4; ++m)
#pragma unroll
                    for (int n = 0; n < 2; ++n) acc[a][b][m][n] = (f32x4){0.f, 0.f, 0.f, 0.f};
        cur = nxt; cA = nA; cB = nB; ++ui;
        if constexpr (ALIGN_EPI) { if (wr == 1) PG8_BAR; }
    }
    PG8_WAIT_V(0);
    if constexpr (!ALIGN_EPI) { if (wr == 0) PG8_BAR; }
    PG8_BAR;
    if constexpr (Epi::AFTER_DRAIN) { E.fused(acc, cur, wr, wc, fr, fq, lds, wid, lane); S.done(cur); }
#undef PG8_SA
#undef PG8_SB
#undef PG8_STAGE
#undef PG8_LDA
#undef PG8_LDB
#undef PG8_MMA
#undef PG8_WAIT_V
#undef PG8_WAIT_L
#undef PG8_BAR
#undef PG8_SCHED
}
}

#ifndef PG8_SP2
#define PG8_SP2 true
#endif
#ifndef PG8_ALIGN
#define PG8_ALIGN true
#endif

#include <hip/hip_bf16.h>
#include <cmath>
namespace attn_body {
using bf16=__hip_bfloat16;
using bf16x8=__attribute__((ext_vector_type(8)))short;
using s16x4=__attribute__((ext_vector_type(4)))short;
using f32x16=__attribute__((ext_vector_type(16)))float;
using u32x4=__attribute__((ext_vector_type(4)))unsigned;
constexpr int SEQ=4096,D=64,PQ=3584,PO=1024;
constexpr int NW=8,QBLK=32,QB=QBLK*NW,KVBLK=64,NQB=SEQ/QB;
constexpr int ATTN_UNIT_ROWS=QB;
__device__ __forceinline__ int crow(int r,int hi){return (r&3)+8*(r>>2)+4*hi;}
#define SBAR() __builtin_amdgcn_sched_barrier(0)
__device__ __forceinline__ void cmask(f32x16&p0,f32x16&p1,int jb,int qrel,int hi){
  const float NEG=-INFINITY;
  if(jb>(qrel>>6)){
  #pragma unroll
  for(int r=0;r<16;++r){p0[r]=NEG;p1[r]=NEG;}}
}

constexpr int NSLOT=3, SLOTB=8192;
constexpr int LDS_K=0, LDS_V=NSLOT*SLOTB, LDS_WS=2*NSLOT*SLOTB, LDS_OST=LDS_WS+NW*64*4, LDS_BYTES=LDS_OST+NW*4096;
constexpr float C2=0.125f*1.4426950408889634f;
__device__ __forceinline__ void glds16(const void*gsrc,unsigned lds_dst){unsigned keep;
  asm volatile("s_mov_b32 %0, m0\n\ts_mov_b32 m0, %2\n\ts_nop 0\n\tglobal_load_lds_dwordx4 %1, off\n\ts_mov_b32 m0, %0":"=&s"(keep):"v"(gsrc),"s"(lds_dst):"memory");}
__device__ __forceinline__ float max3f(float a,float b,float c){float r;asm("v_max3_f32 %0, %1, %2, %3":"=v"(r):"v"(a),"v"(b),"v"(c));return r;}
__device__ __forceinline__ float max2f(float a,float b){float r;asm("v_max_f32_e32 %0, %1, %2":"=v"(r):"v"(a),"v"(b));return r;}
__device__ __forceinline__ float fadd_s(float a,float b){float r;asm("v_add_f32_e32 %0, %1, %2":"=v"(r):"v"(a),"v"(b));return r;}
__device__ __forceinline__ float fsub_s(float a,float b){float r;asm("v_sub_f32_e32 %0, %1, %2":"=v"(r):"v"(a),"v"(b));return r;}
typedef float f32x2_t __attribute__((ext_vector_type(2))); typedef __bf16 bf16x2_t __attribute__((ext_vector_type(2)));
__device__ __forceinline__ unsigned cvtpk_s(float lo,float hi){f32x2_t v={lo,hi};bf16x2_t b=__builtin_convertvector(v,bf16x2_t);return __builtin_bit_cast(unsigned,b);}
#define WAIT_BAR(N) asm volatile("s_waitcnt vmcnt(" #N ") lgkmcnt(0)\n\ts_barrier":::"memory")

__device__ __forceinline__ void qkt(f32x16&p0,f32x16&p1,const char*Kslot,const bf16x8*qr,const f32x16&negm,int r32,int hi){
  const char*kb=Kslot+hi*1024+r32*16;
  #pragma unroll
  for(int d0=0;d0<4;++d0){
    const bf16x8 b0=*reinterpret_cast<const bf16x8*>(kb+d0*2048);
    const bf16x8 b1=*reinterpret_cast<const bf16x8*>(kb+d0*2048+512);
    if(d0==0){p0=__builtin_amdgcn_mfma_f32_32x32x16_bf16(b0,qr[0],negm,0,0,0);p1=__builtin_amdgcn_mfma_f32_32x32x16_bf16(b1,qr[0],negm,0,0,0);}
    else{p0=__builtin_amdgcn_mfma_f32_32x32x16_bf16(b0,qr[d0],p0,0,0,0);p1=__builtin_amdgcn_mfma_f32_32x32x16_bf16(b1,qr[d0],p1,0,0,0);}}
}
typedef __attribute__((address_space(3))) const char* lds_cptr;
typedef short v4i16_t __attribute__((ext_vector_type(4)));
__device__ __forceinline__ void kload8(bf16x8*kf,lds_cptr kp){
  kf[0]=*(const __attribute__((address_space(3))) bf16x8*)(kp);      kf[1]=*(const __attribute__((address_space(3))) bf16x8*)(kp+512);
  kf[2]=*(const __attribute__((address_space(3))) bf16x8*)(kp+2048); kf[3]=*(const __attribute__((address_space(3))) bf16x8*)(kp+2560);
  kf[4]=*(const __attribute__((address_space(3))) bf16x8*)(kp+4096); kf[5]=*(const __attribute__((address_space(3))) bf16x8*)(kp+4608);
  kf[6]=*(const __attribute__((address_space(3))) bf16x8*)(kp+6144); kf[7]=*(const __attribute__((address_space(3))) bf16x8*)(kp+6656);
}
__device__ __forceinline__ void kload2(bf16x8*kf,lds_cptr kp,int j){ kf[2*j]=*(const __attribute__((address_space(3))) bf16x8*)(kp+j*2048); kf[2*j+1]=*(const __attribute__((address_space(3))) bf16x8*)(kp+j*2048+512); }
__device__ __forceinline__ s16x4 vtr(lds_cptr p){ return __builtin_bit_cast(s16x4,__builtin_amdgcn_ds_read_tr16_b64_v4i16((__attribute__((address_space(3))) v4i16_t*)p)); }
__device__ __forceinline__ float rowmax(const f32x16&p0,const f32x16&p1){
  float a=max3f(p0[0],p0[1],p1[0]),b=max3f(p0[2],p0[3],p1[1]);a=max3f(a,p1[2],p1[3]);
  #pragma unroll
  for(int r=4;r<16;r+=4){a=max3f(a,p0[r],p0[r+1]);b=max3f(b,p0[r+2],p0[r+3]);a=max3f(a,p1[r],p1[r+1]);b=max3f(b,p1[r+2],p1[r+3]);}
  const float m=max2f(a,b);
  auto rr=__builtin_amdgcn_permlane32_swap(__float_as_uint(m),__float_as_uint(m),false,false);
  return max2f(__uint_as_float(rr[0]),__uint_as_float(rr[1]));
}
__device__ __forceinline__ void pv(f32x16*o,int vb,bf16x8 pa0,bf16x8 pa1,bf16x8 pa2,bf16x8 pa3){
  #pragma unroll
  for(int d0=0;d0<2;++d0){s16x4 lo[4],hi[4];
    #pragma unroll
    for(int ks=0;ks<4;++ks){
      asm volatile("ds_read_b64_tr_b16 %0,%1 offset:%c2":"=&v"(lo[ks]):"v"(vb),"i"(d0*4096+ks*1024):"memory");
      asm volatile("ds_read_b64_tr_b16 %0,%1 offset:%c2":"=&v"(hi[ks]):"v"(vb),"i"(d0*4096+ks*1024+512):"memory");}
    asm volatile("s_waitcnt lgkmcnt(0)":::"memory");SBAR();
    #define PK(k) (bf16x8){lo[k][0],lo[k][1],lo[k][2],lo[k][3],hi[k][0],hi[k][1],hi[k][2],hi[k][3]}
    o[d0]=__builtin_amdgcn_mfma_f32_32x32x16_bf16(pa0,PK(0),o[d0],0,0,0);
    o[d0]=__builtin_amdgcn_mfma_f32_32x32x16_bf16(pa1,PK(1),o[d0],0,0,0);
    o[d0]=__builtin_amdgcn_mfma_f32_32x32x16_bf16(pa2,PK(2),o[d0],0,0,0);
    o[d0]=__builtin_amdgcn_mfma_f32_32x32x16_bf16(pa3,PK(3),o[d0],0,0,0);
    #undef PK
  }
}

#ifndef ATTN_STORE16
#define ATTN_STORE16(p,v) (*(u32x4*)(p)=(v))
#endif
template<int THRL> __device__ __forceinline__ void attn_unit(int b,int qcol,int kcol,int vcol,int ocol,int qb,const bf16*__restrict__ P,bf16*O,char*shm){
  const int tid=threadIdx.x,lane=tid&63,r32=lane&31,hi=lane>>5; const int wid=__builtin_amdgcn_readfirstlane(tid>>6);
  const long rowbase=(long)b*SEQ; const int q0=qb*QB;
  const bf16*Qw=P+(rowbase+q0+wid*QBLK)*PQ+qcol;
  const bf16*Kh=P+rowbase*PQ+kcol,*Vh=P+rowbase*PQ+vcol;
  const unsigned lds0=(unsigned)(uintptr_t)shm;
  float*wsf=(float*)(shm+LDS_WS)+wid*64;
  const bf16*ksrc=Kh+(long)lane*PQ+wid*8;
  const bf16*vsrc=Vh+(long)(16*(wid&3)+(lane>>2))*PQ+(wid>>2)*32+(lane&3)*8;
  const unsigned kdst=lds0+LDS_K+wid*1024, vdst=lds0+LDS_V+wid*1024;
  #define DMA_K(t,slot) glds16(ksrc+(long)(t)*KVBLK*PQ,(unsigned)__builtin_amdgcn_readfirstlane(kdst+(slot)))
  #define DMA_V(t,slot) glds16(vsrc+(long)(t)*KVBLK*PQ,(unsigned)__builtin_amdgcn_readfirstlane(vdst+(slot)))
  const int vb0=(int)(lds0+LDS_V)+((lane>>4)&1)*32+(lane&3)*8+(4*hi+((lane&15)>>2))*64;
  const char*Kbase=shm+LDS_K; bf16x8 kf[8];
  const lds_cptr shm3=(lds_cptr)shm; const lds_cptr kp0=shm3+LDS_K+hi*1024+r32*16; const lds_cptr vp0=shm3+LDS_V+((lane>>4)&1)*32+(lane&3)*8+(4*hi+((lane&15)>>2))*64;
  const int NT=(q0+QB)/KVBLK;
  DMA_K(0,0);DMA_V(0,0);DMA_K(1,SLOTB);
  bf16x8 qr[4];
  #pragma unroll
  for(int d0=0;d0<4;++d0)qr[d0]=*reinterpret_cast<const bf16x8*>(&Qw[(long)r32*PQ+d0*16+hi*8]);
  float mhat=0.f,l_reg=0.f;f32x16 o[2];o[0]=f32x16{};o[1]=f32x16{};f32x16 negm=f32x16{};asm volatile("":"+v"(negm));
  const int qrel=wid*QBLK+r32;
  #define CMASK(P0,P1,t) do{int jb_=(t)-(NT-4); if(jb_>=0)cmask(P0,P1,jb_,qrel,hi);}while(0)
  bool resc=false;
  #define START(P0,P1) do{ const float rm=rowmax(P0,P1); resc=false; \
    { const float dl=rm; mhat=fadd_s(mhat,dl); \
      _Pragma("unroll") for(int r=0;r<16;++r){P0[r]=fsub_s(P0[r],dl);P1[r]=fsub_s(P1[r],dl);} \
      _Pragma("unroll") for(int r=0;r<16;++r)negm[r]=-mhat; asm volatile("":"+v"(negm)); } \
    _Pragma("unroll") for(int r=0;r<16;++r)P0[r]=__builtin_amdgcn_exp2f(P0[r]); }while(0)
  #define RESC() do{ if(resc){ asm volatile("s_waitcnt lgkmcnt(0)":::"memory"); \
      _Pragma("unroll") for(int d_=0;d_<2;++d_) _Pragma("unroll") for(int r=0;r<16;++r)o[d_][r]*=wsf[crow(r,hi)]; } }while(0)
  f32x16 pA0,pA1,pB0,pB1;
  int sl_prev=0,sl_cur=0,sl_next=SLOTB;
  #define ROT() do{sl_prev=sl_cur;sl_cur=sl_next;sl_next=(sl_next==(NSLOT-1)*SLOTB)?0:sl_next+SLOTB;}while(0)
  DMA_K(2,2*SLOTB);
  WAIT_BAR(3);
  qkt(pA0,pA1,Kbase,qr,negm,r32,hi);asm volatile("s_nop 15\n\ts_nop 7":"+v"(pA0),"+v"(pA1));CMASK(pA0,pA1,0);
  START(pA0,pA1);
  _Pragma("unroll") for(int r=0;r<16;++r)pA1[r]=__builtin_amdgcn_exp2f(pA1[r]);
  WAIT_BAR(0);
  DMA_K(3,0);DMA_V(1,SLOTB);
  ROT();
  kload8(kf,kp0+sl_cur);
  WAIT_BAR(2);
  s16x4 vlo[8],vhi[8]; u32x4 pw0,pw1,pw2,pw3;
  #define PKW(P,B) cvtpk_s(P[B],P[B+1])
  #define PAF(k) __builtin_bit_cast(bf16x8,pw##k)
  #define VFR(i) (bf16x8){vlo[i][0],vlo[i][1],vlo[i][2],vlo[i][3],vhi[i][0],vhi[i][1],vhi[i][2],vhi[i][3]}
  #define PIN(x) asm volatile("":"+v"(x))
  #define MX3(a,b,c) __builtin_fmaxf(__builtin_fmaxf((a),(b)),(c))
  #define GAPA(MF,A0,A1,A2,A3,W0,W1,PW) do{ MF; sacc+=A0; sacc+=A1; sacc+=A2; sacc+=A3; PIN(sacc); W0; W1; PIN(PW); SBAR(); }while(0)
  #define EX(v) __builtin_amdgcn_exp2f(v)
  #define GAPB(MF,X,B) do{ MF; X[B]=EX(X[B]); X[B+1]=EX(X[B+1]); X[B+2]=EX(X[B+2]); X[B+3]=EX(X[B+3]); PIN(X); SBAR(); }while(0)
  #define VRD(i) do{ vlo[i]=vtr(vp_+(((i)>>2)*4096+((i)&3)*1024)); vhi[i]=vtr(vp_+(((i)>>2)*4096+((i)&3)*1024+512)); }while(0)
  #define KRD(G,j) do{ if(G){ kload2(kf,kp0+sl_next,j); SBAR(); } }while(0)
  #define STEP(C0,C1,P0,P1,t,GK,GV,GL) do{ SBAR(); \
    const lds_cptr vp_=vp0+sl_prev; \
    VRD(0); SBAR(); float sacc=(P0[0]+P0[1]); \
    GAPA(C0=__builtin_amdgcn_mfma_f32_32x32x16_bf16(kf[0],qr[0],negm,0,0,0), P0[2],P0[3],P0[4],P0[5],     pw0[0]=PKW(P0,0), pw0[1]=PKW(P0,2), pw0); \
    VRD(4); SBAR(); GAPA(C1=__builtin_amdgcn_mfma_f32_32x32x16_bf16(kf[1],qr[0],negm,0,0,0), P0[6],P0[7],P0[8],P0[9],     pw0[2]=PKW(P0,4), pw0[3]=PKW(P0,6), pw0); \
    VRD(1); SBAR(); GAPA(C0=__builtin_amdgcn_mfma_f32_32x32x16_bf16(kf[2],qr[1],C0,0,0,0),   P0[10],P0[11],P0[12],P0[13], pw1[0]=PKW(P0,8), pw1[1]=PKW(P0,10), pw1); \
    VRD(5); SBAR(); GAPA(C1=__builtin_amdgcn_mfma_f32_32x32x16_bf16(kf[3],qr[1],C1,0,0,0),   P0[14],P0[15],P1[0],P1[1],   pw1[2]=PKW(P0,12),pw1[3]=PKW(P0,14), pw1); \
    VRD(2); SBAR(); GAPA(C0=__builtin_amdgcn_mfma_f32_32x32x16_bf16(kf[4],qr[2],C0,0,0,0),   P1[2],P1[3],P1[4],P1[5],     pw2[0]=PKW(P1,0), pw2[1]=PKW(P1,2), pw2); \
    VRD(6); SBAR(); GAPA(C1=__builtin_amdgcn_mfma_f32_32x32x16_bf16(kf[5],qr[2],C1,0,0,0),   P1[6],P1[7],P1[8],P1[9],     pw2[2]=PKW(P1,4), pw2[3]=PKW(P1,6), pw2); \
    VRD(3); SBAR(); GAPA(C0=__builtin_amdgcn_mfma_f32_32x32x16_bf16(kf[6],qr[3],C0,0,0,0),   P1[10],P1[11],P1[12],P1[13], pw3[0]=PKW(P1,8), pw3[1]=PKW(P1,10), pw3); \
    VRD(7); SBAR(); GAPA(C1=__builtin_amdgcn_mfma_f32_32x32x16_bf16(kf[7],qr[3],C1,0,0,0),   P1[14],P1[15],0.f,0.f,       pw3[2]=PKW(P1,12),pw3[3]=PKW(P1,14), pw3); \
    l_reg+=sacc; \
    if(GK){DMA_K((t)+3,sl_cur);} if(GV){DMA_V((t)+1,sl_next);} \
    CMASK(C0,C1,t); \
    { float a=MX3(C0[0],C0[1],C1[0]),b=MX3(C0[2],C0[3],C1[1]); a=MX3(a,C1[2],C1[3]); \
      _Pragma("unroll") for(int r=4;r<16;r+=4){a=MX3(a,C0[r],C0[r+1]);b=MX3(b,C0[r+2],C0[r+3]);a=MX3(a,C1[r],C1[r+1]);b=MX3(b,C1[r+2],C1[r+3]);} \
      float rm=__builtin_fmaxf(a,b); { auto rr=__builtin_amdgcn_permlane32_swap(__float_as_uint(rm),__float_as_uint(rm),false,false); rm=__builtin_fmaxf(__uint_as_float(rr[0]),__uint_as_float(rr[1])); } \
      resc=false; \
      if(__builtin_expect(__any(rm>(float)THRL),0)){ const float dl=__builtin_fmaxf(rm,0.f); mhat+=dl; \
        _Pragma("unroll") for(int r=0;r<16;++r){C0[r]-=dl;C1[r]-=dl;} \
        _Pragma("unroll") for(int r=0;r<16;++r)negm[r]=-mhat; asm volatile("":"+v"(negm)); \
        const float f=__builtin_amdgcn_exp2f(-dl); l_reg*=f; if(hi==0)wsf[r32]=f; resc=true; } } \
    SBAR(); \
    GAPB(o[0]=__builtin_amdgcn_mfma_f32_32x32x16_bf16(PAF(0),VFR(0),o[0],0,0,0), C0,0); \
    GAPB(o[1]=__builtin_amdgcn_mfma_f32_32x32x16_bf16(PAF(0),VFR(4),o[1],0,0,0), C0,4); \
    KRD(GL,0); GAPB(o[0]=__builtin_amdgcn_mfma_f32_32x32x16_bf16(PAF(1),VFR(1),o[0],0,0,0), C0,8); \
    KRD(GL,1); GAPB(o[1]=__builtin_amdgcn_mfma_f32_32x32x16_bf16(PAF(1),VFR(5),o[1],0,0,0), C0,12); \
    KRD(GL,2); GAPB(o[0]=__builtin_amdgcn_mfma_f32_32x32x16_bf16(PAF(2),VFR(2),o[0],0,0,0), C1,0); \
    KRD(GL,3); GAPB(o[1]=__builtin_amdgcn_mfma_f32_32x32x16_bf16(PAF(2),VFR(6),o[1],0,0,0), C1,4); \
    GAPB(o[0]=__builtin_amdgcn_mfma_f32_32x32x16_bf16(PAF(3),VFR(3),o[0],0,0,0), C1,8); \
    GAPB(o[1]=__builtin_amdgcn_mfma_f32_32x32x16_bf16(PAF(3),VFR(7),o[1],0,0,0), C1,12); \
    }while(0)
  int t=1;
  #undef CMASK
  #define CMASK(P0,P1,t) do{}while(0)
  for(;t+5<NT;t+=2){
    STEP(pB0,pB1,pA0,pA1,t,true,true,true);     WAIT_BAR(2); RESC(); ROT();
    STEP(pA0,pA1,pB0,pB1,t+1,true,true,true);   WAIT_BAR(2); RESC(); ROT();
  }
  #undef CMASK
  #define CMASK(P0,P1,t) do{int jb_=(t)-(NT-4); if(jb_>=0)cmask(P0,P1,jb_,qrel,hi);}while(0)
  #define ENDW(tt) do{ if((tt)+3<NT){WAIT_BAR(2);} else if((tt)+2<NT){WAIT_BAR(1);} else {WAIT_BAR(0);} }while(0)
  for(;t+1<NT;t+=2){
    STEP(pB0,pB1,pA0,pA1,t,(t+3<NT),(t+1<NT),(t+1<NT));       ENDW(t);   RESC(); ROT();
    STEP(pA0,pA1,pB0,pB1,t+1,(t+4<NT),(t+2<NT),(t+2<NT));     ENDW(t+1); RESC(); ROT();
  }
  STEP(pB0,pB1,pA0,pA1,NT-1,false,false,false); RESC();
  { float sacc=pB0[0]+pB0[1]; _Pragma("unroll") for(int r=2;r<16;++r)sacc+=pB0[r]; _Pragma("unroll") for(int r=0;r<16;++r)sacc+=pB1[r]; l_reg+=sacc;
    pw0=(u32x4){PKW(pB0,0),PKW(pB0,2),PKW(pB0,4),PKW(pB0,6)};pw1=(u32x4){PKW(pB0,8),PKW(pB0,10),PKW(pB0,12),PKW(pB0,14)};pw2=(u32x4){PKW(pB1,0),PKW(pB1,2),PKW(pB1,4),PKW(pB1,6)};pw3=(u32x4){PKW(pB1,8),PKW(pB1,10),PKW(pB1,12),PKW(pB1,14)};
    SBAR(); pv(o,vb0+sl_cur,PAF(0),PAF(1),PAF(2),PAF(3)); }
  #undef PKW
  #undef PAF
  #undef VFR
  #undef PIN
  #undef MX3
  #undef GAPA
  #undef GAPB
  #undef EX
  #undef VRD
  #undef KRD
  #undef STEP
  #undef ENDW
  {auto rr=__builtin_amdgcn_permlane32_swap(__float_as_uint(l_reg),__float_as_uint(l_reg),false,false);l_reg=__uint_as_float(rr[0])+__uint_as_float(rr[1]);}
  if(hi==0)wsf[32+r32]=l_reg;asm volatile("s_waitcnt lgkmcnt(0)":::"memory");
  float rli[16];
  #pragma unroll
  for(int r=0;r<16;++r)rli[r]=__builtin_amdgcn_rcpf(wsf[32+crow(r,hi)]);
  bf16*Ow=O+(rowbase+q0+wid*QBLK)*PO+ocol;
  { bf16*stg=(bf16*)(shm+LDS_OST)+wid*2048;
    #pragma unroll
    for(int r=0;r<16;++r){const int orow=crow(r,hi);
      #pragma unroll
      for(int d0=0;d0<2;++d0)stg[orow*64+d0*32+r32]=__float2bfloat16(o[d0][r]*rli[r]);}
    asm volatile("s_waitcnt lgkmcnt(0)":::"memory");
    #pragma unroll
    for(int i=0;i<4;++i){const int row=i*8+(lane>>3),ch=lane&7; const u32x4 v=*(const u32x4*)(stg+row*64+ch*8); ATTN_STORE16(Ow+(long)row*PO+ch*8,v);} }
  asm volatile("s_waitcnt lgkmcnt(0)\n\ts_barrier":::"memory");
  #undef DMA_K
  #undef DMA_V
  #undef CMASK
  #undef START
  #undef RESC
  #undef ROT
}
constexpr int ATTN_LDS_BYTES=LDS_BYTES;
struct AttnTensors { const bf16* P; bf16* O; };
struct AttnUnit { int bh; int qb; };
struct StaticOrder {
  int vcu;
  __device__ __forceinline__ explicit StaticOrder(int grid,int block):vcu((block%8)*(grid/8)+block/8){}
  __device__ __forceinline__ bool next(int i,AttnUnit&u)const{ if(i>=8)return false; const int s=4*(vcu&1)+(i>>1); u.bh=vcu>>1; u.qb=(i&1)?15-s:s; return true; }
  __device__ __forceinline__ void a_ready(const AttnUnit&)const{}
  __device__ __forceinline__ void done(const AttnUnit&)const{}
};
template<class Sched,int THRL=8> __device__ __forceinline__ void attn_phase(char*lds,const AttnTensors&T,const Sched&S){
  AttnUnit u;
  for(int i=0;S.next(i,u);++i){ S.a_ready(u);
    const int vh=u.bh&1, mp=(u.bh>>1)&1, h=(u.bh>>2)&3, b=u.bh>>4, hm=h*2+mp;
    attn_unit<THRL>(b, 1536+hm*64, 2048+hm*64, 2560+h*128+vh*64, hm*128+vh*64, u.qb, T.P, T.O, lds); S.done(u); }
}
#undef SBAR
#undef WAIT_BAR
}


constexpr int NWAVES = 8;
constexpr int RING_BYTES = 131072;
constexpr int LDSCTL_OFF = RING_BYTES, MISC_OFF = LDSCTL_OFF + 320;
constexpr int LDS_BYTES = 147456;
constexpr int CW_BAR = 4096;
constexpr size_t CTL_ZERO_BYTES = 64 * 1024;
#define GAS __attribute__((address_space(1)))
#define LAS __attribute__((address_space(3)))
typedef unsigned short bf16;
typedef unsigned v4u __attribute__((ext_vector_type(4)));
typedef float f32x4 __attribute__((ext_vector_type(4)));
typedef short bf16x8 __attribute__((ext_vector_type(8)));
typedef GAS unsigned gu32;
typedef GAS unsigned long long gu64;
#define RLX_AGENT __ATOMIC_RELAXED, __HIP_MEMORY_SCOPE_AGENT
#define LDS_WAIT() asm volatile("s_waitcnt lgkmcnt(0)" ::: "memory")
#define VM_WAIT() asm volatile("s_waitcnt vmcnt(0)" ::: "memory")
__device__ __forceinline__ unsigned long long rt() { return __builtin_amdgcn_s_memrealtime(); }
__device__ __forceinline__ unsigned pk2(float lo, float hi) { return (unsigned)f2bf(lo) | ((unsigned)f2bf(hi) << 16); }

#define XB_TMO      128
#define XB_XCNT(j)  (256  + 64 * (j))
#define XB_XSUB(j)  (1280 + 64 * (j))
#define XB_XGEN(j)  (2304 + 64 * (j))
#define XB_TOP      3328
#define XB_TOPGEN   3392
#define XCD_BAR_WORDS 3456
#define XB_SPIN_CAP (1u << 18)

__device__ __forceinline__ unsigned xb_ld(unsigned* p)              { return __hip_atomic_load(p, __ATOMIC_RELAXED, __HIP_MEMORY_SCOPE_AGENT); }
__device__ __forceinline__ unsigned xb_add(unsigned* p, unsigned v) { return __hip_atomic_fetch_add(p, v, __ATOMIC_RELAXED, __HIP_MEMORY_SCOPE_AGENT); }
__device__ __forceinline__ unsigned xb_xcc_id() { return (unsigned)__builtin_amdgcn_s_getreg((3 << 11) | 20) & 0xFu; }
#define XB_SPIN(cond, bar) do { unsigned _sp = 0; while (cond) { __builtin_amdgcn_s_sleep(1); \
    if ((++_sp & 255u) == 0u) { if (xb_ld(&(bar)[XB_TMO])) break; if (_sp > XB_SPIN_CAP) { atomicAdd(&(bar)[XB_TMO], 1u); break; } } } } while (0)

struct XcdBarrier {
    unsigned* bar; unsigned x;
    volatile LAS unsigned* st;
};

__device__ __forceinline__ XcdBarrier xcd_barrier_post(unsigned* bar, volatile LAS unsigned* st) {
    XcdBarrier b; b.bar = bar; b.x = xb_xcc_id(); b.st = st;
    if (threadIdx.x == 0) (void)xb_add(&bar[XB_XCNT(b.x)], 1u);
    return b;
}
__device__ __forceinline__ void xcd_barrier_complete(unsigned* bar, unsigned x, unsigned& nloc, unsigned& nx) {
    const unsigned G = gridDim.x * gridDim.y * gridDim.z;
    unsigned sum, cnt, mine, sp = 0u;
    for (;;) {
        sum = 0u; cnt = 0u; mine = 0u;
#pragma unroll
        for (unsigned j = 0; j < 16; ++j) { const unsigned c = xb_ld(&bar[XB_XCNT(j)]); sum += c; cnt += (c > 0u) ? 1u : 0u; mine = (j == x) ? c : mine; }
        if (sum == G) break;
        __builtin_amdgcn_s_sleep(1);
        if ((++sp & 255u) == 0u) { if (xb_ld(&bar[XB_TMO])) break; if (sp > XB_SPIN_CAP) { atomicAdd(&bar[XB_TMO], 1u); break; } }
    }
    nloc = mine > 0u ? mine : 1u; nx = cnt > 0u ? cnt : 1u;
}

__device__ __forceinline__ void xcd_barrier(const XcdBarrier& b) {
    asm volatile("s_waitcnt vmcnt(0)" ::: "memory");
    __syncthreads();
    if (threadIdx.x == 0) {
        unsigned* bar = b.bar;
        __builtin_amdgcn_s_waitcnt(0);
        unsigned nloc = b.st[0], nx = b.st[1];
        if (nloc == 0u) { xcd_barrier_complete(bar, b.x, nloc, nx); b.st[0] = nloc; b.st[1] = nx; }
        const unsigned old = xb_add(&bar[XB_XSUB(b.x)], 1u);
        const unsigned gen = old / nloc;
        if (old + 1u == (gen + 1u) * nloc) {
            __builtin_amdgcn_fence(__ATOMIC_RELEASE, "agent");
            asm volatile("s_waitcnt vmcnt(0)" ::: "memory");
            const unsigned og = xb_add(&bar[XB_TOP], 1u);
            const unsigned tg = og / nx;
            if (og + 1u == (tg + 1u) * nx) xb_add(&bar[XB_TOPGEN], 1u);
            else XB_SPIN(xb_ld(&bar[XB_TOPGEN]) == tg, bar);
            __builtin_amdgcn_fence(__ATOMIC_ACQUIRE, "agent");
            xb_add(&bar[XB_XGEN(b.x)], 1u);
            asm volatile("s_waitcnt vmcnt(0)" ::: "memory");
        } else {
            XB_SPIN(xb_ld(&bar[XB_XGEN(b.x)]) == gen, bar);
            __builtin_amdgcn_fence(__ATOMIC_ACQUIRE, "agent");
            asm volatile("s_waitcnt vmcnt(0)" ::: "memory");
        }
    }
    __syncthreads();
}

#ifndef PHMASK
#define PHMASK 0xffff
#endif
struct Args { const void* in[20]; float* out; unsigned char* ws; int ph_lo, ph_hi; };
enum Phase { PH_INPROJ = 1, PH_ATTN = 2, PH_OUTPROJ = 5, PH_CQ = 6, PH_CO = 7, PH_END = 9 };

__global__ void __launch_bounds__(NWAVES * 64, 2) mk_fwd(Args args) {
    extern __shared__ __attribute__((aligned(16))) unsigned char lds[];
    LAS unsigned char* L = (LAS unsigned char*)lds;
    const int tid = threadIdx.x;
    unsigned char* ws = args.ws;
    for (int u = tid; u < (LDS_BYTES - LDSCTL_OFF) / 4; u += NWAVES * 64) ((LAS unsigned*)(L + LDSCTL_OFF))[u] = 0u;
    __syncthreads();
    const int G = gridDim.x;
    XcdBarrier bar = xcd_barrier_post((unsigned*)(ws + WS_CTL) + CW_BAR, (volatile LAS unsigned*)(L + MISC_OFF) + 8);
#define WSP(T_, off) ((T_*)(ws + (off)))
    const int lo = args.ph_lo, hi = args.ph_hi;
#define IN(k) (lo <= (k) && (k) < hi && ((PHMASK >> (k)) & 1))
#define SEAM(k) do { if ((k) + 1 < hi) xcd_barrier(bar); } while (0)
    if (IN(PH_INPROJ)) {
        { pg8::Gemm g{WSP(bf16_t, WS_XN), WSP(bf16_t, WS_WIN), T, NP, D}; pg8::StaticOrder S; S.init(T, NP, G, (int)blockIdx.x);
          pg8::EpiInProj E{WSP(bf16_t, WS_PROJ), WSP(float, WS_GA), WSP(float, WS_ROPE), WSP(float, WS_ROPE) + T * 8};
          pg8::gemm_phase<pg8::EpiInProj, pg8::StaticOrder, true, true>(L, g, S, E); }
#ifndef NO_KVM
        { pg8::Gemm g{WSP(bf16_t, WS_MEMN), WSP(bf16_t, WS_WCKV), TM, 2 * D, D}; pg8::StaticOrder S; S.init(TM, 2 * D, G, (int)blockIdx.x);
          pg8::EpiBf16<0> E{WSP(bf16_t, WS_KVM), 2 * D, nullptr, 0, 0, 1.f};
          pg8::gemm_phase<pg8::EpiBf16<0>, pg8::StaticOrder, true, true>(L, g, S, E); }
#endif
        SEAM(PH_INPROJ);
    }
    if (IN(PH_ATTN)) {
        const attn_body::AttnTensors AT{WSP(const attn_body::bf16, WS_PROJ), WSP(attn_body::bf16, WS_OD)};
        const attn_body::StaticOrder S(G, (int)blockIdx.x);
        attn_body::attn_phase<attn_body::StaticOrder>((char*)lds, AT, S);
        SEAM(PH_ATTN);
    }
    if (IN(PH_OUTPROJ)) {
        pg8::Gemm g{WSP(bf16_t, WS_MIXED), WSP(bf16_t, WS_WOUT), T, D, D}; pg8::StaticOrder S; S.init(T, D, G, (int)blockIdx.x);
        pg8::EpiOutProj E{(const float*)args.in[0], args.out, WSP(bf16_t, WS_X1B), WSP(float, WS_MISC)};
        pg8::gemm_phase<pg8::EpiOutProj, pg8::StaticOrder, true, true>(L, g, S, E);
        SEAM(PH_OUTPROJ);
    }
    if (IN(PH_CQ)) {
        pg8::Gemm g{WSP(bf16_t, WS_X1B), WSP(bf16_t, WS_WCQ), T, D, D}; pg8::StaticOrder S; S.init(T, D, G, (int)blockIdx.x);
        pg8::EpiCq E{WSP(bf16_t, WS_QC), WSP(float, WS_MISC)};
        pg8::gemm_phase<pg8::EpiCq, pg8::StaticOrder, true, true>(L, g, S, E);
        SEAM(PH_CQ);
    }
    if (IN(PH_CO)) {
        pg8::Gemm g{WSP(bf16_t, WS_OC), WSP(bf16_t, WS_WCO), T, D, D}; pg8::StaticOrder S; S.init(T, D, G, (int)blockIdx.x);
        pg8::EpiCo E{args.out, WSP(float, WS_MISC) + T};
        pg8::gemm_phase<pg8::EpiCo, pg8::StaticOrder, true, true>(L, g, S, E);
        SEAM(PH_CO);
    }
#undef IN
#undef SEAM
}

extern "C" void kernel_launch(void* const* d_in, const int* in_sizes, int n_in, void* d_out, int out_size, void* d_ws, size_t ws_size, hipStream_t stream) {
    if (n_in != 20 || in_sizes[0] != T * D || out_size != T * D || ws_size < WS_END) { fprintf(stderr, "kernel_launch: unexpected shapes / workspace (%d inputs, ws %zu)\n", n_in, ws_size); return; }
    const float* x = (const float*)d_in[0]; const float* mem = (const float*)d_in[1]; const int* pos = (const int*)d_in[2];
    const float* norm_mix_w = (const float*)d_in[3]; const float* w_in = (const float*)d_in[4]; const float* w_alpha2 = (const float*)d_in[5];
    const float* b_alpha2 = (const float*)d_in[6]; const float* gla_norm_w = (const float*)d_in[7];
    const float* lq1 = (const float*)d_in[8]; const float* lk1 = (const float*)d_in[9]; const float* lq2 = (const float*)d_in[10]; const float* lk2 = (const float*)d_in[11];
    const float* diff_norm_w = (const float*)d_in[12]; const float* w_out = (const float*)d_in[13]; const float* norm_cross_w = (const float*)d_in[14];
    const float* norm_mem_w = (const float*)d_in[15]; const float* w_cq = (const float*)d_in[16]; const float* w_ckv = (const float*)d_in[17];
    const float* w_co = (const float*)d_in[18]; const float* final_norm_w = (const float*)d_in[19];
    float* out = (float*)d_out; unsigned char* ws = (unsigned char*)d_ws;
    bf16_t* WIN = (bf16_t*)(ws + WS_WIN); bf16_t* WOUT = (bf16_t*)(ws + WS_WOUT); bf16_t* WCQ = (bf16_t*)(ws + WS_WCQ); bf16_t* WCO = (bf16_t*)(ws + WS_WCO); bf16_t* WCKV = (bf16_t*)(ws + WS_WCKV);
    bf16_t* MEMN = (bf16_t*)(ws + WS_MEMN); bf16_t* KVM = (bf16_t*)(ws + WS_KVM); float* GA = (float*)(ws + WS_GA);
    float* CS = (float*)(ws + WS_ROPE); float* SN = CS + T * 8; float* RSS = (float*)(ws + WS_MISC); float* RSS2 = RSS + T; float* LAM = RSS + 2 * T;
    bf16_t* XN = (bf16_t*)(ws + WS_XN); bf16_t* MIXED = (bf16_t*)(ws + WS_MIXED); bf16_t* PROJ = (bf16_t*)(ws + WS_PROJ);
    bf16_t* X1B = (bf16_t*)(ws + WS_X1B); bf16_t* QC = (bf16_t*)(ws + WS_QC); bf16_t* OC = (bf16_t*)(ws + WS_OC); bf16_t* OD = (bf16_t*)(ws + WS_OD);
    float* GO = (float*)(ws + WS_KVC); float* G = (float*)(ws + WS_ST);

    auto nb = [](size_t n, int b) { return (unsigned)((n + b - 1) / b); };
    static int grid = 0;
    if (grid == 0) {
        int dev = 0, cus = 0;
        if (hipGetDevice(&dev) != hipSuccess || hipDeviceGetAttribute(&cus, hipDeviceAttributeMultiprocessorCount, dev) != hipSuccess) { fprintf(stderr, "kernel_launch: device query failed\n"); grid = -1; return; }
        if (hipFuncSetAttribute((const void*)mk_fwd, hipFuncAttributeMaxDynamicSharedMemorySize, LDS_BYTES) != hipSuccess) { fprintf(stderr, "kernel_launch: hipFuncSetAttribute failed\n"); grid = -1; return; }
        grid = cus;
        if (grid != 256) fprintf(stderr, "kernel_launch: %d CUs (expected 256)\n", grid);
    }
    if (grid < 0) return;
    (void)hipMemsetAsync((char*)d_ws + WS_CTL, 0, CTL_ZERO_BYTES, stream);
    Args a{};
    for (int i = 0; i < 20; ++i) a.in[i] = d_in[i];
    a.out = out; a.ws = ws;
#define MK(p) do { a.ph_lo = (p); a.ph_hi = (p) + 1; hipLaunchKernelGGL(mk_fwd, dim3(grid), dim3(NWAVES * 64), LDS_BYTES, stream, a); } while (0)
    k_prep_w<<<nb((size_t)NP * D, 256), 256, 0, stream>>>(w_in, D, D_IN, WIN, NP, nullptr, 1);
    k_prep_w<<<nb((size_t)D * D, 256), 256, 0, stream>>>(w_out, D, D, WOUT, D, nullptr, 0);
    k_prep_w<<<nb((size_t)D * D, 256), 256, 0, stream>>>(w_cq, D, D, WCQ, D, norm_cross_w, 0);
    k_prep_w<<<nb((size_t)D * D, 256), 256, 0, stream>>>(w_co, D, D, WCO, D, nullptr, 0);
    k_prep_w<<<nb((size_t)2 * D * D, 256), 256, 0, stream>>>(w_ckv, D, 2 * D, WCKV, 2 * D, nullptr, 0);
    k_rmsnorm_rows<<<T / 4, 256, 0, stream>>>(x, norm_mix_w, XN, T);
    k_rmsnorm_rows<<<TM / 4, 256, 0, stream>>>(mem, norm_mem_w, MEMN, TM);
    k_rope_tab<<<nb((size_t)T * 8, 256), 256, 0, stream>>>(pos, CS, SN, LAM, lq1, lk1, lq2, lk2, RSS);
    MK(PH_INPROJ);
    k_gla_gate<<<nb((size_t)T * 256, 256), 256, 0, stream>>>(GA, w_alpha2, b_alpha2, G);
    k_gla_rec<<<BATCH * 4, 128, 0, stream>>>(PROJ, G, GO);
    k_gla_out<<<T * 4 / 4, 256, 0, stream>>>(GO, PROJ, gla_norm_w, MIXED);
    MK(PH_ATTN);
    k_diff_out<<<T * 4 / 4, 256, 0, stream>>>(OD, PROJ, diff_norm_w, LAM, MIXED);
    MK(PH_OUTPROJ);
    MK(PH_CQ);
    k_cross_attn<<<(T / 16) * 4, 256, 0, stream>>>(QC, KVM, OC);
    MK(PH_CO);
    k_final_norm<<<T / 4, 256, 0, stream>>>(out, RSS2, final_norm_w);
}
```

```cpp
#include <hip/hip_runtime.h>
#include <cstdio>
#include <cstdint>

typedef unsigned short bf16_t;
typedef short bf16x8 __attribute__((ext_vector_type(8)));
typedef float f32x4 __attribute__((ext_vector_type(4)));

constexpr int BATCH = 8, SEQ = 4096, D = 1024, T = BATCH * SEQ;
constexpr int MEM_LEN = 256, TM = BATCH * MEM_LEN;
constexpr int D_IN = 3600, NP = 3840, PP = 3584;
constexpr float EPS = 1e-6f;
constexpr int C_GQ = 0, C_GK = 256, C_GV = 512, C_GG = 1024, C_DQ = 1536, C_DK = 2048, C_DV = 2560, C_DG = 3072, C_GA = 3584;

constexpr size_t MiB = 1u << 20;
constexpr size_t WS_CTL = 0;
constexpr size_t WS_WIN = 1 * MiB;
constexpr size_t WS_WOUT = 9 * MiB;
constexpr size_t WS_WCQ = 11 * MiB;
constexpr size_t WS_WCO = 13 * MiB;
constexpr size_t WS_WCKV = 15 * MiB;
constexpr size_t WS_MEMN = 20 * MiB;
constexpr size_t WS_KVM = 24 * MiB;
constexpr size_t WS_GA = 32 * MiB;
constexpr size_t WS_ROPE = 34 * MiB;
constexpr size_t WS_MISC = 36 * MiB;
constexpr size_t WS_XN = 40 * MiB;
constexpr size_t WS_MIXED = WS_XN;
constexpr size_t WS_PROJ = 104 * MiB;
constexpr size_t WS_X1B = WS_PROJ, WS_QC = WS_PROJ + 64 * MiB, WS_OC = WS_PROJ + 128 * MiB;
constexpr size_t WS_OD = 328 * MiB;
constexpr size_t WS_KVC = 392 * MiB;
constexpr size_t WS_ST = 456 * MiB;
constexpr size_t WS_END = 488 * MiB;

__device__ __forceinline__ bf16_t f2bf(float f) { unsigned u = __float_as_uint(f); return (bf16_t)((u + 0x7fffu + ((u >> 16) & 1u)) >> 16); }
__device__ __forceinline__ float bf2f(bf16_t h) { return __uint_as_float(((unsigned)h) << 16); }
__device__ __forceinline__ float wave_sum(float v) {
#pragma unroll
    for (int o = 1; o < 64; o <<= 1) v += __shfl_xor(v, o);
    return v;
}
__device__ __forceinline__ float silu(float x) { return x / (1.f + __expf(-x)); }

__device__ __forceinline__ int win_src_col(int n) { return n < 1536 ? n : (n < 3584 ? n + 16 : (n < 3600 ? n - 3584 + 1536 : -1)); }
__global__ void k_prep_w(const float* __restrict__ W, int K, int Nsrc, bf16_t* __restrict__ Wt, int Nout, const float* __restrict__ kscale, int mode) {
    const size_t i = (size_t)blockIdx.x * blockDim.x + threadIdx.x;
    if (i >= (size_t)Nout * K) return;
    const int n = (int)(i / K), k = (int)(i % K);
    const int c = mode == 1 ? win_src_col(n) : n;
    float v = 0.f;
    if (c >= 0) { v = W[(size_t)k * Nsrc + c]; if (kscale) v *= kscale[k]; }
    Wt[i] = f2bf(v);
}
__global__ void k_rmsnorm_rows(const float* __restrict__ x, const float* __restrict__ w, bf16_t* __restrict__ out, int rows) {
    const int row = blockIdx.x * (blockDim.x / 64) + (threadIdx.x >> 6), lane = threadIdx.x & 63;
    if (row >= rows) return;
    const f32x4* xr = (const f32x4*)(x + (size_t)row * D);
    f32x4 v[4]; float s = 0.f;
#pragma unroll
    for (int j = 0; j < 4; ++j) { v[j] = xr[lane + 64 * j]; s += v[j].x * v[j].x + v[j].y * v[j].y + v[j].z * v[j].z + v[j].w * v[j].w; }
    const float r = rsqrtf(wave_sum(s) * (1.f / D) + EPS);
#pragma unroll
    for (int j = 0; j < 4; ++j) {
        const f32x4 ww = ((const f32x4*)w)[lane + 64 * j];
        bf16_t* o = out + (size_t)row * D + 4 * (lane + 64 * j);
        o[0] = f2bf(v[j].x * r * ww.x); o[1] = f2bf(v[j].y * r * ww.y); o[2] = f2bf(v[j].z * r * ww.z); o[3] = f2bf(v[j].w * r * ww.w);
    }
}
__device__ __forceinline__ void sincos_d(double a, float& c, float& s) {
    const double q = rint(a * 0.63661977236758134308);
    double r = fma(-q, 1.5707963267948966, a); r = fma(-q, 6.123233995736766e-17, r);
    const double r2 = r * r;
    double sp = r * (1.0 + r2 * (-1.0 / 6 + r2 * (1.0 / 120 + r2 * (-1.0 / 5040 + r2 * (1.0 / 362880 + r2 * (-1.0 / 39916800 + r2 * (1.0 / 6227020800.0)))))));
    double cp = 1.0 + r2 * (-0.5 + r2 * (1.0 / 24 + r2 * (-1.0 / 720 + r2 * (1.0 / 40320 + r2 * (-1.0 / 3628800 + r2 * (1.0 / 479001600.0 + r2 * (-1.0 / 87178291200.0)))))));
    const int qi = ((int)(long long)q) & 3;
    double cc = (qi == 0) ? cp : (qi == 1) ? -sp : (qi == 2) ? -cp : sp;
    double ss = (qi == 0) ? sp : (qi == 1) ? cp : (qi == 2) ? -sp : -cp;
    c = (float)cc; s = (float)ss;
}
__global__ void k_rope_tab(const int* __restrict__ pos, float* __restrict__ cs, float* __restrict__ sn, float* __restrict__ lam,
                           const float* q1, const float* k1, const float* q2, const float* k2, float* rss) {
    const int i = blockIdx.x * blockDim.x + threadIdx.x;
    if (i < T * 8) {
        const int t = i >> 3, j = i & 7;
        const double invf[8] = {1.0, 0.19392274474868576, 0.03760603093086393, 0.007292664737217109, 0.001414213562373095, 0.0002742481756762073, 5.318295896944988e-05, 1.031338537721246e-05};
        double f = invf[0];
#pragma unroll
        for (int u = 1; u < 8; ++u) f = (j == u) ? invf[u] : f;
        float c, s; sincos_d((double)pos[t] * f, c, s);
        cs[i] = c; sn[i] = s;
    }
    if (i < 2 * T) rss[i] = 0.f;
    if (i == 0) {
        float a = 0.f, b = 0.f;
        for (int u = 0; u < 64; ++u) { a += q1[u] * k1[u]; b += q2[u] * k2[u]; }
        lam[0] = expf(a) - expf(b) + 0.2f;
    }
}

template <class Epi>
__global__ void __launch_bounds__(256) k_gemm(const bf16_t* __restrict__ A, const bf16_t* __restrict__ Bt, int M, int N, int K, Epi epi) {
    const int lane = threadIdx.x & 63, wid = threadIdx.x >> 6, wr = wid >> 1, wc = wid & 1;
    const int m0 = blockIdx.y * 64 + wr * 32, n0 = blockIdx.x * 64 + wc * 32;
    const int fr = lane & 15, fq = lane >> 4;
    f32x4 acc[2][2];
#pragma unroll
    for (int i = 0; i < 2; ++i)
#pragma unroll
        for (int j = 0; j < 2; ++j) acc[i][j] = (f32x4){0.f, 0.f, 0.f, 0.f};
    const bf16_t* ap = A + (size_t)(m0 + fr) * K + 8 * fq;
    const bf16_t* bp = Bt + (size_t)(n0 + fr) * K + 8 * fq;
    for (int k0 = 0; k0 < K; k0 += 32) {
        bf16x8 a[2], b[2];
#pragma unroll
        for (int i = 0; i < 2; ++i) { a[i] = *(const bf16x8*)(ap + (size_t)i * 16 * K + k0); b[i] = *(const bf16x8*)(bp + (size_t)i * 16 * K + k0); }
#pragma unroll
        for (int i = 0; i < 2; ++i)
#pragma unroll
            for (int j = 0; j < 2; ++j) acc[i][j] = __builtin_amdgcn_mfma_f32_16x16x32_bf16(a[i], b[j], acc[i][j], 0, 0, 0);
    }
#pragma unroll
    for (int i = 0; i < 2; ++i)
#pragma unroll
        for (int j = 0; j < 2; ++j)
#pragma unroll
            for (int r = 0; r < 4; ++r) epi(m0 + i * 16 + fq * 4 + r, n0 + j * 16 + fr, acc[i][j][r]);
}
struct EpiInProj { bf16_t* proj; float* ga;
    __device__ __forceinline__ void operator()(int m, int n, float v) const { if (n < PP) proj[(size_t)m * PP + n] = f2bf(v); else if (n < PP + 16) ga[m * 16 + n - PP] = v; } };
struct EpiBf16Plain { bf16_t* o; int ld;
    __device__ __forceinline__ void operator()(int m, int n, float v) const { o[(size_t)m * ld + n] = f2bf(v); } };
struct EpiOutProj { const float* x; float* x1; bf16_t* x1b; float* rss;
    __device__ __forceinline__ void operator()(int m, int n, float v) const { const size_t i = (size_t)m * D + n; const float y = x[i] + v; x1[i] = y; x1b[i] = f2bf(y); atomicAdd(rss + m, y * y); } };
struct EpiCq { bf16_t* qc; const float* rss;
    __device__ __forceinline__ void operator()(int m, int n, float v) const { qc[(size_t)m * D + n] = f2bf(v * rsqrtf(rss[m] * (1.f / D) + EPS) * (0.0625f * 1.4426950408889634f)); } };
struct EpiCo { float* x12; float* rss2;
    __device__ __forceinline__ void operator()(int m, int n, float v) const { const size_t i = (size_t)m * D + n; const float y = x12[i] + v; x12[i] = y; atomicAdd(rss2 + m, y * y); } };

__global__ void k_rope(bf16_t* __restrict__ proj, const float* __restrict__ cs, const float* __restrict__ sn) {
    const int i = blockIdx.x * blockDim.x + threadIdx.x;
    if (i >= T * 128) return;
    const int j = i & 7, hm = (i >> 3) & 7, wh = (i >> 6) & 1, t = i >> 7;
    bf16_t* b = proj + (size_t)t * PP + (wh ? C_DK : C_DQ) + hm * 64;
    const float r1 = bf2f(b[j]), r2 = bf2f(b[j + 8]), c = cs[t * 8 + j], s = sn[t * 8 + j];
    b[j] = f2bf(r1 * c - r2 * s); b[j + 8] = f2bf(r2 * c + r1 * s);
}

__global__ void k_gla_gate(const float* __restrict__ ga, const float* __restrict__ w2, const float* __restrict__ b2, float* __restrict__ G) {
    const int i = blockIdx.x * blockDim.x + threadIdx.x;
    if (i >= T * 256) return;
    const int c = i & 255, t = i >> 8;
    float z = b2[c];
#pragma unroll
    for (int r = 0; r < 16; ++r) z += ga[t * 16 + r] * w2[r * 256 + c];
    const float ls = fminf(z, 0.f) - log1pf(expf(-fabsf(z)));
    G[i] = ls * (1.f / 16.f);
}
__global__ void __launch_bounds__(128) k_gla_rec(const bf16_t* __restrict__ proj, const float* __restrict__ G, float* __restrict__ GO) {
    const int e = threadIdx.x, h = blockIdx.x & 3, b = blockIdx.x >> 2;
    float S[64];
#pragma unroll
    for (int c = 0; c < 64; ++c) S[c] = 0.f;
    for (int s = 0; s < SEQ; ++s) {
        const size_t t = (size_t)b * SEQ + s;
        const bf16x8* q8 = (const bf16x8*)(proj + t * PP + C_GQ + h * 64);
        const bf16x8* k8 = (const bf16x8*)(proj + t * PP + C_GK + h * 64);
        const float v = bf2f(proj[t * PP + C_GV + h * 128 + e]);
        const f32x4* g4 = (const f32x4*)(G + t * 256 + h * 64);
        float o = 0.f;
#pragma unroll
        for (int c8 = 0; c8 < 8; ++c8) {
            const bf16x8 qq = q8[c8], kk = k8[c8]; const f32x4 ga = g4[2 * c8], gb = g4[2 * c8 + 1];
#pragma unroll
            for (int j = 0; j < 8; ++j) { const int c = c8 * 8 + j; const float g = j < 4 ? ga[j] : gb[j - 4];
                S[c] = __expf(g) * S[c] + bf2f((bf16_t)kk[j]) * v; o += bf2f((bf16_t)qq[j]) * S[c]; }
        }
        GO[t * 512 + h * 128 + e] = o * 0.125f;
    }
}
__global__ void k_gla_out(const float* __restrict__ GO, const bf16_t* __restrict__ proj, const float* __restrict__ w, bf16_t* __restrict__ mixed) {
    const int gw = blockIdx.x * (blockDim.x / 64) + (threadIdx.x >> 6), lane = threadIdx.x & 63;
    if (gw >= T * 4) return;
    const int h = gw & 3; const size_t t = gw >> 2;
    const float o0 = GO[t * 512 + h * 128 + lane], o1 = GO[t * 512 + h * 128 + 64 + lane];
    const float r = rsqrtf(wave_sum(o0 * o0 + o1 * o1) * (1.f / 128) + EPS);
    const float g0 = bf2f(proj[t * PP + C_GG + h * 128 + lane]), g1 = bf2f(proj[t * PP + C_GG + h * 128 + 64 + lane]);
    mixed[t * D + h * 128 + lane] = f2bf(o0 * r * w[lane] * silu(g0));
    mixed[t * D + h * 128 + 64 + lane] = f2bf(o1 * r * w[64 + lane] * silu(g1));
}

__global__ void __launch_bounds__(256) k_diff_attn(const bf16_t* __restrict__ proj, bf16_t* __restrict__ od) {
    const int tid = threadIdx.x, qtr = tid & 3, rl = tid >> 2;
    const int hm = blockIdx.x & 7, chunk = (blockIdx.x >> 3) & 63, b = blockIdx.x >> 9;
    const int h = hm >> 1;
    const size_t t = (size_t)b * SEQ + chunk * 64 + rl;
    float q[64];
    { const bf16x8* qp = (const bf16x8*)(proj + t * PP + C_DQ + hm * 64);
#pragma unroll
      for (int c = 0; c < 8; ++c) { const bf16x8 qq = qp[c];
#pragma unroll
          for (int j = 0; j < 8; ++j) q[c * 8 + j] = bf2f((bf16_t)qq[j]); } }
    float o[32];
#pragma unroll
    for (int i = 0; i < 32; ++i) o[i] = 0.f;
    float m = -INFINITY, l = 0.f;
    const int nk = (chunk + 1) * 64;
    for (int j = 0; j < nk; ++j) {
        const size_t tk = (size_t)b * SEQ + j;
        const bf16x8* kp = (const bf16x8*)(proj + tk * PP + C_DK + hm * 64);
        float s = 0.f;
#pragma unroll
        for (int c = 0; c < 8; ++c) { const bf16x8 kk = kp[c];
#pragma unroll
            for (int j = 0; j < 8; ++j) s += q[c * 8 + j] * bf2f((bf16_t)kk[j]); }
        const float mn = fmaxf(m, s), al = exp2f(m - mn), p = exp2f(s - mn);
        l = l * al + p; m = mn;
        const bf16x8* vp = (const bf16x8*)(proj + tk * PP + C_DV + h * 128 + qtr * 32);
#pragma unroll
        for (int c = 0; c < 4; ++c) { const bf16x8 vv = vp[c];
#pragma unroll
            for (int j = 0; j < 8; ++j) o[c * 8 + j] = o[c * 8 + j] * al + p * bf2f((bf16_t)vv[j]); }
    }
    const float rl_ = 1.f / l;
#pragma unroll
    for (int i = 0; i < 32; ++i) od[t * D + hm * 128 + qtr * 32 + i] = f2bf(o[i] * rl_);
}
__global__ void k_diff_out(const bf16_t* __restrict__ od, const bf16_t* __restrict__ proj, const float* __restrict__ w, const float* __restrict__ lam, bf16_t* __restrict__ mixed) {
    const int gw = blockIdx.x * (blockDim.x / 64) + (threadIdx.x >> 6), lane = threadIdx.x & 63;
    if (gw >= T * 4) return;
    const int h = gw & 3; const size_t t = gw >> 2;
    const float lm = lam[0];
    const bf16_t* o1 = od + t * D + (2 * h) * 128; const bf16_t* o2 = o1 + 128;
    const float d0 = bf2f(o1[lane]) - lm * bf2f(o2[lane]), d1 = bf2f(o1[64 + lane]) - lm * bf2f(o2[64 + lane]);
    const float r = rsqrtf(wave_sum(d0 * d0 + d1 * d1) * (1.f / 128) + EPS);
    const float g0 = bf2f(proj[t * PP + C_DG + h * 128 + lane]), g1 = bf2f(proj[t * PP + C_DG + h * 128 + 64 + lane]);
    mixed[t * D + 512 + h * 128 + lane] = f2bf(d0 * r * w[lane] * 0.8f * silu(g0));
    mixed[t * D + 512 + h * 128 + 64 + lane] = f2bf(d1 * r * w[64 + lane] * 0.8f * silu(g1));
}

__global__ void __launch_bounds__(256) k_cross_attn(const bf16_t* __restrict__ qc, const bf16_t* __restrict__ kvm, bf16_t* __restrict__ oc) {
    __shared__ float sp[16][257];
    __shared__ float sl[16];
    const int tid = threadIdx.x, head = blockIdx.x & 3, tile = blockIdx.x >> 2;
    const size_t t0 = (size_t)tile * 16; const int b = (int)(t0 / SEQ);
    const bf16_t* kp = kvm + (size_t)(b * MEM_LEN + tid) * 2048 + head * 256;
    float acc[16];
#pragma unroll
    for (int r = 0; r < 16; ++r) acc[r] = 0.f;
    for (int d = 0; d < 256; ++d) {
        const float kv = bf2f(kp[d]);
#pragma unroll
        for (int r = 0; r < 16; ++r) acc[r] += kv * bf2f(qc[(t0 + r) * D + head * 256 + d]);
    }
#pragma unroll
    for (int r = 0; r < 16; ++r) sp[r][tid] = acc[r];
    __syncthreads();
    { const int w = tid >> 6, lane = tid & 63;
      for (int r = w * 4; r < w * 4 + 4; ++r) {
          float mx = -INFINITY;
          for (int j = lane; j < 256; j += 64) mx = fmaxf(mx, sp[r][j]);
#pragma unroll
          for (int o = 1; o < 64; o <<= 1) mx = fmaxf(mx, __shfl_xor(mx, o));
          float sum = 0.f;
          for (int j = lane; j < 256; j += 64) { const float p = exp2f(sp[r][j] - mx); sp[r][j] = p; sum += p; }
          sum = wave_sum(sum);
          if (lane == 0) sl[r] = sum;
      } }
    __syncthreads();
#pragma unroll
    for (int r = 0; r < 16; ++r) acc[r] = 0.f;
    const bf16_t* vp = kvm + (size_t)(b * MEM_LEN) * 2048 + 1024 + head * 256 + tid;
    for (int j = 0; j < 256; ++j) {
        const float v = bf2f(vp[(size_t)j * 2048]);
#pragma unroll
        for (int r = 0; r < 16; ++r) acc[r] += sp[r][j] * v;
    }
#pragma unroll
    for (int r = 0; r < 16; ++r) oc[(t0 + r) * D + head * 256 + tid] = f2bf(acc[r] / sl[r]);
}
__global__ void k_final_norm(float* __restrict__ x2, const float* __restrict__ rss2, const float* __restrict__ w) {
    const int row = blockIdx.x * (blockDim.x / 64) + (threadIdx.x >> 6), lane = threadIdx.x & 63;
    if (row >= T) return;
    const float r = rsqrtf(rss2[row] * (1.f / D) + EPS);
    f32x4* xr = (f32x4*)(x2 + (size_t)row * D);
#pragma unroll
    for (int j = 0; j < 4; ++j) { f32x4 v = xr[lane + 64 * j]; const f32x4 ww = ((const f32x4*)w)[lane + 64 * j]; v.x *= r * ww.x; v.y *= r * ww.y; v.z *= r * ww.z; v.w *= r * ww.w; xr[lane + 64 * j] = v; }
}


namespace pg8 {
#define PG8_LAS __attribute__((address_space(3)))
typedef unsigned short bf16_t;
typedef short bf16x8 __attribute__((ext_vector_type(8)));
typedef float f32x4 __attribute__((ext_vector_type(4)));
typedef unsigned u32x4 __attribute__((ext_vector_type(4)));
constexpr int BM = 256, BK = 64, HALF = 128, HTB = HALF * BK * 2  , STAGE_BYTES = 8 * HTB, NXCD = 8, WGM = 8;

__host__ __device__ __forceinline__ int lds_byte(int r, int c) { const int st = (r >> 4) * 2 + (c >> 5), rr = r & 15, cc = c & 31, ob = rr * 64 + cc * 2; return st * 1024 + (ob ^ (((ob >> 9) & 1) << 5)); }
__host__ __device__ __forceinline__ void stage_rc(int b, int& R, int& C) { const int st = b / 1024, sb = b % 1024, swz = sb ^ (((sb >> 9) & 1) << 5); R = (st >> 1) * 16 + swz / 64; C = (st & 1) * 32 + (swz % 64) / 2; }
__host__ __device__ __forceinline__ int perm32(int rho) { const int n = rho >> 4, i = rho & 15; return 8 * (i >> 2) + 4 * n + (i & 3); }

struct Unit { int pm, pn; };
struct Gemm { const bf16_t* A; const bf16_t* Bt; int M, N, K; };

struct StaticOrder {
    int nM, nN, nwg, G, c;
    __host__ __device__ void init(int M, int N, int G_, int c_) { nM = M / BM; nN = N / BM; nwg = nM * nN; G = G_; c = c_; }
    __host__ __device__ bool next(int i, Unit& u) const {
        const long L = (long)i * G + c; if (L >= nwg) return false;
        int wgid = (int)L; { const int q = nwg / NXCD, r = nwg % NXCD, xcd = wgid % NXCD, off = wgid / NXCD; wgid = (xcd < r ? xcd * (q + 1) : r * (q + 1) + (xcd - r) * q) + off; }
        const int nig = WGM * nN, gid = wgid / nig, fm = gid * WGM, gsz = (nM - fm) < WGM ? (nM - fm) : WGM;
        u.pm = fm + ((wgid % nig) % gsz); u.pn = (wgid % nig) / gsz; return true;
    }
    __device__ __forceinline__ void a_ready(const Unit&) const {}
    __device__ __forceinline__ void done(const Unit&) const {}
};

__device__ __forceinline__ unsigned cvt_pk_bf16(float lo, float hi) { unsigned r; asm volatile("v_cvt_pk_bf16_f32 %0, %1, %2" : "=v"(r) : "v"(lo), "v"(hi)); return r; }
typedef float f32x2 __attribute__((ext_vector_type(2)));
__device__ __forceinline__ f32x2 gelu_pk(f32x2 v) {
    const f32x2 av = __builtin_elementwise_abs(v), d = av * 0.2316418882f + 1.0f;
    f32x2 t; t.x = __builtin_amdgcn_rcpf(d.x); t.y = __builtin_amdgcn_rcpf(d.y);
    f32x2 q = t * 0.5307027145f + (-0.7265760135f); q = q * t + 0.7107068705f; q = q * t + (-0.142248368f); q = q * t + 0.127414796f; q = q * t;
    const f32x2 s = (v * v) * (-0.72134752044f);
    f32x2 e; e.x = __builtin_amdgcn_exp2f(s.x); e.y = __builtin_amdgcn_exp2f(s.y);
    const f32x2 m = v * (q * e), r = v - m;
    f32x2 o; o.x = v.x < 0.f ? m.x : r.x; o.y = v.y < 0.f ? m.y : r.y; return o;
}

template <int ACT  > struct EpiBf16 {
    static constexpr bool PERM = true, AFTER_DRAIN = false; static_assert(ACT == 0 || ACT == 1, "EpiBf16: ACT is 0 (none) or 1 (gelu_pk)");
    bf16_t* O; int ldc; const float* bias; int split_cols; size_t split_stride; float scale0;
    __device__ __forceinline__ void operator()(const f32x4 (&acc)[2][2][4][2], const Unit& u, int wr, int wc, int fr, int fq) const {
        asm volatile("" : "+v"(fr), "+v"(fq));
        const int row0 = u.pm * BM + wr * 64 + fr; int colt = u.pn * BM; bf16_t* base = O;
        float sc = 1.f; if (split_cols) { const int t = colt / split_cols; base += (size_t)t * split_stride; colt -= t * split_cols; if (t == 0) sc = scale0; }
        const int col0 = colt + wc * 32 + 8 * fq, bcol0 = u.pn * BM + wc * 32 + 8 * fq;
        f32x4 bv[2][2];
#pragma unroll
        for (int bj = 0; bj < 2; ++bj)
#pragma unroll
            for (int n = 0; n < 2; ++n) bv[bj][n] = bias ? *(const f32x4*)(bias + bcol0 + bj * HALF + 4 * n) : (f32x4){0.f, 0.f, 0.f, 0.f};
#pragma unroll
        for (int ai = 0; ai < 2; ++ai)
#pragma unroll
            for (int m = 0; m < 4; ++m) { bf16_t* rowp = base + (size_t)(row0 + ai * HALF + m * 16) * ldc + col0;
#pragma unroll
                for (int bj = 0; bj < 2; ++bj) { f32x4 v0 = acc[ai][bj][m][0] + bv[bj][0], v1 = acc[ai][bj][m][1] + bv[bj][1];
                    if (ACT == 1) { f32x2 a = gelu_pk((f32x2){v0[0], v0[1]}), b = gelu_pk((f32x2){v0[2], v0[3]}), c = gelu_pk((f32x2){v1[0], v1[1]}), d = gelu_pk((f32x2){v1[2], v1[3]});
                        v0 = (f32x4){a.x, a.y, b.x, b.y}; v1 = (f32x4){c.x, c.y, d.x, d.y}; }
                    v0 = v0 * sc; v1 = v1 * sc; u32x4 w; w.x = cvt_pk_bf16(v0[0], v0[1]); w.y = cvt_pk_bf16(v0[2], v0[3]); w.z = cvt_pk_bf16(v1[0], v1[1]); w.w = cvt_pk_bf16(v1[2], v1[3]);
                    *(u32x4*)(rowp + bj * HALF) = w; } }
    }
};

constexpr float QC2 = 0.125f * 1.4426950408889634f;
constexpr float QC3 = 0.0625f * 1.4426950408889634f;
constexpr int PPITCH = 3584;
__device__ __forceinline__ u32x4 pack8(const f32x4& v0, const f32x4& v1) { u32x4 w; w.x = cvt_pk_bf16(v0[0], v0[1]); w.y = cvt_pk_bf16(v0[2], v0[3]); w.z = cvt_pk_bf16(v1[0], v1[1]); w.w = cvt_pk_bf16(v1[2], v1[3]); return w; }
struct EpiInProj {
    static constexpr bool PERM = true, AFTER_DRAIN = false;
    bf16_t* proj; float* ga; const float* cs; const float* sn;
    __device__ __forceinline__ void operator()(const f32x4 (&acc)[2][2][4][2], const Unit& u, int wr, int wc, int fr, int fq) const {
        asm volatile("" : "+v"(fr), "+v"(fq));
        const int row0 = u.pm * BM + wr * 64 + fr;
        if (u.pn == 14) {
            if (wc == 0 && fq < 2) {
#pragma unroll
                for (int ai = 0; ai < 2; ++ai)
#pragma unroll
                    for (int m = 0; m < 4; ++m) { float* g = ga + (size_t)(row0 + ai * HALF + m * 16) * 16 + 8 * fq; *(f32x4*)g = acc[ai][0][m][0]; *(f32x4*)(g + 4) = acc[ai][0][m][1]; }
            }
            return;
        }
#ifdef NO_ROPE
        const bool rope = false;
#else
        const bool rope = (u.pn >= 6) && (u.pn <= 9) && ((wc & 1) == 0);
#endif
        const float sc = (u.pn == 6 || u.pn == 7) ? QC2 : 1.f;
        const float sg = (fq == 0) ? -1.f : 1.f;
        const bool rl = fq < 2;
        bf16_t* base = proj + u.pn * BM + wc * 32 + 8 * fq;
#pragma unroll
        for (int ai = 0; ai < 2; ++ai)
#pragma unroll
            for (int m = 0; m < 4; ++m) {
                const int row = row0 + ai * HALF + m * 16;
                f32x4 c0 = (f32x4){1.f, 1.f, 1.f, 1.f}, c1 = c0, s0 = (f32x4){0.f, 0.f, 0.f, 0.f}, s1 = s0;
                if (rope) { c0 = *(const f32x4*)(cs + (size_t)row * 8); c1 = *(const f32x4*)(cs + (size_t)row * 8 + 4); s0 = *(const f32x4*)(sn + (size_t)row * 8); s1 = *(const f32x4*)(sn + (size_t)row * 8 + 4); }
#pragma unroll
                for (int bj = 0; bj < 2; ++bj) {
                    f32x4 v0 = acc[ai][bj][m][0], v1 = acc[ai][bj][m][1];
                    if (rope) {
                        f32x4 p0, p1;
#pragma unroll
                        for (int i = 0; i < 4; ++i) { p0[i] = __shfl_xor(v0[i], 16); p1[i] = __shfl_xor(v1[i], 16); }
                        if (rl) { v0 = v0 * c0 + (p0 * s0) * sg; v1 = v1 * c1 + (p1 * s1) * sg; }
                    }
                    v0 = v0 * sc; v1 = v1 * sc;
                    *(u32x4*)(base + (size_t)row * PPITCH + bj * HALF) = pack8(v0, v1);
                }
                asm volatile("" ::: "memory");
            }
    }
};
struct EpiOutProj {
    static constexpr bool PERM = true, AFTER_DRAIN = false;
    const float* x; float* x1; bf16_t* x1b; float* rss;
    __device__ __forceinline__ void operator()(const f32x4 (&acc)[2][2][4][2], const Unit& u, int wr, int wc, int fr, int fq) const {
        asm volatile("" : "+v"(fr), "+v"(fq));
        const int row0 = u.pm * BM + wr * 64 + fr, col0 = u.pn * BM + wc * 32 + 8 * fq;
#pragma unroll
        for (int ai = 0; ai < 2; ++ai)
#pragma unroll
            for (int m = 0; m < 4; ++m) {
                const int row = row0 + ai * HALF + m * 16; const size_t off = (size_t)row * 1024 + col0; float ss = 0.f;
#pragma unroll
                for (int bj = 0; bj < 2; ++bj) {
                    const f32x4 v0 = acc[ai][bj][m][0] + *(const f32x4*)(x + off + bj * HALF), v1 = acc[ai][bj][m][1] + *(const f32x4*)(x + off + bj * HALF + 4);
                    *(f32x4*)(x1 + off + bj * HALF) = v0; *(f32x4*)(x1 + off + bj * HALF + 4) = v1;
                    *(u32x4*)(x1b + off + bj * HALF) = pack8(v0, v1);
                    ss += (v0[0] * v0[0] + v0[1] * v0[1]) + (v0[2] * v0[2] + v0[3] * v0[3]) + (v1[0] * v1[0] + v1[1] * v1[1]) + (v1[2] * v1[2] + v1[3] * v1[3]);
                }
                ss += __shfl_xor(ss, 16); ss += __shfl_xor(ss, 32);
                if (fq == 0) atomicAdd(rss + row, ss);
                asm volatile("" ::: "memory");
            }
    }
};
struct EpiCq {
    static constexpr bool PERM = true, AFTER_DRAIN = false;
    bf16_t* qc; const float* rss;
    __device__ __forceinline__ void operator()(const f32x4 (&acc)[2][2][4][2], const Unit& u, int wr, int wc, int fr, int fq) const {
        asm volatile("" : "+v"(fr), "+v"(fq));
        const int row0 = u.pm * BM + wr * 64 + fr, col0 = u.pn * BM + wc * 32 + 8 * fq;
#pragma unroll
        for (int ai = 0; ai < 2; ++ai)
#pragma unroll
            for (int m = 0; m < 4; ++m) {
                const int row = row0 + ai * HALF + m * 16; const float r = rsqrtf(rss[row] * (1.f / 1024.f) + 1e-6f) * QC3;
#pragma unroll
                for (int bj = 0; bj < 2; ++bj) *(u32x4*)(qc + (size_t)row * 1024 + col0 + bj * HALF) = pack8(acc[ai][bj][m][0] * r, acc[ai][bj][m][1] * r);
            }
    }
};
struct EpiCo {
    static constexpr bool PERM = true, AFTER_DRAIN = false;
    float* x12; float* rss2;
    __device__ __forceinline__ void operator()(const f32x4 (&acc)[2][2][4][2], const Unit& u, int wr, int wc, int fr, int fq) const {
        asm volatile("" : "+v"(fr), "+v"(fq));
        const int row0 = u.pm * BM + wr * 64 + fr, col0 = u.pn * BM + wc * 32 + 8 * fq;
#pragma unroll
        for (int ai = 0; ai < 2; ++ai)
#pragma unroll
            for (int m = 0; m < 4; ++m) {
                const int row = row0 + ai * HALF + m * 16; const size_t off = (size_t)row * 1024 + col0; float ss = 0.f;
#pragma unroll
                for (int bj = 0; bj < 2; ++bj) {
                    const f32x4 v0 = acc[ai][bj][m][0] + *(const f32x4*)(x12 + off + bj * HALF), v1 = acc[ai][bj][m][1] + *(const f32x4*)(x12 + off + bj * HALF + 4);
                    *(f32x4*)(x12 + off + bj * HALF) = v0; *(f32x4*)(x12 + off + bj * HALF + 4) = v1;
                    ss += (v0[0] * v0[0] + v0[1] * v0[1]) + (v0[2] * v0[2] + v0[3] * v0[3]) + (v1[0] * v1[0] + v1[1] * v1[1]) + (v1[2] * v1[2] + v1[3] * v1[3]);
                }
                ss += __shfl_xor(ss, 16); ss += __shfl_xor(ss, 32);
                if (fq == 0) atomicAdd(rss2 + row, ss);
                asm volatile("" ::: "memory");
            }
    }
};
template <class Epi, class Sched, bool ALIGN_EPI = false, bool SP2 = false>
__device__ __forceinline__ void gemm_phase(PG8_LAS unsigned char* lds, const Gemm g, const Sched& S, const Epi& E) {
    const int tid = threadIdx.x, wid = __builtin_amdgcn_readfirstlane(tid >> 6), lane = tid & 63, wr = wid >> 2, wc = wid & 3, fr = lane & 15, fq = lane >> 4;
    const int K = g.K, nt = K / BK;
    unsigned voffA[2], voffB[2];
#pragma unroll
    for (int i = 0; i < 2; ++i) { int R, C; stage_rc(tid * 16 + i * 8192, R, C); const int Rb = Epi::PERM ? ((R & ~31) + perm32(R & 31)) : R;
        voffA[i] = (unsigned)(R * K + C) * 2u; voffB[i] = (unsigned)(Rb * K + C) * 2u; }
    const size_t kstep = (size_t)(BK * 2);
    const size_t hstep = (size_t)HALF * K * 2;
    const size_t tstep = 2 * hstep;
    const unsigned ldsw = (unsigned)wid * 1024u;
    const int aoff = lds_byte(wr * 64 + fr, fq * 8), boff = lds_byte(wc * 32 + fr, fq * 8);
#define PG8_SA(b, h) (((b) * 2 + (h)) * HTB)
#define PG8_SB(b, h) ((4 + (b) * 2 + (h)) * HTB)
#define PG8_STAGE(bufoff, gbase, voff) do { _Pragma("unroll") for (int _i = 0; _i < 2; ++_i) \
        __builtin_amdgcn_global_load_lds((const unsigned*)((const char*)(gbase) + (voff)[_i]), (PG8_LAS unsigned*)(lds + (bufoff) + ldsw + _i * 8192), 16, 0, 0); } while (0)
#define PG8_LDA(dst, b, h) do { _Pragma("unroll") for (int m = 0; m < 4; ++m) _Pragma("unroll") for (int k = 0; k < 2; ++k) dst[m][k] = *(const PG8_LAS bf16x8*)(lds + PG8_SA(b, h) + aoff + m * 2048 + k * 1024); } while (0)
#define PG8_LDB(dst, b, h) do { _Pragma("unroll") for (int n = 0; n < 2; ++n) _Pragma("unroll") for (int k = 0; k < 2; ++k) dst[n][k] = *(const PG8_LAS bf16x8*)(lds + PG8_SB(b, h) + boff + n * 2048 + k * 1024); } while (0)
#define PG8_MMA(ai, bj, At, Bt) do { __builtin_amdgcn_s_setprio(1); _Pragma("unroll") for (int m = 0; m < 4; ++m) _Pragma("unroll") for (int n = 0; n < 2; ++n) _Pragma("unroll") for (int k = 0; k < 2; ++k) \
        acc[ai][bj][m][n] = __builtin_amdgcn_mfma_f32_16x16x32_bf16(Bt[n][k], At[m][k], acc[ai][bj][m][n], 0, 0, 0); __builtin_amdgcn_s_setprio(0); } while (0)
#define PG8_WAIT_V(n) asm volatile("s_waitcnt vmcnt(" #n ")" ::: "memory")
#define PG8_WAIT_L(n) asm volatile("s_waitcnt lgkmcnt(" #n ")" ::: "memory")
#define PG8_BAR __builtin_amdgcn_s_barrier()
#define PG8_SCHED __builtin_amdgcn_sched_barrier(0)
    Unit cur, nxt; int ui = 0;
    if (!S.next(0, cur)) return;
    f32x4 acc[2][2][4][2];
#pragma unroll
    for (int a = 0; a < 2; ++a)
#pragma unroll
        for (int b = 0; b < 2; ++b)
#pragma unroll
            for (int m = 0; m < 4; ++m)
#pragma unroll
                for (int n = 0; n < 2; ++n) acc[a][b][m][n] = (f32x4){0.f, 0.f, 0.f, 0.f};
    bf16x8 At[4][2], B0[2][2], B1[2][2];
    const char* cA = (const char*)g.A + (size_t)cur.pm * tstep; const char* cB = (const char*)g.Bt + (size_t)cur.pn * tstep;
    S.a_ready(cur);
    if constexpr (SP2) {
        PG8_STAGE(PG8_SB(0, 0), cB, voffB); PG8_STAGE(PG8_SB(0, 1), cB + hstep, voffB); PG8_STAGE(PG8_SA(0, 0), cA, voffA); PG8_STAGE(PG8_SA(0, 1), cA + hstep, voffA);
        if (wr == 1) PG8_BAR;
        PG8_WAIT_V(2); PG8_BAR;
        PG8_STAGE(PG8_SB(1, 0), cB + kstep, voffB); PG8_STAGE(PG8_SA(1, 0), cA + kstep, voffA); PG8_STAGE(PG8_SB(1, 1), cB + hstep + kstep, voffB);
        PG8_WAIT_V(6); PG8_BAR;
    } else {
        PG8_STAGE(PG8_SB(0, 0), cB, voffB); PG8_STAGE(PG8_SA(0, 0), cA, voffA); PG8_STAGE(PG8_SB(0, 1), cB + hstep, voffB); PG8_STAGE(PG8_SA(0, 1), cA + hstep, voffA);
        if (wr == 1) PG8_BAR;
        PG8_WAIT_V(4); PG8_BAR;
        PG8_STAGE(PG8_SB(1, 0), cB + kstep, voffB); PG8_STAGE(PG8_SA(1, 0), cA + kstep, voffA); PG8_STAGE(PG8_SB(1, 1), cB + hstep + kstep, voffB);
        PG8_WAIT_V(6); PG8_BAR;
    }
    for (;;) {
        const bool has_next = S.next(ui + 1, nxt);
        const char* nA = has_next ? (const char*)g.A + (size_t)nxt.pm * tstep : cA; const char* nB = has_next ? (const char*)g.Bt + (size_t)nxt.pn * tstep : cB;
        for (int t = 0; t < nt; t += 2) {
            const bool last = (t == nt - 2);
            const char* a1 = cA + (size_t)(t + 1) * kstep;
            const char* a2 = last ? nA : cA + (size_t)(t + 2) * kstep; const char* b2 = last ? nB : cB + (size_t)(t + 2) * kstep;
            const char* a3 = a2 + kstep; const char* b3 = b2 + kstep;
            if (last && has_next) S.a_ready(nxt);
            if constexpr (SP2) {
            PG8_LDB(B0, 0, 0); PG8_LDB(B1, 0, 1); PG8_SCHED; PG8_LDA(At, 0, 0); PG8_STAGE(PG8_SA(1, 1), a1 + hstep, voffA);
            PG8_WAIT_V(8); PG8_WAIT_L(0); PG8_BAR; PG8_MMA(0, 0, At, B0); PG8_MMA(0, 1, At, B1); PG8_BAR; PG8_SCHED;
            PG8_LDA(At, 0, 1); PG8_STAGE(PG8_SB(0, 0), b2, voffB); PG8_STAGE(PG8_SB(0, 1), b2 + hstep, voffB); PG8_STAGE(PG8_SA(0, 0), a2, voffA);
            PG8_WAIT_V(8); PG8_WAIT_L(0); PG8_BAR; PG8_MMA(1, 0, At, B0); PG8_MMA(1, 1, At, B1); PG8_BAR; PG8_SCHED;
            PG8_LDB(B0, 1, 0); PG8_LDB(B1, 1, 1); PG8_SCHED; PG8_LDA(At, 1, 0); PG8_STAGE(PG8_SA(0, 1), a2 + hstep, voffA);
            PG8_WAIT_V(8); PG8_WAIT_L(0); PG8_BAR; PG8_MMA(0, 0, At, B0); PG8_MMA(0, 1, At, B1); PG8_BAR; PG8_SCHED;
            PG8_LDA(At, 1, 1); PG8_STAGE(PG8_SB(1, 0), b3, voffB); PG8_STAGE(PG8_SB(1, 1), b3 + hstep, voffB); PG8_STAGE(PG8_SA(1, 0), a3, voffA);
            PG8_WAIT_V(8); PG8_WAIT_L(0); PG8_BAR; PG8_MMA(1, 0, At, B0); PG8_MMA(1, 1, At, B1); PG8_BAR; PG8_SCHED;
            } else {
            PG8_LDB(B0, 0, 0); PG8_SCHED; PG8_LDA(At, 0, 0); PG8_STAGE(PG8_SA(1, 1), a1 + hstep, voffA);
            PG8_WAIT_L(8); PG8_BAR; PG8_WAIT_L(0); PG8_MMA(0, 0, At, B0); PG8_BAR; PG8_SCHED;
            PG8_LDB(B1, 0, 1); PG8_STAGE(PG8_SB(0, 0), b2, voffB);
            PG8_BAR; PG8_WAIT_L(0); PG8_MMA(0, 1, At, B1); PG8_BAR;
            PG8_LDA(At, 0, 1); PG8_STAGE(PG8_SA(0, 0), a2, voffA);
            PG8_BAR; PG8_WAIT_L(0); PG8_MMA(1, 0, At, B0); PG8_BAR; PG8_SCHED;
            PG8_STAGE(PG8_SB(0, 1), b2 + hstep, voffB);
            PG8_WAIT_V(6); PG8_BAR; PG8_MMA(1, 1, At, B1); PG8_BAR;
            PG8_LDB(B0, 1, 0); PG8_SCHED; PG8_LDA(At, 1, 0); PG8_STAGE(PG8_SA(0, 1), a2 + hstep, voffA);
            PG8_WAIT_L(8); PG8_BAR; PG8_WAIT_L(0); PG8_MMA(0, 0, At, B0); PG8_BAR; PG8_SCHED;
            PG8_LDB(B1, 1, 1); PG8_STAGE(PG8_SB(1, 0), b3, voffB);
            PG8_BAR; PG8_WAIT_L(0); PG8_MMA(0, 1, At, B1); PG8_BAR;
            PG8_LDA(At, 1, 1); PG8_STAGE(PG8_SA(1, 0), a3, voffA);
            PG8_BAR; PG8_WAIT_L(0); PG8_MMA(1, 0, At, B0); PG8_BAR; PG8_SCHED;
            PG8_STAGE(PG8_SB(1, 1), b3 + hstep, voffB);
            PG8_WAIT_V(6); PG8_BAR; PG8_MMA(1, 1, At, B1); PG8_BAR;
            }
        }
        if constexpr (ALIGN_EPI) { if (wr == 0) PG8_BAR; }
        if constexpr (!Epi::AFTER_DRAIN) { E(acc, cur, wr, wc, fr, fq); S.done(cur); }
        if (!has_next) break;
#pragma unroll
        for (int a = 0; a < 2; ++a)
#pragma unroll
            for (int b = 0; b < 2; ++b)
#pragma unroll
                for (int m = 0; m < 4; ++m)
#pragma unroll
                    for (int n = 0; n < 2; ++n) acc[a][b][m][n] = (f32x4){0.f, 0.f, 0.f, 0.f};
        cur = nxt; cA = nA; cB = nB; ++ui;
        if constexpr (ALIGN_EPI) { if (wr == 1) PG8_BAR; }
    }
    PG8_WAIT_V(0);
    if constexpr (!ALIGN_EPI) { if (wr == 0) PG8_BAR; }
    PG8_BAR;
    if constexpr (Epi::AFTER_DRAIN) { E.fused(acc, cur, wr, wc, fr, fq, lds, wid, lane); S.done(cur); }
#undef PG8_SA
#undef PG8_SB
#undef PG8_STAGE
#undef PG8_LDA
#undef PG8_LDB
#undef PG8_MMA
#undef PG8_WAIT_V
#undef PG8_WAIT_L
#undef PG8_BAR
#undef PG8_SCHED
}
}

#ifndef PG8_SP2
#define PG8_SP2 true
#endif
#ifndef PG8_ALIGN
#define PG8_ALIGN true
#endif

#include <hip/hip_bf16.h>
#include <cmath>
namespace attn_body {
using bf16=__hip_bfloat16;
using bf16x8=__attribute__((ext_vector_type(8)))short;
using s16x4=__attribute__((ext_vector_type(4)))short;
using f32x16=__attribute__((ext_vector_type(16)))float;
using u32x4=__attribute__((ext_vector_type(4)))unsigned;
constexpr int SEQ=4096,D=64,PQ=3584,PO=1024;
constexpr int NW=8,QBLK=32,QB=QBLK*NW,KVBLK=64,NQB=SEQ/QB;
constexpr int ATTN_UNIT_ROWS=QB;
__device__ __forceinline__ int crow(int r,int hi){return (r&3)+8*(r>>2)+4*hi;}
#define SBAR() __builtin_amdgcn_sched_barrier(0)
__device__ __forceinline__ void cmask(f32x16&p0,f32x16&p1,int jb,int qrel,int hi){
  const float NEG=-INFINITY;
  if(jb>(qrel>>6)){
  #pragma unroll
  for(int r=0;r<16;++r){p0[r]=NEG;p1[r]=NEG;}}
}

constexpr int NSLOT=3, SLOTB=8192;
constexpr int LDS_K=0, LDS_V=NSLOT*SLOTB, LDS_WS=2*NSLOT*SLOTB, LDS_OST=LDS_WS+NW*64*4, LDS_BYTES=LDS_OST+NW*4096;
constexpr float C2=0.125f*1.4426950408889634f;
__device__ __forceinline__ void glds16(const void*gsrc,unsigned lds_dst){unsigned keep;
  asm volatile("s_mov_b32 %0, m0\n\ts_mov_b32 m0, %2\n\ts_nop 0\n\tglobal_load_lds_dwordx4 %1, off\n\ts_mov_b32 m0, %0":"=&s"(keep):"v"(gsrc),"s"(lds_dst):"memory");}
__device__ __forceinline__ float max3f(float a,float b,float c){float r;asm("v_max3_f32 %0, %1, %2, %3":"=v"(r):"v"(a),"v"(b),"v"(c));return r;}
__device__ __forceinline__ float max2f(float a,float b){float r;asm("v_max_f32_e32 %0, %1, %2":"=v"(r):"v"(a),"v"(b));return r;}
__device__ __forceinline__ float fadd_s(float a,float b){float r;asm("v_add_f32_e32 %0, %1, %2":"=v"(r):"v"(a),"v"(b));return r;}
__device__ __forceinline__ float fsub_s(float a,float b){float r;asm("v_sub_f32_e32 %0, %1, %2":"=v"(r):"v"(a),"v"(b));return r;}
typedef float f32x2_t __attribute__((ext_vector_type(2))); typedef __bf16 bf16x2_t __attribute__((ext_vector_type(2)));
__device__ __forceinline__ unsigned cvtpk_s(float lo,float hi){f32x2_t v={lo,hi};bf16x2_t b=__builtin_convertvector(v,bf16x2_t);return __builtin_bit_cast(unsigned,b);}
#define WAIT_BAR(N) asm volatile("s_waitcnt vmcnt(" #N ") lgkmcnt(0)\n\ts_barrier":::"memory")

__device__ __forceinline__ void qkt(f32x16&p0,f32x16&p1,const char*Kslot,const bf16x8*qr,const f32x16&negm,int r32,int hi){
  const char*kb=Kslot+hi*1024+r32*16;
  #pragma unroll
  for(int d0=0;d0<4;++d0){
    const bf16x8 b0=*reinterpret_cast<const bf16x8*>(kb+d0*2048);
    const bf16x8 b1=*reinterpret_cast<const bf16x8*>(kb+d0*2048+512);
    if(d0==0){p0=__builtin_amdgcn_mfma_f32_32x32x16_bf16(b0,qr[0],negm,0,0,0);p1=__builtin_amdgcn_mfma_f32_32x32x16_bf16(b1,qr[0],negm,0,0,0);}
    else{p0=__builtin_amdgcn_mfma_f32_32x32x16_bf16(b0,qr[d0],p0,0,0,0);p1=__builtin_amdgcn_mfma_f32_32x32x16_bf16(b1,qr[d0],p1,0,0,0);}}
}
typedef __attribute__((address_space(3))) const char* lds_cptr;
typedef short v4i16_t __attribute__((ext_vector_type(4)));
__device__ __forceinline__ void kload8(bf16x8*kf,lds_cptr kp){
  kf[0]=*(const __attribute__((address_space(3))) bf16x8*)(kp);      kf[1]=*(const __attribute__((address_space(3))) bf16x8*)(kp+512);
  kf[2]=*(const __attribute__((address_space(3))) bf16x8*)(kp+2048); kf[3]=*(const __attribute__((address_space(3))) bf16x8*)(kp+2560);
  kf[4]=*(const __attribute__((address_space(3))) bf16x8*)(kp+4096); kf[5]=*(const __attribute__((address_space(3))) bf16x8*)(kp+4608);
  kf[6]=*(const __attribute__((address_space(3))) bf16x8*)(kp+6144); kf[7]=*(const __attribute__((address_space(3))) bf16x8*)(kp+6656);
}
__device__ __forceinline__ void kload2(bf16x8*kf,lds_cptr kp,int j){ kf[2*j]=*(const __attribute__((address_space(3))) bf16x8*)(kp+j*2048); kf[2*j+1]=*(const __attribute__((address_space(3))) bf16x8*)(kp+j*2048+512); }
__device__ __forceinline__ s16x4 vtr(lds_cptr p){ return __builtin_bit_cast(s16x4,__builtin_amdgcn_ds_read_tr16_b64_v4i16((__attribute__((address_space(3))) v4i16_t*)p)); }
__device__ __forceinline__ float rowmax(const f32x16&p0,const f32x16&p1){
  float a=max3f(p0[0],p0[1],p1[0]),b=max3f(p0[2],p0[3],p1[1]);a=max3f(a,p1[2],p1[3]);
  #pragma unroll
  for(int r=4;r<16;r+=4){a=max3f(a,p0[r],p0[r+1]);b=max3f(b,p0[r+2],p0[r+3]);a=max3f(a,p1[r],p1[r+1]);b=max3f(b,p1[r+2],p1[r+3]);}
  const float m=max2f(a,b);
  auto rr=__builtin_amdgcn_permlane32_swap(__float_as_uint(m),__float_as_uint(m),false,false);
  return max2f(__uint_as_float(rr[0]),__uint_as_float(rr[1]));
}
__device__ __forceinline__ void pv(f32x16*o,int vb,bf16x8 pa0,bf16x8 pa1,bf16x8 pa2,bf16x8 pa3){
  #pragma unroll
  for(int d0=0;d0<2;++d0){s16x4 lo[4],hi[4];
    #pragma unroll
    for(int ks=0;ks<4;++ks){
      asm volatile("ds_read_b64_tr_b16 %0,%1 offset:%c2":"=&v"(lo[ks]):"v"(vb),"i"(d0*4096+ks*1024):"memory");
      asm volatile("ds_read_b64_tr_b16 %0,%1 offset:%c2":"=&v"(hi[ks]):"v"(vb),"i"(d0*4096+ks*1024+512):"memory");}
    asm volatile("s_waitcnt lgkmcnt(0)":::"memory");SBAR();
    #define PK(k) (bf16x8){lo[k][0],lo[k][1],lo[k][2],lo[k][3],hi[k][0],hi[k][1],hi[k][2],hi[k][3]}
    o[d0]=__builtin_amdgcn_mfma_f32_32x32x16_bf16(pa0,PK(0),o[d0],0,0,0);
    o[d0]=__builtin_amdgcn_mfma_f32_32x32x16_bf16(pa1,PK(1),o[d0],0,0,0);
    o[d0]=__builtin_amdgcn_mfma_f32_32x32x16_bf16(pa2,PK(2),o[d0],0,0,0);
    o[d0]=__builtin_amdgcn_mfma_f32_32x32x16_bf16(pa3,PK(3),o[d0],0,0,0);
    #undef PK
  }
}

#ifndef ATTN_STORE16
#define ATTN_STORE16(p,v) (*(u32x4*)(p)=(v))
#endif
template<int THRL> __device__ __forceinline__ void attn_unit(int b,int qcol,int kcol,int vcol,int ocol,int qb,const bf16*__restrict__ P,bf16*O,char*shm){
  const int tid=threadIdx.x,lane=tid&63,r32=lane&31,hi=lane>>5; const int wid=__builtin_amdgcn_readfirstlane(tid>>6);
  const long rowbase=(long)b*SEQ; const int q0=qb*QB;
  const bf16*Qw=P+(rowbase+q0+wid*QBLK)*PQ+qcol;
  const bf16*Kh=P+rowbase*PQ+kcol,*Vh=P+rowbase*PQ+vcol;
  const unsigned lds0=(unsigned)(uintptr_t)shm;
  float*wsf=(float*)(shm+LDS_WS)+wid*64;
  const bf16*ksrc=Kh+(long)lane*PQ+wid*8;
  const bf16*vsrc=Vh+(long)(16*(wid&3)+(lane>>2))*PQ+(wid>>2)*32+(lane&3)*8;
  const unsigned kdst=lds0+LDS_K+wid*1024, vdst=lds0+LDS_V+wid*1024;
  #define DMA_K(t,slot) glds16(ksrc+(long)(t)*KVBLK*PQ,(unsigned)__builtin_amdgcn_readfirstlane(kdst+(slot)))
  #define DMA_V(t,slot) glds16(vsrc+(long)(t)*KVBLK*PQ,(unsigned)__builtin_amdgcn_readfirstlane(vdst+(slot)))
  const int vb0=(int)(lds0+LDS_V)+((lane>>4)&1)*32+(lane&3)*8+(4*hi+((lane&15)>>2))*64;
  const char*Kbase=shm+LDS_K; bf16x8 kf[8];
  const lds_cptr shm3=(lds_cptr)shm; const lds_cptr kp0=shm3+LDS_K+hi*1024+r32*16; const lds_cptr vp0=shm3+LDS_V+((lane>>4)&1)*32+(lane&3)*8+(4*hi+((lane&15)>>2))*64;
  const int NT=(q0+QB)/KVBLK;
  DMA_K(0,0);DMA_V(0,0);DMA_K(1,SLOTB);
  bf16x8 qr[4];
  #pragma unroll
  for(int d0=0;d0<4;++d0)qr[d0]=*reinterpret_cast<const bf16x8*>(&Qw[(long)r32*PQ+d0*16+hi*8]);
  float mhat=0.f,l_reg=0.f;f32x16 o[2];o[0]=f32x16{};o[1]=f32x16{};f32x16 negm=f32x16{};asm volatile("":"+v"(negm));
  const int qrel=wid*QBLK+r32;
  #define CMASK(P0,P1,t) do{int jb_=(t)-(NT-4); if(jb_>=0)cmask(P0,P1,jb_,qrel,hi);}while(0)
  bool resc=false;
  #define START(P0,P1) do{ const float rm=rowmax(P0,P1); resc=false; \
    { const float dl=rm; mhat=fadd_s(mhat,dl); \
      _Pragma("unroll") for(int r=0;r<16;++r){P0[r]=fsub_s(P0[r],dl);P1[r]=fsub_s(P1[r],dl);} \
      _Pragma("unroll") for(int r=0;r<16;++r)negm[r]=-mhat; asm volatile("":"+v"(negm)); } \
    _Pragma("unroll") for(int r=0;r<16;++r)P0[r]=__builtin_amdgcn_exp2f(P0[r]); }while(0)
  #define RESC() do{ if(resc){ asm volatile("s_waitcnt lgkmcnt(0)":::"memory"); \
      _Pragma("unroll") for(int d_=0;d_<2;++d_) _Pragma("unroll") for(int r=0;r<16;++r)o[d_][r]*=wsf[crow(r,hi)]; } }while(0)
  f32x16 pA0,pA1,pB0,pB1;
  int sl_prev=0,sl_cur=0,sl_next=SLOTB;
  #define ROT() do{sl_prev=sl_cur;sl_cur=sl_next;sl_next=(sl_next==(NSLOT-1)*SLOTB)?0:sl_next+SLOTB;}while(0)
  DMA_K(2,2*SLOTB);
  WAIT_BAR(3);
  qkt(pA0,pA1,Kbase,qr,negm,r32,hi);asm volatile("s_nop 15\n\ts_nop 7":"+v"(pA0),"+v"(pA1));CMASK(pA0,pA1,0);
  START(pA0,pA1);
  _Pragma("unroll") for(int r=0;r<16;++r)pA1[r]=__builtin_amdgcn_exp2f(pA1[r]);
  WAIT_BAR(0);
  DMA_K(3,0);DMA_V(1,SLOTB);
  ROT();
  kload8(kf,kp0+sl_cur);
  WAIT_BAR(2);
  s16x4 vlo[8],vhi[8]; u32x4 pw0,pw1,pw2,pw3;
  #define PKW(P,B) cvtpk_s(P[B],P[B+1])
  #define PAF(k) __builtin_bit_cast(bf16x8,pw##k)
  #define VFR(i) (bf16x8){vlo[i][0],vlo[i][1],vlo[i][2],vlo[i][3],vhi[i][0],vhi[i][1],vhi[i][2],vhi[i][3]}
  #define PIN(x) asm volatile("":"+v"(x))
  #define MX3(a,b,c) __builtin_fmaxf(__builtin_fmaxf((a),(b)),(c))
  #define GAPA(MF,A0,A1,A2,A3,W0,W1,PW) do{ MF; sacc+=A0; sacc+=A1; sacc+=A2; sacc+=A3; PIN(sacc); W0; W1; PIN(PW); SBAR(); }while(0)
  #define EX(v) __builtin_amdgcn_exp2f(v)
  #define GAPB(MF,X,B) do{ MF; X[B]=EX(X[B]); X[B+1]=EX(X[B+1]); X[B+2]=EX(X[B+2]); X[B+3]=EX(X[B+3]); PIN(X); SBAR(); }while(0)
  #define VRD(i) do{ vlo[i]=vtr(vp_+(((i)>>2)*4096+((i)&3)*1024)); vhi[i]=vtr(vp_+(((i)>>2)*4096+((i)&3)*1024+512)); }while(0)
  #define KRD(G,j) do{ if(G){ kload2(kf,kp0+sl_next,j); SBAR(); } }while(0)
  #define STEP(C0,C1,P0,P1,t,GK,GV,GL) do{ SBAR(); \
    const lds_cptr vp_=vp0+sl_prev; \
    VRD(0); SBAR(); float sacc=(P0[0]+P0[1]); \
    GAPA(C0=__builtin_amdgcn_mfma_f32_32x32x16_bf16(kf[0],qr[0],negm,0,0,0), P0[2],P0[3],P0[4],P0[5],     pw0[0]=PKW(P0,0), pw0[1]=PKW(P0,2), pw0); \
    VRD(4); SBAR(); GAPA(C1=__builtin_amdgcn_mfma_f32_32x32x16_bf16(kf[1],qr[0],negm,0,0,0), P0[6],P0[7],P0[8],P0[9],     pw0[2]=PKW(P0,4), pw0[3]=PKW(P0,6), pw0); \
    VRD(1); SBAR(); GAPA(C0=__builtin_amdgcn_mfma_f32_32x32x16_bf16(kf[2],qr[1],C0,0,0,0),   P0[10],P0[11],P0[12],P0[13], pw1[0]=PKW(P0,8), pw1[1]=PKW(P0,10), pw1); \
    VRD(5); SBAR(); GAPA(C1=__builtin_amdgcn_mfma_f32_32x32x16_bf16(kf[3],qr[1],C1,0,0,0),   P0[14],P0[15],P1[0],P1[1],   pw1[2]=PKW(P0,12),pw1[3]=PKW(P0,14), pw1); \
    VRD(2); SBAR(); GAPA(C0=__builtin_amdgcn_mfma_f32_32x32x16_bf16(kf[4],qr[2],C0,0,0,0),   P1[2],P1[3],P1[4],P1[5],     pw2[0]=PKW(P1,0), pw2[1]=PKW(P1,2), pw2); \
    VRD(6); SBAR(); GAPA(C1=__builtin_amdgcn_mfma_f32_32x32x16_bf16(kf[5],qr[2],C1,0,0,0),   P1[6],P1[7],P1[8],P1[9],     pw2[2]=PKW(P1,4), pw2[3]=PKW(P1,6), pw2); \
    VRD(3); SBAR(); GAPA(C0=__builtin_amdgcn_mfma_f32_32x32x16_bf16(kf[6],qr[3],C0,0,0,0),   P1[10],P1[11],P1[12],P1[13], pw3[0]=PKW(P1,8), pw3[1]=PKW(P1,10), pw3); \
    VRD(7); SBAR(); GAPA(C1=__builtin_amdgcn_mfma_f32_32x32x16_bf16(kf[7],qr[3],C1,0,0,0),   P1[14],P1[15],0.f,0.f,       pw3[2]=PKW(P1,12),pw3[3]=PKW(P1,14), pw3); \
    l_reg+=sacc; \
    if(GK){DMA_K((t)+3,sl_cur);} if(GV){DMA_V((t)+1,sl_next);} \
    CMASK(C0,C1,t); \
    { float a=MX3(C0[0],C0[1],C1[0]),b=MX3(C0[2],C0[3],C1[1]); a=MX3(a,C1[2],C1[3]); \
      _Pragma("unroll") for(int r=4;r<16;r+=4){a=MX3(a,C0[r],C0[r+1]);b=MX3(b,C0[r+2],C0[r+3]);a=MX3(a,C1[r],C1[r+1]);b=MX3(b,C1[r+2],C1[r+3]);} \
      float rm=__builtin_fmaxf(a,b); { auto rr=__builtin_amdgcn_permlane32_swap(__float_as_uint(rm),__float_as_uint(rm),false,false); rm=__builtin_fmaxf(__uint_as_float(rr[0]),__uint_as_float(rr[1])); } \
      resc=false; \
      if(__builtin_expect(__any(rm>(float)THRL),0)){ const float dl=__builtin_fmaxf(rm,0.f); mhat+=dl; \
        _Pragma("unroll") for(int r=0;r<16;++r){C0[r]-=dl;C1[r]-=dl;} \
        _Pragma("unroll") for(int r=0;r<16;++r)negm[r]=-mhat; asm volatile("":"+v"(negm)); \
        const float f=__builtin_amdgcn_exp2f(-dl); l_reg*=f; if(hi==0)wsf[r32]=f; resc=true; } } \
    SBAR(); \
    GAPB(o[0]=__builtin_amdgcn_mfma_f32_32x32x16_bf16(PAF(0),VFR(0),o[0],0,0,0), C0,0); \
    GAPB(o[1]=__builtin_amdgcn_mfma_f32_32x32x16_bf16(PAF(0),VFR(4),o[1],0,0,0), C0,4); \
    KRD(GL,0); GAPB(o[0]=__builtin_amdgcn_mfma_f32_32x32x16_bf16(PAF(1),VFR(1),o[0],0,0,0), C0,8); \
    KRD(GL,1); GAPB(o[1]=__builtin_amdgcn_mfma_f32_32x32x16_bf16(PAF(1),VFR(5),o[1],0,0,0), C0,12); \
    KRD(GL,2); GAPB(o[0]=__builtin_amdgcn_mfma_f32_32x32x16_bf16(PAF(2),VFR(2),o[0],0,0,0), C1,0); \
    KRD(GL,3); GAPB(o[1]=__builtin_amdgcn_mfma_f32_32x32x16_bf16(PAF(2),VFR(6),o[1],0,0,0), C1,4); \
    GAPB(o[0]=__builtin_amdgcn_mfma_f32_32x32x16_bf16(PAF(3),VFR(3),o[0],0,0,0), C1,8); \
    GAPB(o[1]=__builtin_amdgcn_mfma_f32_32x32x16_bf16(PAF(3),VFR(7),o[1],0,0,0), C1,12); \
    }while(0)
  int t=1;
  #undef CMASK
  #define CMASK(P0,P1,t) do{}while(0)
  for(;t+5<NT;t+=2){
    STEP(pB0,pB1,pA0,pA1,t,true,true,true);     WAIT_BAR(2); RESC(); ROT();
    STEP(pA0,pA1,pB0,pB1,t+1,true,true,true);   WAIT_BAR(2); RESC(); ROT();
  }
  #undef CMASK
  #define CMASK(P0,P1,t) do{int jb_=(t)-(NT-4); if(jb_>=0)cmask(P0,P1,jb_,qrel,hi);}while(0)
  #define ENDW(tt) do{ if((tt)+3<NT){WAIT_BAR(2);} else if((tt)+2<NT){WAIT_BAR(1);} else {WAIT_BAR(0);} }while(0)
  for(;t+1<NT;t+=2){
    STEP(pB0,pB1,pA0,pA1,t,(t+3<NT),(t+1<NT),(t+1<NT));       ENDW(t);   RESC(); ROT();
    STEP(pA0,pA1,pB0,pB1,t+1,(t+4<NT),(t+2<NT),(t+2<NT));     ENDW(t+1); RESC(); ROT();
  }
  STEP(pB0,pB1,pA0,pA1,NT-1,false,false,false); RESC();
  { float sacc=pB0[0]+pB0[1]; _Pragma("unroll") for(int r=2;r<16;++r)sacc+=pB0[r]; _Pragma("unroll") for(int r=0;r<16;++r)sacc+=pB1[r]; l_reg+=sacc;
    pw0=(u32x4){PKW(pB0,0),PKW(pB0,2),PKW(pB0,4),PKW(pB0,6)};pw1=(u32x4){PKW(pB0,8),PKW(pB0,10),PKW(pB0,12),PKW(pB0,14)};pw2=(u32x4){PKW(pB1,0),PKW(pB1,2),PKW(pB1,4),PKW(pB1,6)};pw3=(u32x4){PKW(pB1,8),PKW(pB1,10),PKW(pB1,12),PKW(pB1,14)};
    SBAR(); pv(o,vb0+sl_cur,PAF(0),PAF(1),PAF(2),PAF(3)); }
  #undef PKW
  #undef PAF
  #undef VFR
  #undef PIN
  #undef MX3
  #undef GAPA
  #undef GAPB
  #undef EX
  #undef VRD
  #undef KRD
  #undef STEP
  #undef ENDW
  {auto rr=__builtin_amdgcn_permlane32_swap(__float_as_uint(l_reg),__float_as_uint(l_reg),false,false);l_reg=__uint_as_float(rr[0])+__uint_as_float(rr[1]);}
  if(hi==0)wsf[32+r32]=l_reg;asm volatile("s_waitcnt lgkmcnt(0)":::"memory");
  float rli[16];
  #pragma unroll
  for(int r=0;r<16;++r)rli[r]=__builtin_amdgcn_rcpf(wsf[32+crow(r,hi)]);
  bf16*Ow=O+(rowbase+q0+wid*QBLK)*PO+ocol;
  { bf16*stg=(bf16*)(shm+LDS_OST)+wid*2048;
    #pragma unroll
    for(int r=0;r<16;++r){const int orow=crow(r,hi);
      #pragma unroll
      for(int d0=0;d0<2;++d0)stg[orow*64+d0*32+r32]=__float2bfloat16(o[d0][r]*rli[r]);}
    asm volatile("s_waitcnt lgkmcnt(0)":::"memory");
    #pragma unroll
    for(int i=0;i<4;++i){const int row=i*8+(lane>>3),ch=lane&7; const u32x4 v=*(const u32x4*)(stg+row*64+ch*8); ATTN_STORE16(Ow+(long)row*PO+ch*8,v);} }
  asm volatile("s_waitcnt lgkmcnt(0)\n\ts_barrier":::"memory");
  #undef DMA_K
  #undef DMA_V
  #undef CMASK
  #undef START
  #undef RESC
  #undef ROT
}
constexpr int ATTN_LDS_BYTES=LDS_BYTES;
struct AttnTensors { const bf16* P; bf16* O; };
struct AttnUnit { int bh; int qb; };
struct StaticOrder {
  int vcu;
  __device__ __forceinline__ explicit StaticOrder(int grid,int block):vcu((block%8)*(grid/8)+block/8){}
  __device__ __forceinline__ bool next(int i,AttnUnit&u)const{ if(i>=8)return false; const int s=4*(vcu&1)+(i>>1); u.bh=vcu>>1; u.qb=(i&1)?15-s:s; return true; }
  __device__ __forceinline__ void a_ready(const AttnUnit&)const{}
  __device__ __forceinline__ void done(const AttnUnit&)const{}
};
template<class Sched,int THRL=8> __device__ __forceinline__ void attn_phase(char*lds,const AttnTensors&T,const Sched&S){
  AttnUnit u;
  for(int i=0;S.next(i,u);++i){ S.a_ready(u);
    const int vh=u.bh&1, mp=(u.bh>>1)&1, h=(u.bh>>2)&3, b=u.bh>>4, hm=h*2+mp;
    attn_unit<THRL>(b, 1536+hm*64, 2048+hm*64, 2560+h*128+vh*64, hm*128+vh*64, u.qb, T.P, T.O, lds); S.done(u); }
}
#undef SBAR
#undef WAIT_BAR
}

namespace xattn {
using attn_body::bf16x8; using attn_body::s16x4; using attn_body::f32x16; using attn_body::u32x4; using attn_body::lds_cptr;
constexpr int SLOT = 32768;
#define XWAIT_BAR() asm volatile("s_waitcnt vmcnt(0) lgkmcnt(0)\n\ts_barrier":::"memory")
__device__ __forceinline__ int crow(int r,int hi){return (r&3)+8*(r>>2)+4*hi;}
__device__ __forceinline__ void xattn_unit(int tile, int head, const bf16_t* __restrict__ QC, const bf16_t* __restrict__ KVM, bf16_t* __restrict__ OC, char* shm, float* wsf) {
    const int tid = threadIdx.x, lane = tid & 63, r32 = lane & 31, hi = lane >> 5; const int wid = __builtin_amdgcn_readfirstlane(tid >> 6);
    const int row0 = tile * 256 + wid * 32, b = tile >> 4;
    const bf16_t* Kb = KVM + (size_t)(b * 256) * 2048 + head * 256; const bf16_t* Vb = Kb + 1024;
    const unsigned lds0 = (unsigned)(uintptr_t)shm;
    const lds_cptr shm3 = (lds_cptr)shm;
#pragma unroll
    for (int t = 0; t < 4; ++t)
#pragma unroll
        for (int i = 0; i < 4; ++i) { const int p = wid + 8 * i;
            attn_body::glds16(Kb + (size_t)(64 * t + lane) * 2048 + p * 8, (unsigned)__builtin_amdgcn_readfirstlane(lds0 + t * SLOT + p * 1024)); }
    f32x16 s[4][2];
    const bf16_t* qp = QC + (size_t)(row0 + r32) * 1024 + head * 256 + hi * 8;
#pragma unroll
    for (int dh = 0; dh < 2; ++dh) {
        bf16x8 qf[8];
#pragma unroll
        for (int ks = 0; ks < 8; ++ks) qf[ks] = *(const bf16x8*)(qp + dh * 128 + ks * 16);
        if (dh == 0) XWAIT_BAR();
#pragma unroll
        for (int t = 0; t < 4; ++t) {
            const lds_cptr kp = shm3 + t * SLOT + dh * 16384 + hi * 1024 + r32 * 16;
#pragma unroll
            for (int ks = 0; ks < 8; ++ks) {
                const bf16x8 b0 = *(const __attribute__((address_space(3))) bf16x8*)(kp + ks * 2048);
                const bf16x8 b1 = *(const __attribute__((address_space(3))) bf16x8*)(kp + ks * 2048 + 512);
                if (dh == 0 && ks == 0) { const f32x16 z = f32x16{}; s[t][0] = __builtin_amdgcn_mfma_f32_32x32x16_bf16(b0, qf[ks], z, 0, 0, 0); s[t][1] = __builtin_amdgcn_mfma_f32_32x32x16_bf16(b1, qf[ks], z, 0, 0, 0); }
                else { s[t][0] = __builtin_amdgcn_mfma_f32_32x32x16_bf16(b0, qf[ks], s[t][0], 0, 0, 0); s[t][1] = __builtin_amdgcn_mfma_f32_32x32x16_bf16(b1, qf[ks], s[t][1], 0, 0, 0); }
            }
        }
    }
    XWAIT_BAR();
#pragma unroll
    for (int t = 0; t < 4; ++t)
#pragma unroll
        for (int i = 0; i < 4; ++i) { const int p = wid + 8 * i;
            attn_body::glds16(Vb + (size_t)(64 * t + 16 * (p & 3) + (lane >> 2)) * 2048 + (p >> 2) * 32 + (lane & 3) * 8, (unsigned)__builtin_amdgcn_readfirstlane(lds0 + t * SLOT + p * 1024)); }
    float m = s[0][0][0];
#pragma unroll
    for (int t = 0; t < 4; ++t)
#pragma unroll
        for (int h2 = 0; h2 < 2; ++h2)
#pragma unroll
            for (int r = 0; r < 16; ++r) m = fmaxf(m, s[t][h2][r]);
    m = fmaxf(m, __shfl_xor(m, 32));
    float l = 0.f;
#pragma unroll
    for (int t = 0; t < 4; ++t)
#pragma unroll
        for (int h2 = 0; h2 < 2; ++h2)
#pragma unroll
            for (int r = 0; r < 16; ++r) { const float p = __builtin_amdgcn_exp2f(s[t][h2][r] - m); s[t][h2][r] = p; l += p; }
    l += __shfl_xor(l, 32);
    u32x4 pw[4][4];
#pragma unroll
    for (int t = 0; t < 4; ++t)
#pragma unroll
        for (int ks = 0; ks < 4; ++ks) { const int h2 = ks >> 1, o8 = (ks & 1) * 8;
            pw[t][ks] = (u32x4){attn_body::cvtpk_s(s[t][h2][o8 + 0], s[t][h2][o8 + 1]), attn_body::cvtpk_s(s[t][h2][o8 + 2], s[t][h2][o8 + 3]), attn_body::cvtpk_s(s[t][h2][o8 + 4], s[t][h2][o8 + 5]), attn_body::cvtpk_s(s[t][h2][o8 + 6], s[t][h2][o8 + 7])}; }
    if (hi == 0) wsf[r32] = l;
    XWAIT_BAR();
    f32x16 o[8];
#pragma unroll
    for (int d0 = 0; d0 < 8; ++d0) o[d0] = f32x16{};
    const lds_cptr vp0 = shm3 + ((lane >> 4) & 1) * 32 + (lane & 3) * 8 + (4 * hi + ((lane & 15) >> 2)) * 64;
#pragma unroll
    for (int t = 0; t < 4; ++t)
#pragma unroll
        for (int d0 = 0; d0 < 8; ++d0)
#pragma unroll
            for (int ks = 0; ks < 4; ++ks) {
                const s16x4 vl = attn_body::vtr(vp0 + t * SLOT + d0 * 4096 + ks * 1024), vh = attn_body::vtr(vp0 + t * SLOT + d0 * 4096 + ks * 1024 + 512);
                const bf16x8 vf = (bf16x8){vl[0], vl[1], vl[2], vl[3], vh[0], vh[1], vh[2], vh[3]};
                o[d0] = __builtin_amdgcn_mfma_f32_32x32x16_bf16(__builtin_bit_cast(bf16x8, pw[t][ks]), vf, o[d0], 0, 0, 0);
            }
    XWAIT_BAR();
    float rli[16];
#pragma unroll
    for (int r = 0; r < 16; ++r) rli[r] = __builtin_amdgcn_rcpf(wsf[crow(r, hi)]);
    bf16_t* op = OC + (size_t)row0 * 1024 + head * 256 + r32;
#pragma unroll
    for (int d0 = 0; d0 < 8; ++d0)
#pragma unroll
        for (int r = 0; r < 16; ++r) op[(size_t)crow(r, hi) * 1024 + d0 * 32] = f2bf(o[d0][r] * rli[r]);
    asm volatile("s_waitcnt lgkmcnt(0)" ::: "memory");
}
#undef XWAIT_BAR
}


namespace gla {
using attn_body::bf16x8; using attn_body::s16x4; using attn_body::f32x16; using attn_body::u32x4; using attn_body::lds_cptr;
typedef __attribute__((address_space(3))) char* lds_ptr;
typedef unsigned u32x2 __attribute__((ext_vector_type(2)));
constexpr int PITCH = 144;
constexpr int O_QD = 0, O_KI = 9216, O_KDT = 18432, O_V = 27648, O_DEC = 44032, BUF = 44544, O_SSX = 2 * BUF, LDS_USED = O_SSX + 1024;
#define GWAIT_BAR() asm volatile("s_waitcnt vmcnt(0) lgkmcnt(0)\n\ts_barrier":::"memory")
__device__ __forceinline__ int crow(int r,int hi){return (r&3)+8*(r>>2)+4*hi;}
__device__ __forceinline__ bf16x8 pack8f(const f32x16& v, int o) {
    u32x4 w = (u32x4){attn_body::cvtpk_s(v[o + 0], v[o + 1]), attn_body::cvtpk_s(v[o + 2], v[o + 3]), attn_body::cvtpk_s(v[o + 4], v[o + 5]), attn_body::cvtpk_s(v[o + 6], v[o + 7])};
    return __builtin_bit_cast(bf16x8, w);
}
template <bool PC>
__device__ __forceinline__ void gla_run(int rid, const bf16_t* __restrict__ PROJ, const float* __restrict__ GA, const float* __restrict__ w2, const float* __restrict__ b2,
                                        const float* __restrict__ wn, float* __restrict__ AGG, float* __restrict__ DRUN, bf16_t* __restrict__ MIXED, char* shm) {
    const int tid = threadIdx.x, lane = tid & 63, r32 = lane & 31, hi = lane >> 5; const int wid = __builtin_amdgcn_readfirstlane(tid >> 6);
    const int th = wid >> 2, db = wid & 3;
    const int j = rid & 7, h = (rid >> 3) & 3, b = rid >> 5;
    const size_t tb = (size_t)b * SEQ + (size_t)j * 512;
    const unsigned lds0 = (unsigned)(uintptr_t)shm; const lds_ptr shm3 = (lds_ptr)shm;
    const float* w2p_ = w2 + h * 64 + 8 * wid; const float* b2p_ = b2 + h * 64 + 8 * wid;
    const int pl = (lane & ~12) | ((lane & 4) << 1) | ((lane & 8) >> 1);
    const int cpos0 = 16 * (wid >> 1) + 4 * (wid & 1);
    f32x16 S0 = f32x16{}, S1 = f32x16{};
    float gsum[8];
#pragma unroll
    for (int c = 0; c < 8; ++c) gsum[c] = 0.f;
    if (PC) {
        for (int i = 0; i < j; ++i) {
            const float* ag = AGG + (size_t)(rid - j + i) * 8192 + 32 * db + r32; const float* dr = DRUN + (rid - j + i) * 64;
#pragma unroll
            for (int r = 0; r < 16; ++r) { const int ch = crow(r, hi); S0[r] = S0[r] * dr[ch] + ag[ch * 128]; S1[r] = S1[r] * dr[32 + ch] + ag[(32 + ch) * 128]; }
        }
    }
    f32x4 ga0, ga1, ga2, ga3; bf16x8 rq, rk;
#define GLA_LOAD_RAW(n_) do { const size_t t_ = tb + (size_t)(n_) * 64 + lane; const f32x4* gp_ = (const f32x4*)(GA + t_ * 16); ga0 = gp_[0]; ga1 = gp_[1]; ga2 = gp_[2]; ga3 = gp_[3]; \
        if (PC) rq = *(const bf16x8*)(PROJ + t_ * PP + C_GQ + h * 64 + 8 * wid); rk = *(const bf16x8*)(PROJ + t_ * PP + C_GK + h * 64 + 8 * wid); } while (0)
#define GLA_DMA_V(n_, buf_) do { _Pragma("unroll") for (int i_ = 0; i_ < 2; ++i_) { const int p_ = 2 * wid + i_; \
        attn_body::glds16(PROJ + (tb + (size_t)(n_) * 64 + 16 * (p_ & 3) + (lane >> 2)) * PP + C_GV + h * 128 + (p_ >> 2) * 32 + (lane & 3) * 8, (unsigned)__builtin_amdgcn_readfirstlane(lds0 + (buf_) * BUF + O_V + p_ * 1024)); } } while (0)
    GLA_LOAD_RAW(0); GLA_DMA_V(0, 0);
    for (int n = 0; n < 8; ++n) {
        const int buf = n & 1; const lds_ptr B3 = shm3 + buf * BUF;
        float Gc[8];
        {   float z[8];
            const float* w2p = w2p_; const float* b2p = b2p_;
            asm volatile("" : "+s"(w2p), "+s"(b2p));
#pragma unroll
            for (int c = 0; c < 8; ++c) z[c] = b2p[c];
#pragma unroll
            for (int r = 0; r < 16; ++r) { const float g_ = (r < 4) ? ga0[r & 3] : (r < 8) ? ga1[r & 3] : (r < 12) ? ga2[r & 3] : ga3[r & 3];
#pragma unroll
                for (int c = 0; c < 8; ++c) z[c] += g_ * w2p[r * 256 + c]; }
#pragma unroll
            for (int c = 0; c < 8; ++c) Gc[c] = (fminf(z[c], 0.f) - log1pf(__expf(-fabsf(z[c])))) * 0.0625f; }
#pragma unroll
        for (int off = 1; off < 64; off <<= 1)
#pragma unroll
            for (int c = 0; c < 8; ++c) { const float v = __shfl_up(Gc[c], off); if (lane >= off) Gc[c] += v; }
        float Gl[8];
#pragma unroll
        for (int c = 0; c < 8; ++c) { Gl[c] = __shfl(Gc[c], 63); gsum[c] += Gl[c]; }
        {   float kd[8], ki[8], qd[8];
#pragma unroll
            for (int c = 0; c < 8; ++c) { const float kf_ = bf2f((bf16_t)rk[c]); kd[c] = kf_ * __expf(Gl[c] - Gc[c]);
                if (PC) { ki[c] = kf_ * __expf(-Gc[c]); qd[c] = bf2f((bf16_t)rq[c]) * __expf(Gc[c]) * 0.125f; } }
            if (PC) {
                const lds_ptr rowq = B3 + O_QD + lane * PITCH + cpos0 * 2, rowk = B3 + O_KI + lane * PITCH + cpos0 * 2;
                *(__attribute__((address_space(3))) u32x2*)(rowq) = (u32x2){attn_body::cvtpk_s(qd[0], qd[1]), attn_body::cvtpk_s(qd[2], qd[3])};
                *(__attribute__((address_space(3))) u32x2*)(rowq + 16) = (u32x2){attn_body::cvtpk_s(qd[4], qd[5]), attn_body::cvtpk_s(qd[6], qd[7])};
                *(__attribute__((address_space(3))) u32x2*)(rowk) = (u32x2){attn_body::cvtpk_s(ki[0], ki[1]), attn_body::cvtpk_s(ki[2], ki[3])};
                *(__attribute__((address_space(3))) u32x2*)(rowk + 16) = (u32x2){attn_body::cvtpk_s(ki[4], ki[5]), attn_body::cvtpk_s(ki[6], ki[7])};
            }
#pragma unroll
            for (int c = 0; c < 8; ++c) *(__attribute__((address_space(3))) bf16_t*)(B3 + O_KDT + (8 * wid + c) * PITCH + pl * 2) = f2bf(kd[c]);
            if (lane == 63) {
#pragma unroll
                for (int c = 0; c < 8; ++c) ((__attribute__((address_space(3))) float*)(B3 + O_DEC))[8 * wid + c] = __expf(Gl[c]);
            }
        }
        GWAIT_BAR();
        if (n + 1 < 8) { GLA_LOAD_RAW(n + 1); GLA_DMA_V(n + 1, buf ^ 1); }
        const lds_cptr vp = (lds_cptr)B3 + O_V + db * 4096 + ((lane >> 4) & 1) * 32 + (lane & 3) * 8 + (4 * hi + ((lane & 15) >> 2)) * 64;
        bf16x8 vf[4];
#pragma unroll
        for (int ks = 0; ks < 4; ++ks) { const s16x4 vl = attn_body::vtr(vp + ks * 1024), vh = attn_body::vtr(vp + ks * 1024 + 512); vf[ks] = (bf16x8){vl[0], vl[1], vl[2], vl[3], vh[0], vh[1], vh[2], vh[3]}; }
        const __attribute__((address_space(3))) float* decp = (const __attribute__((address_space(3))) float*)(B3 + O_DEC);
        if (PC) {
            bf16x8 qf[4];
#pragma unroll
            for (int ks = 0; ks < 4; ++ks) qf[ks] = *(const __attribute__((address_space(3))) bf16x8*)(B3 + O_QD + (32 * th + r32) * PITCH + (16 * ks + 8 * hi) * 2);
            f32x16 o = f32x16{};
            o = __builtin_amdgcn_mfma_f32_32x32x16_bf16(pack8f(S0, 0), qf[0], o, 0, 0, 0);
            o = __builtin_amdgcn_mfma_f32_32x32x16_bf16(pack8f(S0, 8), qf[1], o, 0, 0, 0);
            o = __builtin_amdgcn_mfma_f32_32x32x16_bf16(pack8f(S1, 0), qf[2], o, 0, 0, 0);
            o = __builtin_amdgcn_mfma_f32_32x32x16_bf16(pack8f(S1, 8), qf[3], o, 0, 0, 0);
#pragma unroll
            for (int kh = 0; kh < 2; ++kh) {
                if (kh <= th) {
                    f32x16 X = f32x16{};
#pragma unroll
                    for (int ks = 0; ks < 4; ++ks) { const bf16x8 kif = *(const __attribute__((address_space(3))) bf16x8*)(B3 + O_KI + (32 * kh + r32) * PITCH + (16 * ks + 8 * hi) * 2);
                        X = __builtin_amdgcn_mfma_f32_32x32x16_bf16(kif, qf[ks], X, 0, 0, 0); }
                    if (kh == th) {
#pragma unroll
                        for (int r = 0; r < 16; ++r) X[r] = (crow(r, hi) <= r32) ? X[r] : 0.f;
                    }
                    o = __builtin_amdgcn_mfma_f32_32x32x16_bf16(vf[2 * kh], pack8f(X, 0), o, 0, 0, 0);
                    o = __builtin_amdgcn_mfma_f32_32x32x16_bf16(vf[2 * kh + 1], pack8f(X, 8), o, 0, 0, 0);
                }
            }
#pragma unroll
            for (int r = 0; r < 16; ++r) { S0[r] *= decp[crow(r, hi)]; S1[r] *= decp[32 + crow(r, hi)]; }
#pragma unroll
            for (int ks = 0; ks < 4; ++ks) {
                const bf16x8 k0 = *(const __attribute__((address_space(3))) bf16x8*)(B3 + O_KDT + r32 * PITCH + (16 * ks + 8 * hi) * 2);
                const bf16x8 k1 = *(const __attribute__((address_space(3))) bf16x8*)(B3 + O_KDT + (32 + r32) * PITCH + (16 * ks + 8 * hi) * 2);
                S0 = __builtin_amdgcn_mfma_f32_32x32x16_bf16(k0, vf[ks], S0, 0, 0, 0);
                S1 = __builtin_amdgcn_mfma_f32_32x32x16_bf16(k1, vf[ks], S1, 0, 0, 0);
            }
            float ss = 0.f;
#pragma unroll
            for (int r = 0; r < 16; ++r) ss += o[r] * o[r];
            ss += __shfl_xor(ss, 32);
            __attribute__((address_space(3))) float* ssx = (__attribute__((address_space(3))) float*)(shm3 + O_SSX);
            if (hi == 0) ssx[(th * 4 + db) * 32 + r32] = ss;
            asm volatile("s_waitcnt lgkmcnt(0)\n\ts_barrier" ::: "memory");
            const float tot = (ssx[(th * 4 + 0) * 32 + r32] + ssx[(th * 4 + 1) * 32 + r32]) + (ssx[(th * 4 + 2) * 32 + r32] + ssx[(th * 4 + 3) * 32 + r32]);
            const float rn = rsqrtf(tot * (1.f / 128.f) + EPS);
            const size_t t = tb + (size_t)n * 64 + 32 * th + r32;
#pragma unroll
            for (int r4 = 0; r4 < 4; ++r4) {
                const int dv0 = 32 * db + 8 * r4 + 4 * hi;
                const u32x2 gg = *(const u32x2*)(PROJ + t * PP + C_GG + h * 128 + dv0); const f32x4 wv = *(const f32x4*)(wn + dv0);
                const float g0 = __uint_as_float(gg.x << 16), g1 = __uint_as_float(gg.x & 0xffff0000u), g2 = __uint_as_float(gg.y << 16), g3 = __uint_as_float(gg.y & 0xffff0000u);
                u32x2 ov; ov.x = attn_body::cvtpk_s(o[4 * r4 + 0] * rn * wv[0] * silu(g0), o[4 * r4 + 1] * rn * wv[1] * silu(g1));
                ov.y = attn_body::cvtpk_s(o[4 * r4 + 2] * rn * wv[2] * silu(g2), o[4 * r4 + 3] * rn * wv[3] * silu(g3));
                *(u32x2*)(MIXED + t * D + h * 128 + dv0) = ov;
            }
        } else {
#pragma unroll
            for (int r = 0; r < 16; ++r) S0[r] *= decp[32 * th + crow(r, hi)];
#pragma unroll
            for (int ks = 0; ks < 4; ++ks) {
                const bf16x8 k0 = *(const __attribute__((address_space(3))) bf16x8*)(B3 + O_KDT + (32 * th + r32) * PITCH + (16 * ks + 8 * hi) * 2);
                S0 = __builtin_amdgcn_mfma_f32_32x32x16_bf16(k0, vf[ks], S0, 0, 0, 0);
            }
        }
    }
    if (!PC) {
        float* ag = AGG + (size_t)rid * 8192 + 32 * db + r32;
#pragma unroll
        for (int r = 0; r < 16; ++r) ag[(32 * th + crow(r, hi)) * 128] = S0[r];
        if (lane == 0) {
#pragma unroll
            for (int c = 0; c < 8; ++c) DRUN[rid * 64 + 8 * wid + c] = __expf(gsum[c]);
        }
    }
    GWAIT_BAR();
#undef GLA_LOAD_RAW
#undef GLA_DMA_V
}
#undef GWAIT_BAR
}
#ifndef LAS
#define LAS __attribute__((address_space(3)))
#endif

namespace thin {
typedef unsigned v4u __attribute__((ext_vector_type(4)));
typedef unsigned v2u __attribute__((ext_vector_type(2)));
__device__ __forceinline__ unsigned pk2(float lo, float hi) { return (unsigned)f2bf(lo) | ((unsigned)f2bf(hi) << 16); }
template <int MODE>
__device__ __forceinline__ void transpose_item(const float* __restrict__ W, int K, int Nsrc, int nblk, bf16_t* __restrict__ WT, const float* __restrict__ kscale, LAS float* scr, int item, int lane) {
    const int kb = item / nblk, nb = item % nblk, k0 = 64 * kb, n0 = 32 * nb;
    const int n = n0 + (lane & 31); const int c = MODE == 1 ? win_src_col(n) : n;
#pragma unroll 8
    for (int i = 0; i < 32; ++i) { const int kk = 2 * i + (lane >> 5); float v = 0.f; if (c >= 0) { v = W[(size_t)(k0 + kk) * Nsrc + c]; if (kscale) v *= kscale[k0 + kk]; } scr[kk * 33 + (lane & 31)] = v; }
    asm volatile("s_waitcnt lgkmcnt(0)" ::: "memory");
    const int cch = lane & 7;
#pragma unroll
    for (int j = 0; j < 4; ++j) { const int nn = (lane >> 3) + 8 * j; const LAS float* q = scr + (8 * cch) * 33 + nn;
        v4u o; o.x = pk2(q[0 * 33], q[1 * 33]); o.y = pk2(q[2 * 33], q[3 * 33]); o.z = pk2(q[4 * 33], q[5 * 33]); o.w = pk2(q[6 * 33], q[7 * 33]);
        *(v4u*)(WT + (size_t)(n0 + nn) * K + k0 + 8 * cch) = o; }
    asm volatile("s_waitcnt lgkmcnt(0)" ::: "memory");
}
__device__ __forceinline__ void rms_row_to_bf16(const float* __restrict__ xrow, const float* __restrict__ w, bf16_t* __restrict__ orow, int lane) {
    const f32x4* xr = (const f32x4*)xrow + lane;
    f32x4 v[4]; float ss = 0.f;
#pragma unroll
    for (int j = 0; j < 4; ++j) { v[j] = xr[64 * j]; ss += (v[j].x * v[j].x + v[j].y * v[j].y) + (v[j].z * v[j].z + v[j].w * v[j].w); }
    const float r = rsqrtf(wave_sum(ss) * (1.f / D) + EPS);
    v2u* o8 = (v2u*)orow + lane;
#pragma unroll
    for (int j = 0; j < 4; ++j) { const f32x4 ww = ((const f32x4*)w)[lane + 64 * j]; v2u o; o.x = pk2(v[j].x * r * ww.x, v[j].y * r * ww.y); o.y = pk2(v[j].z * r * ww.z, v[j].w * r * ww.w); o8[64 * j] = o; }
}
}
constexpr int NWAVES = 8;
constexpr int RING_BYTES = 131072;
constexpr int LDSCTL_OFF = RING_BYTES, MISC_OFF = LDSCTL_OFF + 320;
constexpr int LDS_BYTES = 147456;
constexpr int CW_BAR = 4096;
constexpr size_t CTL_ZERO_BYTES = 64 * 1024;
#define GAS __attribute__((address_space(1)))
typedef unsigned short bf16;
typedef unsigned v4u __attribute__((ext_vector_type(4)));
typedef float f32x4 __attribute__((ext_vector_type(4)));
typedef short bf16x8 __attribute__((ext_vector_type(8)));
typedef GAS unsigned gu32;
typedef GAS unsigned long long gu64;
#define RLX_AGENT __ATOMIC_RELAXED, __HIP_MEMORY_SCOPE_AGENT
#define LDS_WAIT() asm volatile("s_waitcnt lgkmcnt(0)" ::: "memory")
#define VM_WAIT() asm volatile("s_waitcnt vmcnt(0)" ::: "memory")
__device__ __forceinline__ unsigned long long rt() { return __builtin_amdgcn_s_memrealtime(); }
__device__ __forceinline__ unsigned pk2(float lo, float hi) { return (unsigned)f2bf(lo) | ((unsigned)f2bf(hi) << 16); }

#define XB_TMO      128
#define XB_XCNT(j)  (256  + 64 * (j))
#define XB_XSUB(j)  (1280 + 64 * (j))
#define XB_XGEN(j)  (2304 + 64 * (j))
#define XB_TOP      3328
#define XB_TOPGEN   3392
#define XCD_BAR_WORDS 3456
#define XB_SPIN_CAP (1u << 18)

__device__ __forceinline__ unsigned xb_ld(unsigned* p)              { return __hip_atomic_load(p, __ATOMIC_RELAXED, __HIP_MEMORY_SCOPE_AGENT); }
__device__ __forceinline__ unsigned xb_add(unsigned* p, unsigned v) { return __hip_atomic_fetch_add(p, v, __ATOMIC_RELAXED, __HIP_MEMORY_SCOPE_AGENT); }
__device__ __forceinline__ unsigned xb_xcc_id() { return (unsigned)__builtin_amdgcn_s_getreg((3 << 11) | 20) & 0xFu; }
#define XB_SPIN(cond, bar) do { unsigned _sp = 0; while (cond) { __builtin_amdgcn_s_sleep(1); \
    if ((++_sp & 255u) == 0u) { if (xb_ld(&(bar)[XB_TMO])) break; if (_sp > XB_SPIN_CAP) { atomicAdd(&(bar)[XB_TMO], 1u); break; } } } } while (0)

struct XcdBarrier {
    unsigned* bar; unsigned x;
    volatile LAS unsigned* st;
};

__device__ __forceinline__ XcdBarrier xcd_barrier_post(unsigned* bar, volatile LAS unsigned* st) {
    XcdBarrier b; b.bar = bar; b.x = xb_xcc_id(); b.st = st;
    if (threadIdx.x == 0) (void)xb_add(&bar[XB_XCNT(b.x)], 1u);
    return b;
}
__device__ __forceinline__ void xcd_barrier_complete(unsigned* bar, unsigned x, unsigned& nloc, unsigned& nx) {
    const unsigned G = gridDim.x * gridDim.y * gridDim.z;
    unsigned sum, cnt, mine, sp = 0u;
    for (;;) {
        sum = 0u; cnt = 0u; mine = 0u;
#pragma unroll
        for (unsigned j = 0; j < 16; ++j) { const unsigned c = xb_ld(&bar[XB_XCNT(j)]); sum += c; cnt += (c > 0u) ? 1u : 0u; mine = (j == x) ? c : mine; }
        if (sum == G) break;
        __builtin_amdgcn_s_sleep(1);
        if ((++sp & 255u) == 0u) { if (xb_ld(&bar[XB_TMO])) break; if (sp > XB_SPIN_CAP) { atomicAdd(&bar[XB_TMO], 1u); break; } }
    }
    nloc = mine > 0u ? mine : 1u; nx = cnt > 0u ? cnt : 1u;
}

__device__ __forceinline__ void xcd_barrier(const XcdBarrier& b) {
    asm volatile("s_waitcnt vmcnt(0)" ::: "memory");
    __syncthreads();
    if (threadIdx.x == 0) {
        unsigned* bar = b.bar;
        __builtin_amdgcn_s_waitcnt(0);
        unsigned nloc = b.st[0], nx = b.st[1];
        if (nloc == 0u) { xcd_barrier_complete(bar, b.x, nloc, nx); b.st[0] = nloc; b.st[1] = nx; }
        const unsigned old = xb_add(&bar[XB_XSUB(b.x)], 1u);
        const unsigned gen = old / nloc;
        if (old + 1u == (gen + 1u) * nloc) {
            __builtin_amdgcn_fence(__ATOMIC_RELEASE, "agent");
            asm volatile("s_waitcnt vmcnt(0)" ::: "memory");
            const unsigned og = xb_add(&bar[XB_TOP], 1u);
            const unsigned tg = og / nx;
            if (og + 1u == (tg + 1u) * nx) xb_add(&bar[XB_TOPGEN], 1u);
            else XB_SPIN(xb_ld(&bar[XB_TOPGEN]) == tg, bar);
            __builtin_amdgcn_fence(__ATOMIC_ACQUIRE, "agent");
            xb_add(&bar[XB_XGEN(b.x)], 1u);
            asm volatile("s_waitcnt vmcnt(0)" ::: "memory");
        } else {
            XB_SPIN(xb_ld(&bar[XB_XGEN(b.x)]) == gen, bar);
            __builtin_amdgcn_fence(__ATOMIC_ACQUIRE, "agent");
            asm volatile("s_waitcnt vmcnt(0)" ::: "memory");
        }
    }
    __syncthreads();
}

#ifndef PHMASK
#define PHMASK 0xffff
#endif
struct Args { const void* in[20]; float* out; unsigned char* ws; int ph_lo, ph_hi; };
enum Phase { PH_PRO = 0, PH_INPROJ = 1, PH_MIX = 4, PH_FIN = 9, PH_ATTN = 2, PH_OUTPROJ = 5, PH_CQ = 6, PH_XATTN = 7, PH_CO = 8, PH_END = 10 };
constexpr int LDS_WSCR = RING_BYTES + 1024;

__global__ void __launch_bounds__(NWAVES * 64, 2) mk_fwd(Args args) {
    extern __shared__ __attribute__((aligned(16))) unsigned char lds[];
    LAS unsigned char* L = (LAS unsigned char*)lds;
    const int tid = threadIdx.x;
    unsigned char* ws = args.ws;
    for (int u = tid; u < (LDS_BYTES - LDSCTL_OFF) / 4; u += NWAVES * 64) ((LAS unsigned*)(L + LDSCTL_OFF))[u] = 0u;
    __syncthreads();
    const int G = gridDim.x;
    XcdBarrier bar = xcd_barrier_post((unsigned*)(ws + WS_CTL) + CW_BAR, (volatile LAS unsigned*)(L + MISC_OFF) + 8);
#define WSP(T_, off) ((T_*)(ws + (off)))
    const int lo = args.ph_lo, hi = args.ph_hi;
#define IN(k) (lo <= (k) && (k) < hi && ((PHMASK >> (k)) & 1))
#define SEAM(k) do { if ((k) + 1 < hi) xcd_barrier(bar); } while (0)
    if (IN(PH_PRO)) {
        const int wave = __builtin_amdgcn_readfirstlane(tid >> 6), lane = tid & 63;
        const int gw = (int)blockIdx.x * NWAVES + wave, NGW = G * NWAVES;
        LAS float* scr = (LAS float*)(L + wave * 16384);
        constexpr int I_IN = 16 * (NP / 32), I_SQ = 16 * (D / 32), I_KV = 16 * (2 * D / 32);
        for (int it = gw; it < I_IN + 3 * I_SQ + I_KV; it += NGW) {
            int r = it;
            if (r < I_IN) { thin::transpose_item<1>((const float*)args.in[4], D, D_IN, NP / 32, WSP(bf16_t, WS_WIN), nullptr, scr, r, lane); continue; } r -= I_IN;
            if (r < I_SQ) { thin::transpose_item<0>((const float*)args.in[13], D, D, D / 32, WSP(bf16_t, WS_WOUT), nullptr, scr, r, lane); continue; } r -= I_SQ;
            if (r < I_SQ) { thin::transpose_item<0>((const float*)args.in[16], D, D, D / 32, WSP(bf16_t, WS_WCQ), (const float*)args.in[14], scr, r, lane); continue; } r -= I_SQ;
            if (r < I_SQ) { thin::transpose_item<0>((const float*)args.in[18], D, D, D / 32, WSP(bf16_t, WS_WCO), nullptr, scr, r, lane); continue; } r -= I_SQ;
            thin::transpose_item<0>((const float*)args.in[17], D, 2 * D, 2 * D / 32, WSP(bf16_t, WS_WCKV), nullptr, scr, r, lane);
        }
        for (int m = gw; m < T; m += NGW) thin::rms_row_to_bf16((const float*)args.in[0] + (size_t)m * D, (const float*)args.in[3], WSP(bf16_t, WS_XN) + (size_t)m * D, lane);
        for (int m = gw; m < TM; m += NGW) thin::rms_row_to_bf16((const float*)args.in[1] + (size_t)m * D, (const float*)args.in[15], WSP(bf16_t, WS_MEMN) + (size_t)m * D, lane);
        { const int gt = (int)blockIdx.x * (NWAVES * 64) + tid, NGT = G * NWAVES * 64;
          float* cs = WSP(float, WS_ROPE); float* sn = cs + T * 8; float* rss = WSP(float, WS_MISC); const int* pos = (const int*)args.in[2];
          for (int i = gt; i < T * 8; i += NGT) {
              const int t = i >> 3, j = i & 7;
              double f = 1.0;
              f = (j == 1) ? 0.19392274474868576 : f; f = (j == 2) ? 0.03760603093086393 : f; f = (j == 3) ? 0.007292664737217109 : f; f = (j == 4) ? 0.001414213562373095 : f;
              f = (j == 5) ? 0.0002742481756762073 : f; f = (j == 6) ? 5.318295896944988e-05 : f; f = (j == 7) ? 1.031338537721246e-05 : f;
              float c, sv; sincos_d((double)pos[t] * f, c, sv); cs[i] = c; sn[i] = sv;
          }
          for (int i = gt; i < 2 * T; i += NGT) rss[i] = 0.f;
          if (gt == 0) { const float* q1 = (const float*)args.in[8]; const float* k1 = (const float*)args.in[9]; const float* q2 = (const float*)args.in[10]; const float* k2 = (const float*)args.in[11];
              float a = 0.f, b = 0.f; for (int u = 0; u < 64; ++u) { a += q1[u] * k1[u]; b += q2[u] * k2[u]; } rss[2 * T] = expf(a) - expf(b) + 0.2f; } }
        SEAM(PH_PRO);
    }
    if (IN(PH_INPROJ)) {
        { pg8::Gemm g{WSP(bf16_t, WS_XN), WSP(bf16_t, WS_WIN), T, NP, D}; pg8::StaticOrder S; S.init(T, NP, G, (int)blockIdx.x);
          pg8::EpiInProj E{WSP(bf16_t, WS_PROJ), WSP(float, WS_GA), WSP(float, WS_ROPE), WSP(float, WS_ROPE) + T * 8};
          pg8::gemm_phase<pg8::EpiInProj, pg8::StaticOrder, true, true>(L, g, S, E); }
#ifndef NO_KVM
        { pg8::Gemm g{WSP(bf16_t, WS_MEMN), WSP(bf16_t, WS_WCKV), TM, 2 * D, D}; pg8::StaticOrder S; S.init(TM, 2 * D, G, (int)blockIdx.x);
          pg8::EpiBf16<0> E{WSP(bf16_t, WS_KVM), 2 * D, nullptr, 0, 0, 1.f};
          pg8::gemm_phase<pg8::EpiBf16<0>, pg8::StaticOrder, true, true>(L, g, S, E); }
#endif
        SEAM(PH_INPROJ);
    }
    if (IN(PH_ATTN)) {
        { const int vcu = (G % 8 == 0) ? ((int)blockIdx.x % 8) * (G / 8) + (int)blockIdx.x / 8 : (int)blockIdx.x;
          for (int rid = vcu; rid < 256; rid += G)
              gla::gla_run<false>(rid, WSP(bf16_t, WS_PROJ), WSP(float, WS_GA), (const float*)args.in[5], (const float*)args.in[6], (const float*)args.in[7], WSP(float, WS_KVC), WSP(float, WS_ST), WSP(bf16_t, WS_MIXED), (char*)lds); }
        const attn_body::AttnTensors AT{WSP(const attn_body::bf16, WS_PROJ), WSP(attn_body::bf16, WS_OD)};
        const attn_body::StaticOrder S(G, (int)blockIdx.x);
        attn_body::attn_phase<attn_body::StaticOrder>((char*)lds, AT, S);
        SEAM(PH_ATTN);
    }
    if (IN(PH_MIX)) {
        const int wave = __builtin_amdgcn_readfirstlane(tid >> 6), lane = tid & 63;
        const int gw = (int)blockIdx.x * NWAVES + wave, NGW = G * NWAVES;
        { const int vcu = (G % 8 == 0) ? ((int)blockIdx.x % 8) * (G / 8) + (int)blockIdx.x / 8 : (int)blockIdx.x;
          for (int rid = vcu; rid < 256; rid += G)
              gla::gla_run<true>(rid, WSP(bf16_t, WS_PROJ), WSP(float, WS_GA), (const float*)args.in[5], (const float*)args.in[6], (const float*)args.in[7], WSP(float, WS_KVC), WSP(float, WS_ST), WSP(bf16_t, WS_MIXED), (char*)lds); }
        const bf16_t* od = WSP(bf16_t, WS_OD); const bf16_t* proj = WSP(bf16_t, WS_PROJ); bf16_t* mixed = WSP(bf16_t, WS_MIXED);
        const float lm = WSP(float, WS_MISC)[2 * T]; const float* w = (const float*)args.in[12];
        const float w0 = w[2 * lane] * 0.8f, w1 = w[2 * lane + 1] * 0.8f;
        for (int it = gw; it < T * 4; it += NGW) {
            const int h = it & 3; const size_t t = it >> 2;
            const unsigned a1 = *(const unsigned*)(od + t * D + (2 * h) * 128 + 2 * lane), a2 = *(const unsigned*)(od + t * D + (2 * h + 1) * 128 + 2 * lane);
            const unsigned gg = *(const unsigned*)(proj + t * PP + C_DG + h * 128 + 2 * lane);
            const float d0 = __uint_as_float(a1 << 16) - lm * __uint_as_float(a2 << 16), d1 = __uint_as_float(a1 & 0xffff0000u) - lm * __uint_as_float(a2 & 0xffff0000u);
            const float r = rsqrtf(wave_sum(d0 * d0 + d1 * d1) * (1.f / 128) + EPS);
            const float g0 = __uint_as_float(gg << 16), g1 = __uint_as_float(gg & 0xffff0000u);
            *(unsigned*)(mixed + t * D + 512 + h * 128 + 2 * lane) = thin::pk2(d0 * r * w0 * silu(g0), d1 * r * w1 * silu(g1));
        }
        SEAM(PH_MIX);
    }
    if (IN(PH_OUTPROJ)) {
        pg8::Gemm g{WSP(bf16_t, WS_MIXED), WSP(bf16_t, WS_WOUT), T, D, D}; pg8::StaticOrder S; S.init(T, D, G, (int)blockIdx.x);
        pg8::EpiOutProj E{(const float*)args.in[0], args.out, WSP(bf16_t, WS_X1B), WSP(float, WS_MISC)};
        pg8::gemm_phase<pg8::EpiOutProj, pg8::StaticOrder, true, true>(L, g, S, E);
        SEAM(PH_OUTPROJ);
    }
    if (IN(PH_CQ)) {
        pg8::Gemm g{WSP(bf16_t, WS_X1B), WSP(bf16_t, WS_WCQ), T, D, D}; pg8::StaticOrder S; S.init(T, D, G, (int)blockIdx.x);
        pg8::EpiCq E{WSP(bf16_t, WS_QC), WSP(float, WS_MISC)};
        pg8::gemm_phase<pg8::EpiCq, pg8::StaticOrder, true, true>(L, g, S, E);
        SEAM(PH_CQ);
    }
    if (IN(PH_XATTN)) {
        const int vcu = (G % 8 == 0) ? ((int)blockIdx.x % 8) * (G / 8) + (int)blockIdx.x / 8 : (int)blockIdx.x;
        float* wsf = (float*)(lds + LDS_WSCR) + (tid >> 6) * 64;
        for (int id = vcu; id < 512; id += G) xattn::xattn_unit(id >> 2, id & 3, WSP(bf16_t, WS_QC), WSP(bf16_t, WS_KVM), WSP(bf16_t, WS_OC), (char*)lds, wsf);
        SEAM(PH_XATTN);
    }
    if (IN(PH_CO)) {
        pg8::Gemm g{WSP(bf16_t, WS_OC), WSP(bf16_t, WS_WCO), T, D, D}; pg8::StaticOrder S; S.init(T, D, G, (int)blockIdx.x);
        pg8::EpiCo E{args.out, WSP(float, WS_MISC) + T};
        pg8::gemm_phase<pg8::EpiCo, pg8::StaticOrder, true, true>(L, g, S, E);
        SEAM(PH_CO);
    }
    if (IN(PH_FIN)) {
        const int wave = __builtin_amdgcn_readfirstlane(tid >> 6), lane = tid & 63;
        const int gw = (int)blockIdx.x * NWAVES + wave, NGW = G * NWAVES;
        const float* rss2 = WSP(float, WS_MISC) + T; const float* w = (const float*)args.in[19];
        f32x4 ww[4];
#pragma unroll
        for (int j = 0; j < 4; ++j) ww[j] = ((const f32x4*)w)[lane + 64 * j];
        for (int m = gw; m < T; m += NGW) {
            const float r = rsqrtf(rss2[m] * (1.f / D) + EPS);
            f32x4* xr = (f32x4*)(args.out + (size_t)m * D);
#pragma unroll
            for (int j = 0; j < 4; ++j) { f32x4 v = xr[lane + 64 * j]; v = v * ww[j] * r; xr[lane + 64 * j] = v; }
        }
    }
#undef IN
#undef SEAM
}

extern "C" void kernel_launch(void* const* d_in, const int* in_sizes, int n_in, void* d_out, int out_size, void* d_ws, size_t ws_size, hipStream_t stream) {
    if (n_in != 20 || in_sizes[0] != T * D || out_size != T * D || ws_size < WS_END) { fprintf(stderr, "kernel_launch: unexpected shapes / workspace (%d inputs, ws %zu)\n", n_in, ws_size); return; }
    const float* x = (const float*)d_in[0]; const float* mem = (const float*)d_in[1]; const int* pos = (const int*)d_in[2];
    const float* norm_mix_w = (const float*)d_in[3]; const float* w_in = (const float*)d_in[4]; const float* w_alpha2 = (const float*)d_in[5];
    const float* b_alpha2 = (const float*)d_in[6]; const float* gla_norm_w = (const float*)d_in[7];
    const float* lq1 = (const float*)d_in[8]; const float* lk1 = (const float*)d_in[9]; const float* lq2 = (const float*)d_in[10]; const float* lk2 = (const float*)d_in[11];
    const float* diff_norm_w = (const float*)d_in[12]; const float* w_out = (const float*)d_in[13]; const float* norm_cross_w = (const float*)d_in[14];
    const float* norm_mem_w = (const float*)d_in[15]; const float* w_cq = (const float*)d_in[16]; const float* w_ckv = (const float*)d_in[17];
    const float* w_co = (const float*)d_in[18]; const float* final_norm_w = (const float*)d_in[19];
    float* out = (float*)d_out; unsigned char* ws = (unsigned char*)d_ws;
    bf16_t* WIN = (bf16_t*)(ws + WS_WIN); bf16_t* WOUT = (bf16_t*)(ws + WS_WOUT); bf16_t* WCQ = (bf16_t*)(ws + WS_WCQ); bf16_t* WCO = (bf16_t*)(ws + WS_WCO); bf16_t* WCKV = (bf16_t*)(ws + WS_WCKV);
    bf16_t* MEMN = (bf16_t*)(ws + WS_MEMN); bf16_t* KVM = (bf16_t*)(ws + WS_KVM); float* GA = (float*)(ws + WS_GA);
    float* CS = (float*)(ws + WS_ROPE); float* SN = CS + T * 8; float* RSS = (float*)(ws + WS_MISC); float* RSS2 = RSS + T; float* LAM = RSS + 2 * T;
    bf16_t* XN = (bf16_t*)(ws + WS_XN); bf16_t* MIXED = (bf16_t*)(ws + WS_MIXED); bf16_t* PROJ = (bf16_t*)(ws + WS_PROJ);
    bf16_t* X1B = (bf16_t*)(ws + WS_X1B); bf16_t* QC = (bf16_t*)(ws + WS_QC); bf16_t* OC = (bf16_t*)(ws + WS_OC); bf16_t* OD = (bf16_t*)(ws + WS_OD);
    float* GO = (float*)(ws + WS_KVC); float* G = (float*)(ws + WS_ST);

    auto nb = [](size_t n, int b) { return (unsigned)((n + b - 1) / b); };
    static int grid = 0;
    if (grid == 0) {
        int dev = 0, cus = 0;
        if (hipGetDevice(&dev) != hipSuccess || hipDeviceGetAttribute(&cus, hipDeviceAttributeMultiprocessorCount, dev) != hipSuccess) { fprintf(stderr, "kernel_launch: device query failed\n"); grid = -1; return; }
        if (hipFuncSetAttribute((const void*)mk_fwd, hipFuncAttributeMaxDynamicSharedMemorySize, LDS_BYTES) != hipSuccess) { fprintf(stderr, "kernel_launch: hipFuncSetAttribute failed\n"); grid = -1; return; }
        grid = cus;
        if (grid != 256) fprintf(stderr, "kernel_launch: %d CUs (expected 256)\n", grid);
    }
    if (grid < 0) return;
    (void)hipMemsetAsync((char*)d_ws + WS_CTL, 0, CTL_ZERO_BYTES, stream);
    Args a{};
    for (int i = 0; i < 20; ++i) a.in[i] = d_in[i];
    a.out = out; a.ws = ws;
#define MK(p) do { a.ph_lo = (p); a.ph_hi = (p) + 1; hipLaunchKernelGGL(mk_fwd, dim3(grid), dim3(NWAVES * 64), LDS_BYTES, stream, a); } while (0)
#ifdef MULTI_LAUNCH
    MK(PH_PRO); MK(PH_INPROJ); MK(PH_ATTN); MK(PH_MIX); MK(PH_OUTPROJ); MK(PH_CQ); MK(PH_XATTN); MK(PH_CO); MK(PH_FIN);
#else
    a.ph_lo = 0; a.ph_hi = PH_END;
    hipLaunchKernelGGL(mk_fwd, dim3(grid), dim3(NWAVES * 64), LDS_BYTES, stream, a);
#endif
}
```

```cpp
#include <hip/hip_runtime.h>
#include <cstdio>
#include <cstdint>

typedef unsigned short bf16_t;
typedef short bf16x8 __attribute__((ext_vector_type(8)));
typedef float f32x4 __attribute__((ext_vector_type(4)));

constexpr int BATCH = 8, SEQ = 4096, D = 1024, T = BATCH * SEQ;
constexpr int MEM_LEN = 256, TM = BATCH * MEM_LEN;
constexpr int D_IN = 3600, NP = 3840, PP = 3584;
constexpr float EPS = 1e-6f;
constexpr int C_GQ = 0, C_GK = 256, C_GV = 512, C_GG = 1024, C_DQ = 1536, C_DK = 2048, C_DV = 2560, C_DG = 3072, C_GA = 3584;

constexpr size_t MiB = 1u << 20;
constexpr size_t WS_CTL = 0;
constexpr size_t WS_WIN = 1 * MiB;
constexpr size_t WS_WOUT = 9 * MiB;
constexpr size_t WS_WCQ = 11 * MiB;
constexpr size_t WS_WCO = 13 * MiB;
constexpr size_t WS_WCKV = 15 * MiB;
constexpr size_t WS_MEMN = 20 * MiB;
constexpr size_t WS_KVM = 24 * MiB;
constexpr size_t WS_GA = 32 * MiB;
constexpr size_t WS_ROPE = 34 * MiB;
constexpr size_t WS_MISC = 36 * MiB;
constexpr size_t WS_XN = 40 * MiB;
constexpr size_t WS_MIXED = WS_XN;
constexpr size_t WS_PROJ = 104 * MiB;
constexpr size_t WS_X1B = WS_PROJ, WS_QC = WS_PROJ + 64 * MiB, WS_OC = WS_PROJ + 128 * MiB;
constexpr size_t WS_OD = 328 * MiB;
constexpr size_t WS_KVC = 392 * MiB;
constexpr size_t WS_ST = 456 * MiB;
constexpr size_t WS_END = 488 * MiB;

__device__ __forceinline__ bf16_t f2bf(float f) { unsigned u = __float_as_uint(f); return (bf16_t)((u + 0x7fffu + ((u >> 16) & 1u)) >> 16); }
__device__ __forceinline__ float bf2f(bf16_t h) { return __uint_as_float(((unsigned)h) << 16); }
__device__ __forceinline__ float wave_sum(float v) {
#pragma unroll
    for (int o = 1; o < 64; o <<= 1) v += __shfl_xor(v, o);
    return v;
}
__device__ __forceinline__ float silu(float x) { return x / (1.f + __expf(-x)); }

__device__ __forceinline__ int win_src_col(int n) { return n < 1536 ? n : (n < 3584 ? n + 16 : (n < 3600 ? n - 3584 + 1536 : -1)); }
__global__ void k_prep_w(const float* __restrict__ W, int K, int Nsrc, bf16_t* __restrict__ Wt, int Nout, const float* __restrict__ kscale, int mode) {
    const size_t i = (size_t)blockIdx.x * blockDim.x + threadIdx.x;
    if (i >= (size_t)Nout * K) return;
    const int n = (int)(i / K), k = (int)(i % K);
    const int c = mode == 1 ? win_src_col(n) : n;
    float v = 0.f;
    if (c >= 0) { v = W[(size_t)k * Nsrc + c]; if (kscale) v *= kscale[k]; }
    Wt[i] = f2bf(v);
}
__global__ void k_rmsnorm_rows(const float* __restrict__ x, const float* __restrict__ w, bf16_t* __restrict__ out, int rows) {
    const int row = blockIdx.x * (blockDim.x / 64) + (threadIdx.x >> 6), lane = threadIdx.x & 63;
    if (row >= rows) return;
    const f32x4* xr = (const f32x4*)(x + (size_t)row * D);
    f32x4 v[4]; float s = 0.f;
#pragma unroll
    for (int j = 0; j < 4; ++j) { v[j] = xr[lane + 64 * j]; s += v[j].x * v[j].x + v[j].y * v[j].y + v[j].z * v[j].z + v[j].w * v[j].w; }
    const float r = rsqrtf(wave_sum(s) * (1.f / D) + EPS);
#pragma unroll
    for (int j = 0; j < 4; ++j) {
        const f32x4 ww = ((const f32x4*)w)[lane + 64 * j];
        bf16_t* o = out + (size_t)row * D + 4 * (lane + 64 * j);
        o[0] = f2bf(v[j].x * r * ww.x); o[1] = f2bf(v[j].y * r * ww.y); o[2] = f2bf(v[j].z * r * ww.z); o[3] = f2bf(v[j].w * r * ww.w);
    }
}
__device__ __forceinline__ void sincos_d(double a, float& c, float& s) {
    const double q = rint(a * 0.63661977236758134308);
    double r = fma(-q, 1.5707963267948966, a); r = fma(-q, 6.123233995736766e-17, r);
    const double r2 = r * r;
    double sp = r * (1.0 + r2 * (-1.0 / 6 + r2 * (1.0 / 120 + r2 * (-1.0 / 5040 + r2 * (1.0 / 362880 + r2 * (-1.0 / 39916800 + r2 * (1.0 / 6227020800.0)))))));
    double cp = 1.0 + r2 * (-0.5 + r2 * (1.0 / 24 + r2 * (-1.0 / 720 + r2 * (1.0 / 40320 + r2 * (-1.0 / 3628800 + r2 * (1.0 / 479001600.0 + r2 * (-1.0 / 87178291200.0)))))));
    const int qi = ((int)(long long)q) & 3;
    double cc = (qi == 0) ? cp : (qi == 1) ? -sp : (qi == 2) ? -cp : sp;
    double ss = (qi == 0) ? sp : (qi == 1) ? cp : (qi == 2) ? -sp : -cp;
    c = (float)cc; s = (float)ss;
}
__global__ void k_rope_tab(const int* __restrict__ pos, float* __restrict__ cs, float* __restrict__ sn, float* __restrict__ lam,
                           const float* q1, const float* k1, const float* q2, const float* k2, float* rss) {
    const int i = blockIdx.x * blockDim.x + threadIdx.x;
    if (i < T * 8) {
        const int t = i >> 3, j = i & 7;
        const double invf[8] = {1.0, 0.19392274474868576, 0.03760603093086393, 0.007292664737217109, 0.001414213562373095, 0.0002742481756762073, 5.318295896944988e-05, 1.031338537721246e-05};
        double f = invf[0];
#pragma unroll
        for (int u = 1; u < 8; ++u) f = (j == u) ? invf[u] : f;
        float c, s; sincos_d((double)pos[t] * f, c, s);
        cs[i] = c; sn[i] = s;
    }
    if (i < 2 * T) rss[i] = 0.f;
    if (i == 0) {
        float a = 0.f, b = 0.f;
        for (int u = 0; u < 64; ++u) { a += q1[u] * k1[u]; b += q2[u] * k2[u]; }
        lam[0] = expf(a) - expf(b) + 0.2f;
    }
}

template <class Epi>
__global__ void __launch_bounds__(256) k_gemm(const bf16_t* __restrict__ A, const bf16_t* __restrict__ Bt, int M, int N, int K, Epi epi) {
    const int lane = threadIdx.x & 63, wid = threadIdx.x >> 6, wr = wid >> 1, wc = wid & 1;
    const int m0 = blockIdx.y * 64 + wr * 32, n0 = blockIdx.x * 64 + wc * 32;
    const int fr = lane & 15, fq = lane >> 4;
    f32x4 acc[2][2];
#pragma unroll
    for (int i = 0; i < 2; ++i)
#pragma unroll
        for (int j = 0; j < 2; ++j) acc[i][j] = (f32x4){0.f, 0.f, 0.f, 0.f};
    const bf16_t* ap = A + (size_t)(m0 + fr) * K + 8 * fq;
    const bf16_t* bp = Bt + (size_t)(n0 + fr) * K + 8 * fq;
    for (int k0 = 0; k0 < K; k0 += 32) {
        bf16x8 a[2], b[2];
#pragma unroll
        for (int i = 0; i < 2; ++i) { a[i] = *(const bf16x8*)(ap + (size_t)i * 16 * K + k0); b[i] = *(const bf16x8*)(bp + (size_t)i * 16 * K + k0); }
#pragma unroll
        for (int i = 0; i < 2; ++i)
#pragma unroll
            for (int j = 0; j < 2; ++j) acc[i][j] = __builtin_amdgcn_mfma_f32_16x16x32_bf16(a[i], b[j], acc[i][j], 0, 0, 0);
    }
#pragma unroll
    for (int i = 0; i < 2; ++i)
#pragma unroll
        for (int j = 0; j < 2; ++j)
#pragma unroll
            for (int r = 0; r < 4; ++r) epi(m0 + i * 16 + fq * 4 + r, n0 + j * 16 + fr, acc[i][j][r]);
}
struct EpiInProj { bf16_t* proj; float* ga;
    __device__ __forceinline__ void operator()(int m, int n, float v) const { if (n < PP) proj[(size_t)m * PP + n] = f2bf(v); else if (n < PP + 16) ga[m * 16 + n - PP] = v; } };
struct EpiBf16Plain { bf16_t* o; int ld;
    __device__ __forceinline__ void operator()(int m, int n, float v) const { o[(size_t)m * ld + n] = f2bf(v); } };
struct EpiOutProj { const float* x; float* x1; bf16_t* x1b; float* rss;
    __device__ __forceinline__ void operator()(int m, int n, float v) const { const size_t i = (size_t)m * D + n; const float y = x[i] + v; x1[i] = y; x1b[i] = f2bf(y); atomicAdd(rss + m, y * y); } };
struct EpiCq { bf16_t* qc; const float* rss;
    __device__ __forceinline__ void operator()(int m, int n, float v) const { qc[(size_t)m * D + n] = f2bf(v * rsqrtf(rss[m] * (1.f / D) + EPS) * (0.0625f * 1.4426950408889634f)); } };
struct EpiCo { float* x12; float* rss2;
    __device__ __forceinline__ void operator()(int m, int n, float v) const { const size_t i = (size_t)m * D + n; const float y = x12[i] + v; x12[i] = y; atomicAdd(rss2 + m, y * y); } };

__global__ void k_rope(bf16_t* __restrict__ proj, const float* __restrict__ cs, const float* __restrict__ sn) {
    const int i = blockIdx.x * blockDim.x + threadIdx.x;
    if (i >= T * 128) return;
    const int j = i & 7, hm = (i >> 3) & 7, wh = (i >> 6) & 1, t = i >> 7;
    bf16_t* b = proj + (size_t)t * PP + (wh ? C_DK : C_DQ) + hm * 64;
    const float r1 = bf2f(b[j]), r2 = bf2f(b[j + 8]), c = cs[t * 8 + j], s = sn[t * 8 + j];
    b[j] = f2bf(r1 * c - r2 * s); b[j + 8] = f2bf(r2 * c + r1 * s);
}

__global__ void k_gla_gate(const float* __restrict__ ga, const float* __restrict__ w2, const float* __restrict__ b2, float* __restrict__ G) {
    const int i = blockIdx.x * blockDim.x + threadIdx.x;
    if (i >= T * 256) return;
    const int c = i & 255, t = i >> 8;
    float z = b2[c];
#pragma unroll
    for (int r = 0; r < 16; ++r) z += ga[t * 16 + r] * w2[r * 256 + c];
    const float ls = fminf(z, 0.f) - log1pf(expf(-fabsf(z)));
    G[i] = ls * (1.f / 16.f);
}
__global__ void __launch_bounds__(128) k_gla_rec(const bf16_t* __restrict__ proj, const float* __restrict__ G, float* __restrict__ GO) {
    const int e = threadIdx.x, h = blockIdx.x & 3, b = blockIdx.x >> 2;
    float S[64];
#pragma unroll
    for (int c = 0; c < 64; ++c) S[c] = 0.f;
    for (int s = 0; s < SEQ; ++s) {
        const size_t t = (size_t)b * SEQ + s;
        const bf16x8* q8 = (const bf16x8*)(proj + t * PP + C_GQ + h * 64);
        const bf16x8* k8 = (const bf16x8*)(proj + t * PP + C_GK + h * 64);
        const float v = bf2f(proj[t * PP + C_GV + h * 128 + e]);
        const f32x4* g4 = (const f32x4*)(G + t * 256 + h * 64);
        float o = 0.f;
#pragma unroll
        for (int c8 = 0; c8 < 8; ++c8) {
            const bf16x8 qq = q8[c8], kk = k8[c8]; const f32x4 ga = g4[2 * c8], gb = g4[2 * c8 + 1];
#pragma unroll
            for (int j = 0; j < 8; ++j) { const int c = c8 * 8 + j; const float g = j < 4 ? ga[j] : gb[j - 4];
                S[c] = __expf(g) * S[c] + bf2f((bf16_t)kk[j]) * v; o += bf2f((bf16_t)qq[j]) * S[c]; }
        }
        GO[t * 512 + h * 128 + e] = o * 0.125f;
    }
}
__global__ void k_gla_out(const float* __restrict__ GO, const bf16_t* __restrict__ proj, const float* __restrict__ w, bf16_t* __restrict__ mixed) {
    const int gw = blockIdx.x * (blockDim.x / 64) + (threadIdx.x >> 6), lane = threadIdx.x & 63;
    if (gw >= T * 4) return;
    const int h = gw & 3; const size_t t = gw >> 2;
    const float o0 = GO[t * 512 + h * 128 + lane], o1 = GO[t * 512 + h * 128 + 64 + lane];
    const float r = rsqrtf(wave_sum(o0 * o0 + o1 * o1) * (1.f / 128) + EPS);
    const float g0 = bf2f(proj[t * PP + C_GG + h * 128 + lane]), g1 = bf2f(proj[t * PP + C_GG + h * 128 + 64 + lane]);
    mixed[t * D + h * 128 + lane] = f2bf(o0 * r * w[lane] * silu(g0));
    mixed[t * D + h * 128 + 64 + lane] = f2bf(o1 * r * w[64 + lane] * silu(g1));
}

__global__ void __launch_bounds__(256) k_diff_attn(const bf16_t* __restrict__ proj, bf16_t* __restrict__ od) {
    const int tid = threadIdx.x, qtr = tid & 3, rl = tid >> 2;
    const int hm = blockIdx.x & 7, chunk = (blockIdx.x >> 3) & 63, b = blockIdx.x >> 9;
    const int h = hm >> 1;
    const size_t t = (size_t)b * SEQ + chunk * 64 + rl;
    float q[64];
    { const bf16x8* qp = (const bf16x8*)(proj + t * PP + C_DQ + hm * 64);
#pragma unroll
      for (int c = 0; c < 8; ++c) { const bf16x8 qq = qp[c];
#pragma unroll
          for (int j = 0; j < 8; ++j) q[c * 8 + j] = bf2f((bf16_t)qq[j]); } }
    float o[32];
#pragma unroll
    for (int i = 0; i < 32; ++i) o[i] = 0.f;
    float m = -INFINITY, l = 0.f;
    const int nk = (chunk + 1) * 64;
    for (int j = 0; j < nk; ++j) {
        const size_t tk = (size_t)b * SEQ + j;
        const bf16x8* kp = (const bf16x8*)(proj + tk * PP + C_DK + hm * 64);
        float s = 0.f;
#pragma unroll
        for (int c = 0; c < 8; ++c) { const bf16x8 kk = kp[c];
#pragma unroll
            for (int j = 0; j < 8; ++j) s += q[c * 8 + j] * bf2f((bf16_t)kk[j]); }
        const float mn = fmaxf(m, s), al = exp2f(m - mn), p = exp2f(s - mn);
        l = l * al + p; m = mn;
        const bf16x8* vp = (const bf16x8*)(proj + tk * PP + C_DV + h * 128 + qtr * 32);
#pragma unroll
        for (int c = 0; c < 4; ++c) { const bf16x8 vv = vp[c];
#pragma unroll
            for (int j = 0; j < 8; ++j) o[c * 8 + j] = o[c * 8 + j] * al + p * bf2f((bf16_t)vv[j]); }
    }
    const float rl_ = 1.f / l;
#pragma unroll
    for (int i = 0; i < 32; ++i) od[t * D + hm * 128 + qtr * 32 + i] = f2bf(o[i] * rl_);
}
__global__ void k_diff_out(const bf16_t* __restrict__ od, const bf16_t* __restrict__ proj, const float* __restrict__ w, const float* __restrict__ lam, bf16_t* __restrict__ mixed) {
    const int gw = blockIdx.x * (blockDim.x / 64) + (threadIdx.x >> 6), lane = threadIdx.x & 63;
    if (gw >= T * 4) return;
    const int h = gw & 3; const size_t t = gw >> 2;
    const float lm = lam[0];
    const bf16_t* o1 = od + t * D + (2 * h) * 128; const bf16_t* o2 = o1 + 128;
    const float d0 = bf2f(o1[lane]) - lm * bf2f(o2[lane]), d1 = bf2f(o1[64 + lane]) - lm * bf2f(o2[64 + lane]);
    const float r = rsqrtf(wave_sum(d0 * d0 + d1 * d1) * (1.f / 128) + EPS);
    const float g0 = bf2f(proj[t * PP + C_DG + h * 128 + lane]), g1 = bf2f(proj[t * PP + C_DG + h * 128 + 64 + lane]);
    mixed[t * D + 512 + h * 128 + lane] = f2bf(d0 * r * w[lane] * 0.8f * silu(g0));
    mixed[t * D + 512 + h * 128 + 64 + lane] = f2bf(d1 * r * w[64 + lane] * 0.8f * silu(g1));
}

__global__ void __launch_bounds__(256) k_cross_attn(const bf16_t* __restrict__ qc, const bf16_t* __restrict__ kvm, bf16_t* __restrict__ oc) {
    __shared__ float sp[16][257];
    __shared__ float sl[16];
    const int tid = threadIdx.x, head = blockIdx.x & 3, tile = blockIdx.x >> 2;
    const size_t t0 = (size_t)tile * 16; const int b = (int)(t0 / SEQ);
    const bf16_t* kp = kvm + (size_t)(b * MEM_LEN + tid) * 2048 + head * 256;
    float acc[16];
#pragma unroll
    for (int r = 0; r < 16; ++r) acc[r] = 0.f;
    for (int d = 0; d < 256; ++d) {
        const float kv = bf2f(kp[d]);
#pragma unroll
        for (int r = 0; r < 16; ++r) acc[r] += kv * bf2f(qc[(t0 + r) * D + head * 256 + d]);
    }
#pragma unroll
    for (int r = 0; r < 16; ++r) sp[r][tid] = acc[r];
    __syncthreads();
    { const int w = tid >> 6, lane = tid & 63;
      for (int r = w * 4; r < w * 4 + 4; ++r) {
          float mx = -INFINITY;
          for (int j = lane; j < 256; j += 64) mx = fmaxf(mx, sp[r][j]);
#pragma unroll
          for (int o = 1; o < 64; o <<= 1) mx = fmaxf(mx, __shfl_xor(mx, o));
          float sum = 0.f;
          for (int j = lane; j < 256; j += 64) { const float p = exp2f(sp[r][j] - mx); sp[r][j] = p; sum += p; }
          sum = wave_sum(sum);
          if (lane == 0) sl[r] = sum;
      } }
    __syncthreads();
#pragma unroll
    for (int r = 0; r < 16; ++r) acc[r] = 0.f;
    const bf16_t* vp = kvm + (size_t)(b * MEM_LEN) * 2048 + 1024 + head * 256 + tid;
    for (int j = 0; j < 256; ++j) {
        const float v = bf2f(vp[(size_t)j * 2048]);
#pragma unroll
        for (int r = 0; r < 16; ++r) acc[r] += sp[r][j] * v;
    }
#pragma unroll
    for (int r = 0; r < 16; ++r) oc[(t0 + r) * D + head * 256 + tid] = f2bf(acc[r] / sl[r]);
}
__global__ void k_final_norm(float* __restrict__ x2, const float* __restrict__ rss2, const float* __restrict__ w) {
    const int row = blockIdx.x * (blockDim.x / 64) + (threadIdx.x >> 6), lane = threadIdx.x & 63;
    if (row >= T) return;
    const float r = rsqrtf(rss2[row] * (1.f / D) + EPS);
    f32x4* xr = (f32x4*)(x2 + (size_t)row * D);
#pragma unroll
    for (int j = 0; j < 4; ++j) { f32x4 v = xr[lane + 64 * j]; const f32x4 ww = ((const f32x4*)w)[lane + 64 * j]; v.x *= r * ww.x; v.y *= r * ww.y; v.z *= r * ww.z; v.w *= r * ww.w; xr[lane + 64 * j] = v; }
}


namespace pg8 {
#define PG8_LAS __attribute__((address_space(3)))
typedef unsigned short bf16_t;
typedef short bf16x8 __attribute__((ext_vector_type(8)));
typedef float f32x4 __attribute__((ext_vector_type(4)));
typedef unsigned u32x4 __attribute__((ext_vector_type(4)));
constexpr int BM = 256, BK = 64, HALF = 128, HTB = HALF * BK * 2  , STAGE_BYTES = 8 * HTB, NXCD = 8, WGM = 8;

__host__ __device__ __forceinline__ int lds_byte(int r, int c) { const int st = (r >> 4) * 2 + (c >> 5), rr = r & 15, cc = c & 31, ob = rr * 64 + cc * 2; return st * 1024 + (ob ^ (((ob >> 9) & 1) << 5)); }
__host__ __device__ __forceinline__ void stage_rc(int b, int& R, int& C) { const int st = b / 1024, sb = b % 1024, swz = sb ^ (((sb >> 9) & 1) << 5); R = (st >> 1) * 16 + swz / 64; C = (st & 1) * 32 + (swz % 64) / 2; }
__host__ __device__ __forceinline__ int perm32(int rho) { const int n = rho >> 4, i = rho & 15; return 8 * (i >> 2) + 4 * n + (i & 3); }

struct Unit { int pm, pn; };
struct Gemm { const bf16_t* A; const bf16_t* Bt; int M, N, K; };

struct StaticOrder {
    int nM, nN, nwg, G, c;
    __host__ __device__ void init(int M, int N, int G_, int c_) { nM = M / BM; nN = N / BM; nwg = nM * nN; G = G_; c = c_; }
    __host__ __device__ bool next(int i, Unit& u) const {
        const long L = (long)i * G + c; if (L >= nwg) return false;
        int wgid = (int)L; { const int q = nwg / NXCD, r = nwg % NXCD, xcd = wgid % NXCD, off = wgid / NXCD; wgid = (xcd < r ? xcd * (q + 1) : r * (q + 1) + (xcd - r) * q) + off; }
        const int nig = WGM * nN, gid = wgid / nig, fm = gid * WGM, gsz = (nM - fm) < WGM ? (nM - fm) : WGM;
        u.pm = fm + ((wgid % nig) % gsz); u.pn = (wgid % nig) / gsz; return true;
    }
    __device__ __forceinline__ void a_ready(const Unit&) const {}
    __device__ __forceinline__ void done(const Unit&) const {}
};

__device__ __forceinline__ unsigned cvt_pk_bf16(float lo, float hi) { unsigned r; asm volatile("v_cvt_pk_bf16_f32 %0, %1, %2" : "=v"(r) : "v"(lo), "v"(hi)); return r; }
typedef float f32x2 __attribute__((ext_vector_type(2)));
__device__ __forceinline__ f32x2 gelu_pk(f32x2 v) {
    const f32x2 av = __builtin_elementwise_abs(v), d = av * 0.2316418882f + 1.0f;
    f32x2 t; t.x = __builtin_amdgcn_rcpf(d.x); t.y = __builtin_amdgcn_rcpf(d.y);
    f32x2 q = t * 0.5307027145f + (-0.7265760135f); q = q * t + 0.7107068705f; q = q * t + (-0.142248368f); q = q * t + 0.127414796f; q = q * t;
    const f32x2 s = (v * v) * (-0.72134752044f);
    f32x2 e; e.x = __builtin_amdgcn_exp2f(s.x); e.y = __builtin_amdgcn_exp2f(s.y);
    const f32x2 m = v * (q * e), r = v - m;
    f32x2 o; o.x = v.x < 0.f ? m.x : r.x; o.y = v.y < 0.f ? m.y : r.y; return o;
}

template <int ACT  > struct EpiBf16 {
    static constexpr bool PERM = true, AFTER_DRAIN = false; static_assert(ACT == 0 || ACT == 1, "EpiBf16: ACT is 0 (none) or 1 (gelu_pk)");
    bf16_t* O; int ldc; const float* bias; int split_cols; size_t split_stride; float scale0;
    __device__ __forceinline__ void operator()(const f32x4 (&acc)[2][2][4][2], const Unit& u, int wr, int wc, int fr, int fq) const {
        asm volatile("" : "+v"(fr), "+v"(fq));
        const int row0 = u.pm * BM + wr * 64 + fr; int colt = u.pn * BM; bf16_t* base = O;
        float sc = 1.f; if (split_cols) { const int t = colt / split_cols; base += (size_t)t * split_stride; colt -= t * split_cols; if (t == 0) sc = scale0; }
        const int col0 = colt + wc * 32 + 8 * fq, bcol0 = u.pn * BM + wc * 32 + 8 * fq;
        f32x4 bv[2][2];
#pragma unroll
        for (int bj = 0; bj < 2; ++bj)
#pragma unroll
            for (int n = 0; n < 2; ++n) bv[bj][n] = bias ? *(const f32x4*)(bias + bcol0 + bj * HALF + 4 * n) : (f32x4){0.f, 0.f, 0.f, 0.f};
#pragma unroll
        for (int ai = 0; ai < 2; ++ai)
#pragma unroll
            for (int m = 0; m < 4; ++m) { bf16_t* rowp = base + (size_t)(row0 + ai * HALF + m * 16) * ldc + col0;
#pragma unroll
                for (int bj = 0; bj < 2; ++bj) { f32x4 v0 = acc[ai][bj][m][0] + bv[bj][0], v1 = acc[ai][bj][m][1] + bv[bj][1];
                    if (ACT == 1) { f32x2 a = gelu_pk((f32x2){v0[0], v0[1]}), b = gelu_pk((f32x2){v0[2], v0[3]}), c = gelu_pk((f32x2){v1[0], v1[1]}), d = gelu_pk((f32x2){v1[2], v1[3]});
                        v0 = (f32x4){a.x, a.y, b.x, b.y}; v1 = (f32x4){c.x, c.y, d.x, d.y}; }
                    v0 = v0 * sc; v1 = v1 * sc; u32x4 w; w.x = cvt_pk_bf16(v0[0], v0[1]); w.y = cvt_pk_bf16(v0[2], v0[3]); w.z = cvt_pk_bf16(v1[0], v1[1]); w.w = cvt_pk_bf16(v1[2], v1[3]);
                    *(u32x4*)(rowp + bj * HALF) = w; } }
    }
};

constexpr float QC2 = 0.125f * 1.4426950408889634f;
constexpr float QC3 = 0.0625f * 1.4426950408889634f;
constexpr int PPITCH = 3584;
__device__ __forceinline__ u32x4 pack8(const f32x4& v0, const f32x4& v1) { u32x4 w; w.x = cvt_pk_bf16(v0[0], v0[1]); w.y = cvt_pk_bf16(v0[2], v0[3]); w.z = cvt_pk_bf16(v1[0], v1[1]); w.w = cvt_pk_bf16(v1[2], v1[3]); return w; }
struct EpiInProj {
    static constexpr bool PERM = true, AFTER_DRAIN = false;
    bf16_t* proj; float* ga; const float* cs; const float* sn;
    __device__ __forceinline__ void operator()(const f32x4 (&acc)[2][2][4][2], const Unit& u, int wr, int wc, int fr, int fq) const {
        asm volatile("" : "+v"(fr), "+v"(fq));
        const int row0 = u.pm * BM + wr * 64 + fr;
        if (u.pn == 14) {
            if (wc == 0 && fq < 2) {
#pragma unroll
                for (int ai = 0; ai < 2; ++ai)
#pragma unroll
                    for (int m = 0; m < 4; ++m) { float* g = ga + (size_t)(row0 + ai * HALF + m * 16) * 16 + 8 * fq; *(f32x4*)g = acc[ai][0][m][0]; *(f32x4*)(g + 4) = acc[ai][0][m][1]; }
            }
            return;
        }
#ifdef NO_ROPE
        const bool rope = false;
#else
        const bool rope = (u.pn >= 6) && (u.pn <= 9) && ((wc & 1) == 0);
#endif
        const float sc = (u.pn == 6 || u.pn == 7) ? QC2 : 1.f;
        const float sg = (fq == 0) ? -1.f : 1.f;
        const bool rl = fq < 2;
        bf16_t* base = proj + u.pn * BM + wc * 32 + 8 * fq;
#pragma unroll
        for (int ai = 0; ai < 2; ++ai)
#pragma unroll
            for (int m = 0; m < 4; ++m) {
                const int row = row0 + ai * HALF + m * 16;
                f32x4 c0 = (f32x4){1.f, 1.f, 1.f, 1.f}, c1 = c0, s0 = (f32x4){0.f, 0.f, 0.f, 0.f}, s1 = s0;
                if (rope) { c0 = *(const f32x4*)(cs + (size_t)row * 8); c1 = *(const f32x4*)(cs + (size_t)row * 8 + 4); s0 = *(const f32x4*)(sn + (size_t)row * 8); s1 = *(const f32x4*)(sn + (size_t)row * 8 + 4); }
#pragma unroll
                for (int bj = 0; bj < 2; ++bj) {
                    f32x4 v0 = acc[ai][bj][m][0], v1 = acc[ai][bj][m][1];
                    if (rope) {
                        f32x4 p0, p1;
#pragma unroll
                        for (int i = 0; i < 4; ++i) { p0[i] = __shfl_xor(v0[i], 16); p1[i] = __shfl_xor(v1[i], 16); }
                        if (rl) { v0 = v0 * c0 + (p0 * s0) * sg; v1 = v1 * c1 + (p1 * s1) * sg; }
                    }
                    v0 = v0 * sc; v1 = v1 * sc;
                    *(u32x4*)(base + (size_t)row * PPITCH + bj * HALF) = pack8(v0, v1);
                }
                asm volatile("" ::: "memory");
            }
    }
};
struct EpiOutProj {
    static constexpr bool PERM = true, AFTER_DRAIN = false;
    const float* x; float* x1; bf16_t* x1b; float* rss;
    __device__ __forceinline__ void operator()(const f32x4 (&acc)[2][2][4][2], const Unit& u, int wr, int wc, int fr, int fq) const {
        asm volatile("" : "+v"(fr), "+v"(fq));
        const int row0 = u.pm * BM + wr * 64 + fr, col0 = u.pn * BM + wc * 32 + 8 * fq;
#pragma unroll
        for (int ai = 0; ai < 2; ++ai)
#pragma unroll
            for (int m = 0; m < 4; ++m) {
                const int row = row0 + ai * HALF + m * 16; const size_t off = (size_t)row * 1024 + col0; float ss = 0.f;
#pragma unroll
                for (int bj = 0; bj < 2; ++bj) {
                    const f32x4 v0 = acc[ai][bj][m][0] + *(const f32x4*)(x + off + bj * HALF), v1 = acc[ai][bj][m][1] + *(const f32x4*)(x + off + bj * HALF + 4);
                    *(u32x4*)(x1b + off + bj * HALF) = pack8(v0, v1);
                    ss += (v0[0] * v0[0] + v0[1] * v0[1]) + (v0[2] * v0[2] + v0[3] * v0[3]) + (v1[0] * v1[0] + v1[1] * v1[1]) + (v1[2] * v1[2] + v1[3] * v1[3]);
                }
                ss += __shfl_xor(ss, 16); ss += __shfl_xor(ss, 32);
                if (fq == 0) atomicAdd(rss + row, ss);
                asm volatile("" ::: "memory");
            }
    }
};
struct EpiCq {
    static constexpr bool PERM = true, AFTER_DRAIN = false;
    bf16_t* qc; const float* rss;
    __device__ __forceinline__ void operator()(const f32x4 (&acc)[2][2][4][2], const Unit& u, int wr, int wc, int fr, int fq) const {
        asm volatile("" : "+v"(fr), "+v"(fq));
        const int row0 = u.pm * BM + wr * 64 + fr, col0 = u.pn * BM + wc * 32 + 8 * fq;
#pragma unroll
        for (int ai = 0; ai < 2; ++ai)
#pragma unroll
            for (int m = 0; m < 4; ++m) {
                const int row = row0 + ai * HALF + m * 16; const float r = rsqrtf(rss[row] * (1.f / 1024.f) + 1e-6f) * QC3;
#pragma unroll
                for (int bj = 0; bj < 2; ++bj) *(u32x4*)(qc + (size_t)row * 1024 + col0 + bj * HALF) = pack8(acc[ai][bj][m][0] * r, acc[ai][bj][m][1] * r);
            }
    }
};
struct EpiCo {
    static constexpr bool PERM = true, AFTER_DRAIN = false;
    const bf16_t* x1b; float* x12; float* rss2;
    __device__ __forceinline__ void operator()(const f32x4 (&acc)[2][2][4][2], const Unit& u, int wr, int wc, int fr, int fq) const {
        asm volatile("" : "+v"(fr), "+v"(fq));
        const int row0 = u.pm * BM + wr * 64 + fr, col0 = u.pn * BM + wc * 32 + 8 * fq;
#pragma unroll
        for (int ai = 0; ai < 2; ++ai)
#pragma unroll
            for (int m = 0; m < 4; ++m) {
                const int row = row0 + ai * HALF + m * 16; const size_t off = (size_t)row * 1024 + col0; float ss = 0.f;
#pragma unroll
                for (int bj = 0; bj < 2; ++bj) {
                    const u32x4 xr = *(const u32x4*)(x1b + off + bj * HALF);
                    const f32x4 r0 = (f32x4){__uint_as_float(xr.x << 16), __uint_as_float(xr.x & 0xffff0000u), __uint_as_float(xr.y << 16), __uint_as_float(xr.y & 0xffff0000u)};
                    const f32x4 r1 = (f32x4){__uint_as_float(xr.z << 16), __uint_as_float(xr.z & 0xffff0000u), __uint_as_float(xr.w << 16), __uint_as_float(xr.w & 0xffff0000u)};
                    const f32x4 v0 = acc[ai][bj][m][0] + r0, v1 = acc[ai][bj][m][1] + r1;
                    *(f32x4*)(x12 + off + bj * HALF) = v0; *(f32x4*)(x12 + off + bj * HALF + 4) = v1;
                    ss += (v0[0] * v0[0] + v0[1] * v0[1]) + (v0[2] * v0[2] + v0[3] * v0[3]) + (v1[0] * v1[0] + v1[1] * v1[1]) + (v1[2] * v1[2] + v1[3] * v1[3]);
                }
                ss += __shfl_xor(ss, 16); ss += __shfl_xor(ss, 32);
                if (fq == 0) atomicAdd(rss2 + row, ss);
                asm volatile("" ::: "memory");
            }
    }
};
template <class Epi, class Sched, bool ALIGN_EPI = false, bool SP2 = false>
__device__ __forceinline__ void gemm_phase(PG8_LAS unsigned char* lds, const Gemm g, const Sched& S, const Epi& E) {
    const int tid = threadIdx.x, wid = __builtin_amdgcn_readfirstlane(tid >> 6), lane = tid & 63, wr = wid >> 2, wc = wid & 3, fr = lane & 15, fq = lane >> 4;
    const int K = g.K, nt = K / BK;
    unsigned voffA[2], voffB[2];
#pragma unroll
    for (int i = 0; i < 2; ++i) { int R, C; stage_rc(tid * 16 + i * 8192, R, C); const int Rb = Epi::PERM ? ((R & ~31) + perm32(R & 31)) : R;
        voffA[i] = (unsigned)(R * K + C) * 2u; voffB[i] = (unsigned)(Rb * K + C) * 2u; }
    const size_t kstep = (size_t)(BK * 2);
    const size_t hstep = (size_t)HALF * K * 2;
    const size_t tstep = 2 * hstep;
    const unsigned ldsw = (unsigned)wid * 1024u;
    const int aoff = lds_byte(wr * 64 + fr, fq * 8), boff = lds_byte(wc * 32 + fr, fq * 8);
#define PG8_SA(b, h) (((b) * 2 + (h)) * HTB)
#define PG8_SB(b, h) ((4 + (b) * 2 + (h)) * HTB)
#define PG8_STAGE(bufoff, gbase, voff) do { _Pragma("unroll") for (int _i = 0; _i < 2; ++_i) \
        __builtin_amdgcn_global_load_lds((const unsigned*)((const char*)(gbase) + (voff)[_i]), (PG8_LAS unsigned*)(lds + (bufoff) + ldsw + _i * 8192), 16, 0, 0); } while (0)
#define PG8_LDA(dst, b, h) do { _Pragma("unroll") for (int m = 0; m < 4; ++m) _Pragma("unroll") for (int k = 0; k < 2; ++k) dst[m][k] = *(const PG8_LAS bf16x8*)(lds + PG8_SA(b, h) + aoff + m * 2048 + k * 1024); } while (0)
#define PG8_LDB(dst, b, h) do { _Pragma("unroll") for (int n = 0; n < 2; ++n) _Pragma("unroll") for (int k = 0; k < 2; ++k) dst[n][k] = *(const PG8_LAS bf16x8*)(lds + PG8_SB(b, h) + boff + n * 2048 + k * 1024); } while (0)
#define PG8_MMA(ai, bj, At, Bt) do { __builtin_amdgcn_s_setprio(1); _Pragma("unroll") for (int m = 0; m < 4; ++m) _Pragma("unroll") for (int n = 0; n < 2; ++n) _Pragma("unroll") for (int k = 0; k < 2; ++k) \
        acc[ai][bj][m][n] = __builtin_amdgcn_mfma_f32_16x16x32_bf16(Bt[n][k], At[m][k], acc[ai][bj][m][n], 0, 0, 0); __builtin_amdgcn_s_setprio(0); } while (0)
#define PG8_WAIT_V(n) asm volatile("s_waitcnt vmcnt(" #n ")" ::: "memory")
#define PG8_WAIT_L(n) asm volatile("s_waitcnt lgkmcnt(" #n ")" ::: "memory")
#define PG8_BAR __builtin_amdgcn_s_barrier()
#define PG8_SCHED __builtin_amdgcn_sched_barrier(0)
    Unit cur, nxt; int ui = 0;
    if (!S.next(0, cur)) return;
    f32x4 acc[2][2][4][2];
#pragma unroll
    for (int a = 0; a < 2; ++a)
#pragma unroll
        for (int b = 0; b < 2; ++b)
#pragma unroll
            for (int m = 0; m < 4; ++m)
#pragma unroll
                for (int n = 0; n < 2; ++n) acc[a][b][m][n] = (f32x4){0.f, 0.f, 0.f, 0.f};
    bf16x8 At[4][2], B0[2][2], B1[2][2];
    const char* cA = (const char*)g.A + (size_t)cur.pm * tstep; const char* cB = (const char*)g.Bt + (size_t)cur.pn * tstep;
    S.a_ready(cur);
    if constexpr (SP2) {
        PG8_STAGE(PG8_SB(0, 0), cB, voffB); PG8_STAGE(PG8_SB(0, 1), cB + hstep, voffB); PG8_STAGE(PG8_SA(0, 0), cA, voffA); PG8_STAGE(PG8_SA(0, 1), cA + hstep, voffA);
        if (wr == 1) PG8_BAR;
        PG8_WAIT_V(2); PG8_BAR;
        PG8_STAGE(PG8_SB(1, 0), cB + kstep, voffB); PG8_STAGE(PG8_SA(1, 0), cA + kstep, voffA); PG8_STAGE(PG8_SB(1, 1), cB + hstep + kstep, voffB);
        PG8_WAIT_V(6); PG8_BAR;
    } else {
        PG8_STAGE(PG8_SB(0, 0), cB, voffB); PG8_STAGE(PG8_SA(0, 0), cA, voffA); PG8_STAGE(PG8_SB(0, 1), cB + hstep, voffB); PG8_STAGE(PG8_SA(0, 1), cA + hstep, voffA);
        if (wr == 1) PG8_BAR;
        PG8_WAIT_V(4); PG8_BAR;
        PG8_STAGE(PG8_SB(1, 0), cB + kstep, voffB); PG8_STAGE(PG8_SA(1, 0), cA + kstep, voffA); PG8_STAGE(PG8_SB(1, 1), cB + hstep + kstep, voffB);
        PG8_WAIT_V(6); PG8_BAR;
    }
    for (;;) {
        const bool has_next = S.next(ui + 1, nxt);
        const char* nA = has_next ? (const char*)g.A + (size_t)nxt.pm * tstep : cA; const char* nB = has_next ? (const char*)g.Bt + (size_t)nxt.pn * tstep : cB;
        for (int t = 0; t < nt; t += 2) {
            const bool last = (t == nt - 2);
            const char* a1 = cA + (size_t)(t + 1) * kstep;
            const char* a2 = last ? nA : cA + (size_t)(t + 2) * kstep; const char* b2 = last ? nB : cB + (size_t)(t + 2) * kstep;
            const char* a3 = a2 + kstep; const char* b3 = b2 + kstep;
            if (last && has_next) S.a_ready(nxt);
            if constexpr (SP2) {
            PG8_LDB(B0, 0, 0); PG8_LDB(B1, 0, 1); PG8_SCHED; PG8_LDA(At, 0, 0); PG8_STAGE(PG8_SA(1, 1), a1 + hstep, voffA);
            PG8_WAIT_V(8); PG8_WAIT_L(0); PG8_BAR; PG8_MMA(0, 0, At, B0); PG8_MMA(0, 1, At, B1); PG8_BAR; PG8_SCHED;
            PG8_LDA(At, 0, 1); PG8_STAGE(PG8_SB(0, 0), b2, voffB); PG8_STAGE(PG8_SB(0, 1), b2 + hstep, voffB); PG8_STAGE(PG8_SA(0, 0), a2, voffA);
            PG8_WAIT_V(8); PG8_WAIT_L(0); PG8_BAR; PG8_MMA(1, 0, At, B0); PG8_MMA(1, 1, At, B1); PG8_BAR; PG8_SCHED;
            PG8_LDB(B0, 1, 0); PG8_LDB(B1, 1, 1); PG8_SCHED; PG8_LDA(At, 1, 0); PG8_STAGE(PG8_SA(0, 1), a2 + hstep, voffA);
            PG8_WAIT_V(8); PG8_WAIT_L(0); PG8_BAR; PG8_MMA(0, 0, At, B0); PG8_MMA(0, 1, At, B1); PG8_BAR; PG8_SCHED;
            PG8_LDA(At, 1, 1); PG8_STAGE(PG8_SB(1, 0), b3, voffB); PG8_STAGE(PG8_SB(1, 1), b3 + hstep, voffB); PG8_STAGE(PG8_SA(1, 0), a3, voffA);
            PG8_WAIT_V(8); PG8_WAIT_L(0); PG8_BAR; PG8_MMA(1, 0, At, B0); PG8_MMA(1, 1, At, B1); PG8_BAR; PG8_SCHED;
            } else {
            PG8_LDB(B0, 0, 0); PG8_SCHED; PG8_LDA(At, 0, 0); PG8_STAGE(PG8_SA(1, 1), a1 + hstep, voffA);
            PG8_WAIT_L(8); PG8_BAR; PG8_WAIT_L(0); PG8_MMA(0, 0, At, B0); PG8_BAR; PG8_SCHED;
            PG8_LDB(B1, 0, 1); PG8_STAGE(PG8_SB(0, 0), b2, voffB);
            PG8_BAR; PG8_WAIT_L(0); PG8_MMA(0, 1, At, B1); PG8_BAR;
            PG8_LDA(At, 0, 1); PG8_STAGE(PG8_SA(0, 0), a2, voffA);
            PG8_BAR; PG8_WAIT_L(0); PG8_MMA(1, 0, At, B0); PG8_BAR; PG8_SCHED;
            PG8_STAGE(PG8_SB(0, 1), b2 + hstep, voffB);
            PG8_WAIT_V(6); PG8_BAR; PG8_MMA(1, 1, At, B1); PG8_BAR;
            PG8_LDB(B0, 1, 0); PG8_SCHED; PG8_LDA(At, 1, 0); PG8_STAGE(PG8_SA(0, 1), a2 + hstep, voffA);
            PG8_WAIT_L(8); PG8_BAR; PG8_WAIT_L(0); PG8_MMA(0, 0, At, B0); PG8_BAR; PG8_SCHED;
            PG8_LDB(B1, 1, 1); PG8_STAGE(PG8_SB(1, 0), b3, voffB);
            PG8_BAR; PG8_WAIT_L(0); PG8_MMA(0, 1, At, B1); PG8_BAR;
            PG8_LDA(At, 1, 1); PG8_STAGE(PG8_SA(1, 0), a3, voffA);
            PG8_BAR; PG8_WAIT_L(0); PG8_MMA(1, 0, At, B0); PG8_BAR; PG8_SCHED;
            PG8_STAGE(PG8_SB(1, 1), b3 + hstep, voffB);
            PG8_WAIT_V(6); PG8_BAR; PG8_MMA(1, 1, At, B1); PG8_BAR;
            }
        }
        if constexpr (ALIGN_EPI) { if (wr == 0) PG8_BAR; }
        if constexpr (!Epi::AFTER_DRAIN) { E(acc, cur, wr, wc, fr, fq); S.done(cur); }
        if (!has_next) break;
#pragma unroll
        for (int a = 0; a < 2; ++a)
#pragma unroll
            for (int b = 0; b < 2; ++b)
#pragma unroll
                for (int m = 0; m < 4; ++m)
#pragma unroll
                    for (int n = 0; n < 2; ++n) acc[a][b][m][n] = (f32x4){0.f, 0.f, 0.f, 0.f};
        cur = nxt; cA = nA; cB = nB; ++ui;
        if constexpr (ALIGN_EPI) { if (wr == 1) PG8_BAR; }
    }
    PG8_WAIT_V(0);
    if constexpr (!ALIGN_EPI) { if (wr == 0) PG8_BAR; }
    PG8_BAR;
    if constexpr (Epi::AFTER_DRAIN) { E.fused(acc, cur, wr, wc, fr, fq, lds, wid, lane); S.done(cur); }
#undef PG8_SA
#undef PG8_SB
#undef PG8_STAGE
#undef PG8_LDA
#undef PG8_LDB
#undef PG8_MMA
#undef PG8_WAIT_V
#undef PG8_WAIT_L
#undef PG8_BAR
#undef PG8_SCHED
}
}

#ifndef PG8_SP2
#define PG8_SP2 true
#endif
#ifndef PG8_ALIGN
#define PG8_ALIGN true
#endif

#include <hip/hip_bf16.h>
#include <cmath>
namespace attn_body {
using bf16=__hip_bfloat16;
using bf16x8=__attribute__((ext_vector_type(8)))short;
using s16x4=__attribute__((ext_vector_type(4)))short;
using f32x16=__attribute__((ext_vector_type(16)))float;
using u32x4=__attribute__((ext_vector_type(4)))unsigned;
constexpr int SEQ=4096,D=64,PQ=3584,PO=1024;
constexpr int NW=8,QBLK=32,QB=QBLK*NW,KVBLK=64,NQB=SEQ/QB;
constexpr int ATTN_UNIT_ROWS=QB;
__device__ __forceinline__ int crow(int r,int hi){return (r&3)+8*(r>>2)+4*hi;}
#define SBAR() __builtin_amdgcn_sched_barrier(0)
__device__ __forceinline__ void cmask(f32x16&p0,f32x16&p1,int jb,int qrel,int hi){
  const float NEG=-INFINITY;
  if(jb>(qrel>>6)){
  #pragma unroll
  for(int r=0;r<16;++r){p0[r]=NEG;p1[r]=NEG;}}
}

constexpr int NSLOT=3, SLOTB=8192;
constexpr int LDS_K=0, LDS_V=NSLOT*SLOTB, LDS_WS=2*NSLOT*SLOTB, LDS_OST=LDS_WS+NW*64*4, LDS_BYTES=LDS_OST+NW*4096;
constexpr float C2=0.125f*1.4426950408889634f;
__device__ __forceinline__ void glds16(const void*gsrc,unsigned lds_dst){unsigned keep;
  asm volatile("s_mov_b32 %0, m0\n\ts_mov_b32 m0, %2\n\ts_nop 0\n\tglobal_load_lds_dwordx4 %1, off\n\ts_mov_b32 m0, %0":"=&s"(keep):"v"(gsrc),"s"(lds_dst):"memory");}
__device__ __forceinline__ float max3f(float a,float b,float c){float r;asm("v_max3_f32 %0, %1, %2, %3":"=v"(r):"v"(a),"v"(b),"v"(c));return r;}
__device__ __forceinline__ float max2f(float a,float b){float r;asm("v_max_f32_e32 %0, %1, %2":"=v"(r):"v"(a),"v"(b));return r;}
__device__ __forceinline__ float fadd_s(float a,float b){float r;asm("v_add_f32_e32 %0, %1, %2":"=v"(r):"v"(a),"v"(b));return r;}
__device__ __forceinline__ float fsub_s(float a,float b){float r;asm("v_sub_f32_e32 %0, %1, %2":"=v"(r):"v"(a),"v"(b));return r;}
typedef float f32x2_t __attribute__((ext_vector_type(2))); typedef __bf16 bf16x2_t __attribute__((ext_vector_type(2)));
__device__ __forceinline__ unsigned cvtpk_s(float lo,float hi){f32x2_t v={lo,hi};bf16x2_t b=__builtin_convertvector(v,bf16x2_t);return __builtin_bit_cast(unsigned,b);}
#define WAIT_BAR(N) asm volatile("s_waitcnt vmcnt(" #N ") lgkmcnt(0)\n\ts_barrier":::"memory")

__device__ __forceinline__ void qkt(f32x16&p0,f32x16&p1,const char*Kslot,const bf16x8*qr,const f32x16&negm,int r32,int hi){
  const char*kb=Kslot+hi*1024+r32*16;
  #pragma unroll
  for(int d0=0;d0<4;++d0){
    const bf16x8 b0=*reinterpret_cast<const bf16x8*>(kb+d0*2048);
    const bf16x8 b1=*reinterpret_cast<const bf16x8*>(kb+d0*2048+512);
    if(d0==0){p0=__builtin_amdgcn_mfma_f32_32x32x16_bf16(b0,qr[0],negm,0,0,0);p1=__builtin_amdgcn_mfma_f32_32x32x16_bf16(b1,qr[0],negm,0,0,0);}
    else{p0=__builtin_amdgcn_mfma_f32_32x32x16_bf16(b0,qr[d0],p0,0,0,0);p1=__builtin_amdgcn_mfma_f32_32x32x16_bf16(b1,qr[d0],p1,0,0,0);}}
}
typedef __attribute__((address_space(3))) const char* lds_cptr;
typedef short v4i16_t __attribute__((ext_vector_type(4)));
__device__ __forceinline__ void kload8(bf16x8*kf,lds_cptr kp){
  kf[0]=*(const __attribute__((address_space(3))) bf16x8*)(kp);      kf[1]=*(const __attribute__((address_space(3))) bf16x8*)(kp+512);
  kf[2]=*(const __attribute__((address_space(3))) bf16x8*)(kp+2048); kf[3]=*(const __attribute__((address_space(3))) bf16x8*)(kp+2560);
  kf[4]=*(const __attribute__((address_space(3))) bf16x8*)(kp+4096); kf[5]=*(const __attribute__((address_space(3))) bf16x8*)(kp+4608);
  kf[6]=*(const __attribute__((address_space(3))) bf16x8*)(kp+6144); kf[7]=*(const __attribute__((address_space(3))) bf16x8*)(kp+6656);
}
__device__ __forceinline__ void kload2(bf16x8*kf,lds_cptr kp,int j){ kf[2*j]=*(const __attribute__((address_space(3))) bf16x8*)(kp+j*2048); kf[2*j+1]=*(const __attribute__((address_space(3))) bf16x8*)(kp+j*2048+512); }
__device__ __forceinline__ s16x4 vtr(lds_cptr p){ return __builtin_bit_cast(s16x4,__builtin_amdgcn_ds_read_tr16_b64_v4i16((__attribute__((address_space(3))) v4i16_t*)p)); }
__device__ __forceinline__ float rowmax(const f32x16&p0,const f32x16&p1){
  float a=max3f(p0[0],p0[1],p1[0]),b=max3f(p0[2],p0[3],p1[1]);a=max3f(a,p1[2],p1[3]);
  #pragma unroll
  for(int r=4;r<16;r+=4){a=max3f(a,p0[r],p0[r+1]);b=max3f(b,p0[r+2],p0[r+3]);a=max3f(a,p1[r],p1[r+1]);b=max3f(b,p1[r+2],p1[r+3]);}
  const float m=max2f(a,b);
  auto rr=__builtin_amdgcn_permlane32_swap(__float_as_uint(m),__float_as_uint(m),false,false);
  return max2f(__uint_as_float(rr[0]),__uint_as_float(rr[1]));
}
__device__ __forceinline__ void pv(f32x16*o,int vb,bf16x8 pa0,bf16x8 pa1,bf16x8 pa2,bf16x8 pa3){
  #pragma unroll
  for(int d0=0;d0<2;++d0){s16x4 lo[4],hi[4];
    #pragma unroll
    for(int ks=0;ks<4;++ks){
      asm volatile("ds_read_b64_tr_b16 %0,%1 offset:%c2":"=&v"(lo[ks]):"v"(vb),"i"(d0*4096+ks*1024):"memory");
      asm volatile("ds_read_b64_tr_b16 %0,%1 offset:%c2":"=&v"(hi[ks]):"v"(vb),"i"(d0*4096+ks*1024+512):"memory");}
    asm volatile("s_waitcnt lgkmcnt(0)":::"memory");SBAR();
    #define PK(k) (bf16x8){lo[k][0],lo[k][1],lo[k][2],lo[k][3],hi[k][0],hi[k][1],hi[k][2],hi[k][3]}
    o[d0]=__builtin_amdgcn_mfma_f32_32x32x16_bf16(pa0,PK(0),o[d0],0,0,0);
    o[d0]=__builtin_amdgcn_mfma_f32_32x32x16_bf16(pa1,PK(1),o[d0],0,0,0);
    o[d0]=__builtin_amdgcn_mfma_f32_32x32x16_bf16(pa2,PK(2),o[d0],0,0,0);
    o[d0]=__builtin_amdgcn_mfma_f32_32x32x16_bf16(pa3,PK(3),o[d0],0,0,0);
    #undef PK
  }
}

#ifndef ATTN_STORE16
#define ATTN_STORE16(p,v) (*(u32x4*)(p)=(v))
#endif
template<int THRL> __device__ __forceinline__ void attn_unit(int b,int qcol,int kcol,int vcol,int ocol,int qb,const bf16*__restrict__ P,bf16*O,char*shm){
  const int tid=threadIdx.x,lane=tid&63,r32=lane&31,hi=lane>>5; const int wid=__builtin_amdgcn_readfirstlane(tid>>6);
  const long rowbase=(long)b*SEQ; const int q0=qb*QB;
  const bf16*Qw=P+(rowbase+q0+wid*QBLK)*PQ+qcol;
  const bf16*Kh=P+rowbase*PQ+kcol,*Vh=P+rowbase*PQ+vcol;
  const unsigned lds0=(unsigned)(uintptr_t)shm;
  float*wsf=(float*)(shm+LDS_WS)+wid*64;
  const bf16*ksrc=Kh+(long)lane*PQ+wid*8;
  const bf16*vsrc=Vh+(long)(16*(wid&3)+(lane>>2))*PQ+(wid>>2)*32+(lane&3)*8;
  const unsigned kdst=lds0+LDS_K+wid*1024, vdst=lds0+LDS_V+wid*1024;
  #define DMA_K(t,slot) glds16(ksrc+(long)(t)*KVBLK*PQ,(unsigned)__builtin_amdgcn_readfirstlane(kdst+(slot)))
  #define DMA_V(t,slot) glds16(vsrc+(long)(t)*KVBLK*PQ,(unsigned)__builtin_amdgcn_readfirstlane(vdst+(slot)))
  const int vb0=(int)(lds0+LDS_V)+((lane>>4)&1)*32+(lane&3)*8+(4*hi+((lane&15)>>2))*64;
  const char*Kbase=shm+LDS_K; bf16x8 kf[8];
  const lds_cptr shm3=(lds_cptr)shm; const lds_cptr kp0=shm3+LDS_K+hi*1024+r32*16; const lds_cptr vp0=shm3+LDS_V+((lane>>4)&1)*32+(lane&3)*8+(4*hi+((lane&15)>>2))*64;
  const int NT=(q0+QB)/KVBLK;
  DMA_K(0,0);DMA_V(0,0);DMA_K(1,SLOTB);
  bf16x8 qr[4];
  #pragma unroll
  for(int d0=0;d0<4;++d0)qr[d0]=*reinterpret_cast<const bf16x8*>(&Qw[(long)r32*PQ+d0*16+hi*8]);
  float mhat=0.f,l_reg=0.f;f32x16 o[2];o[0]=f32x16{};o[1]=f32x16{};f32x16 negm=f32x16{};asm volatile("":"+v"(negm));
  const int qrel=wid*QBLK+r32;
  #define CMASK(P0,P1,t) do{int jb_=(t)-(NT-4); if(jb_>=0)cmask(P0,P1,jb_,qrel,hi);}while(0)
  bool resc=false;
  #define START(P0,P1) do{ const float rm=rowmax(P0,P1); resc=false; \
    { const float dl=rm; mhat=fadd_s(mhat,dl); \
      _Pragma("unroll") for(int r=0;r<16;++r){P0[r]=fsub_s(P0[r],dl);P1[r]=fsub_s(P1[r],dl);} \
      _Pragma("unroll") for(int r=0;r<16;++r)negm[r]=-mhat; asm volatile("":"+v"(negm)); } \
    _Pragma("unroll") for(int r=0;r<16;++r)P0[r]=__builtin_amdgcn_exp2f(P0[r]); }while(0)
  #define RESC() do{ if(resc){ asm volatile("s_waitcnt lgkmcnt(0)":::"memory"); \
      _Pragma("unroll") for(int d_=0;d_<2;++d_) _Pragma("unroll") for(int r=0;r<16;++r)o[d_][r]*=wsf[crow(r,hi)]; } }while(0)
  f32x16 pA0,pA1,pB0,pB1;
  int sl_prev=0,sl_cur=0,sl_next=SLOTB;
  #define ROT() do{sl_prev=sl_cur;sl_cur=sl_next;sl_next=(sl_next==(NSLOT-1)*SLOTB)?0:sl_next+SLOTB;}while(0)
  DMA_K(2,2*SLOTB);
  WAIT_BAR(3);
  qkt(pA0,pA1,Kbase,qr,negm,r32,hi);asm volatile("s_nop 15\n\ts_nop 7":"+v"(pA0),"+v"(pA1));CMASK(pA0,pA1,0);
  START(pA0,pA1);
  _Pragma("unroll") for(int r=0;r<16;++r)pA1[r]=__builtin_amdgcn_exp2f(pA1[r]);
  WAIT_BAR(0);
  DMA_K(3,0);DMA_V(1,SLOTB);
  ROT();
  kload8(kf,kp0+sl_cur);
  WAIT_BAR(2);
  s16x4 vlo[8],vhi[8]; u32x4 pw0,pw1,pw2,pw3;
  #define PKW(P,B) cvtpk_s(P[B],P[B+1])
  #define PAF(k) __builtin_bit_cast(bf16x8,pw##k)
  #define VFR(i) (bf16x8){vlo[i][0],vlo[i][1],vlo[i][2],vlo[i][3],vhi[i][0],vhi[i][1],vhi[i][2],vhi[i][3]}
  #define PIN(x) asm volatile("":"+v"(x))
  #define MX3(a,b,c) __builtin_fmaxf(__builtin_fmaxf((a),(b)),(c))
  #define GAPA(MF,A0,A1,A2,A3,W0,W1,PW) do{ MF; sacc+=A0; sacc+=A1; sacc+=A2; sacc+=A3; PIN(sacc); W0; W1; PIN(PW); SBAR(); }while(0)
  #define EX(v) __builtin_amdgcn_exp2f(v)
  #define GAPB(MF,X,B) do{ MF; X[B]=EX(X[B]); X[B+1]=EX(X[B+1]); X[B+2]=EX(X[B+2]); X[B+3]=EX(X[B+3]); PIN(X); SBAR(); }while(0)
  #define VRD(i) do{ vlo[i]=vtr(vp_+(((i)>>2)*4096+((i)&3)*1024)); vhi[i]=vtr(vp_+(((i)>>2)*4096+((i)&3)*1024+512)); }while(0)
  #define KRD(G,j) do{ if(G){ kload2(kf,kp0+sl_next,j); SBAR(); } }while(0)
  #define STEP(C0,C1,P0,P1,t,GK,GV,GL) do{ SBAR(); \
    const lds_cptr vp_=vp0+sl_prev; \
    VRD(0); SBAR(); float sacc=(P0[0]+P0[1]); \
    GAPA(C0=__builtin_amdgcn_mfma_f32_32x32x16_bf16(kf[0],qr[0],negm,0,0,0), P0[2],P0[3],P0[4],P0[5],     pw0[0]=PKW(P0,0), pw0[1]=PKW(P0,2), pw0); \
    VRD(4); SBAR(); GAPA(C1=__builtin_amdgcn_mfma_f32_32x32x16_bf16(kf[1],qr[0],negm,0,0,0), P0[6],P0[7],P0[8],P0[9],     pw0[2]=PKW(P0,4), pw0[3]=PKW(P0,6), pw0); \
    VRD(1); SBAR(); GAPA(C0=__builtin_amdgcn_mfma_f32_32x32x16_bf16(kf[2],qr[1],C0,0,0,0),   P0[10],P0[11],P0[12],P0[13], pw1[0]=PKW(P0,8), pw1[1]=PKW(P0,10), pw1); \
    VRD(5); SBAR(); GAPA(C1=__builtin_amdgcn_mfma_f32_32x32x16_bf16(kf[3],qr[1],C1,0,0,0),   P0[14],P0[15],P1[0],P1[1],   pw1[2]=PKW(P0,12),pw1[3]=PKW(P0,14), pw1); \
    VRD(2); SBAR(); GAPA(C0=__builtin_amdgcn_mfma_f32_32x32x16_bf16(kf[4],qr[2],C0,0,0,0),   P1[2],P1[3],P1[4],P1[5],     pw2[0]=PKW(P1,0), pw2[1]=PKW(P1,2), pw2); \
    VRD(6); SBAR(); GAPA(C1=__builtin_amdgcn_mfma_f32_32x32x16_bf16(kf[5],qr[2],C1,0,0,0),   P1[6],P1[7],P1[8],P1[9],     pw2[2]=PKW(P1,4), pw2[3]=PKW(P1,6), pw2); \
    VRD(3); SBAR(); GAPA(C0=__builtin_amdgcn_mfma_f32_32x32x16_bf16(kf[6],qr[3],C0,0,0,0),   P1[10],P1[11],P1[12],P1[13], pw3[0]=PKW(P1,8), pw3[1]=PKW(P1,10), pw3); \
    VRD(7); SBAR(); GAPA(C1=__builtin_amdgcn_mfma_f32_32x32x16_bf16(kf[7],qr[3],C1,0,0,0),   P1[14],P1[15],0.f,0.f,       pw3[2]=PKW(P1,12),pw3[3]=PKW(P1,14), pw3); \
    l_reg+=sacc; \
    if(GK){DMA_K((t)+3,sl_cur);} if(GV){DMA_V((t)+1,sl_next);} \
    CMASK(C0,C1,t); \
    { float a=MX3(C0[0],C0[1],C1[0]),b=MX3(C0[2],C0[3],C1[1]); a=MX3(a,C1[2],C1[3]); \
      _Pragma("unroll") for(int r=4;r<16;r+=4){a=MX3(a,C0[r],C0[r+1]);b=MX3(b,C0[r+2],C0[r+3]);a=MX3(a,C1[r],C1[r+1]);b=MX3(b,C1[r+2],C1[r+3]);} \
      float rm=__builtin_fmaxf(a,b); { auto rr=__builtin_amdgcn_permlane32_swap(__float_as_uint(rm),__float_as_uint(rm),false,false); rm=__builtin_fmaxf(__uint_as_float(rr[0]),__uint_as_float(rr[1])); } \
      resc=false; \
      if(__builtin_expect(__any(rm>(float)THRL),0)){ const float dl=__builtin_fmaxf(rm,0.f); mhat+=dl; \
        _Pragma("unroll") for(int r=0;r<16;++r){C0[r]-=dl;C1[r]-=dl;} \
        _Pragma("unroll") for(int r=0;r<16;++r)negm[r]=-mhat; asm volatile("":"+v"(negm)); \
        const float f=__builtin_amdgcn_exp2f(-dl); l_reg*=f; if(hi==0)wsf[r32]=f; resc=true; } } \
    SBAR(); \
    GAPB(o[0]=__builtin_amdgcn_mfma_f32_32x32x16_bf16(PAF(0),VFR(0),o[0],0,0,0), C0,0); \
    GAPB(o[1]=__builtin_amdgcn_mfma_f32_32x32x16_bf16(PAF(0),VFR(4),o[1],0,0,0), C0,4); \
    KRD(GL,0); GAPB(o[0]=__builtin_amdgcn_mfma_f32_32x32x16_bf16(PAF(1),VFR(1),o[0],0,0,0), C0,8); \
    KRD(GL,1); GAPB(o[1]=__builtin_amdgcn_mfma_f32_32x32x16_bf16(PAF(1),VFR(5),o[1],0,0,0), C0,12); \
    KRD(GL,2); GAPB(o[0]=__builtin_amdgcn_mfma_f32_32x32x16_bf16(PAF(2),VFR(2),o[0],0,0,0), C1,0); \
    KRD(GL,3); GAPB(o[1]=__builtin_amdgcn_mfma_f32_32x32x16_bf16(PAF(2),VFR(6),o[1],0,0,0), C1,4); \
    GAPB(o[0]=__builtin_amdgcn_mfma_f32_32x32x16_bf16(PAF(3),VFR(3),o[0],0,0,0), C1,8); \
    GAPB(o[1]=__builtin_amdgcn_mfma_f32_32x32x16_bf16(PAF(3),VFR(7),o[1],0,0,0), C1,12); \
    }while(0)
  int t=1;
  #undef CMASK
  #define CMASK(P0,P1,t) do{}while(0)
  for(;t+5<NT;t+=2){
    STEP(pB0,pB1,pA0,pA1,t,true,true,true);     WAIT_BAR(2); RESC(); ROT();
    STEP(pA0,pA1,pB0,pB1,t+1,true,true,true);   WAIT_BAR(2); RESC(); ROT();
  }
  #undef CMASK
  #define CMASK(P0,P1,t) do{int jb_=(t)-(NT-4); if(jb_>=0)cmask(P0,P1,jb_,qrel,hi);}while(0)
  #define ENDW(tt) do{ if((tt)+3<NT){WAIT_BAR(2);} else if((tt)+2<NT){WAIT_BAR(1);} else {WAIT_BAR(0);} }while(0)
  for(;t+1<NT;t+=2){
    STEP(pB0,pB1,pA0,pA1,t,(t+3<NT),(t+1<NT),(t+1<NT));       ENDW(t);   RESC(); ROT();
    STEP(pA0,pA1,pB0,pB1,t+1,(t+4<NT),(t+2<NT),(t+2<NT));     ENDW(t+1); RESC(); ROT();
  }
  STEP(pB0,pB1,pA0,pA1,NT-1,false,false,false); RESC();
  { float sacc=pB0[0]+pB0[1]; _Pragma("unroll") for(int r=2;r<16;++r)sacc+=pB0[r]; _Pragma("unroll") for(int r=0;r<16;++r)sacc+=pB1[r]; l_reg+=sacc;
    pw0=(u32x4){PKW(pB0,0),PKW(pB0,2),PKW(pB0,4),PKW(pB0,6)};pw1=(u32x4){PKW(pB0,8),PKW(pB0,10),PKW(pB0,12),PKW(pB0,14)};pw2=(u32x4){PKW(pB1,0),PKW(pB1,2),PKW(pB1,4),PKW(pB1,6)};pw3=(u32x4){PKW(pB1,8),PKW(pB1,10),PKW(pB1,12),PKW(pB1,14)};
    SBAR(); pv(o,vb0+sl_cur,PAF(0),PAF(1),PAF(2),PAF(3)); }
  #undef PKW
  #undef PAF
  #undef VFR
  #undef PIN
  #undef MX3
  #undef GAPA
  #undef GAPB
  #undef EX
  #undef VRD
  #undef KRD
  #undef STEP
  #undef ENDW
  {auto rr=__builtin_amdgcn_permlane32_swap(__float_as_uint(l_reg),__float_as_uint(l_reg),false,false);l_reg=__uint_as_float(rr[0])+__uint_as_float(rr[1]);}
  if(hi==0)wsf[32+r32]=l_reg;asm volatile("s_waitcnt lgkmcnt(0)":::"memory");
  float rli[16];
  #pragma unroll
  for(int r=0;r<16;++r)rli[r]=__builtin_amdgcn_rcpf(wsf[32+crow(r,hi)]);
  bf16*Ow=O+(rowbase+q0+wid*QBLK)*PO+ocol;
  { bf16*stg=(bf16*)(shm+LDS_OST)+wid*2048;
    #pragma unroll
    for(int r=0;r<16;++r){const int orow=crow(r,hi);
      #pragma unroll
      for(int d0=0;d0<2;++d0)stg[orow*64+d0*32+r32]=__float2bfloat16(o[d0][r]*rli[r]);}
    asm volatile("s_waitcnt lgkmcnt(0)":::"memory");
    #pragma unroll
    for(int i=0;i<4;++i){const int row=i*8+(lane>>3),ch=lane&7; const u32x4 v=*(const u32x4*)(stg+row*64+ch*8); ATTN_STORE16(Ow+(long)row*PO+ch*8,v);} }
  asm volatile("s_waitcnt lgkmcnt(0)\n\ts_barrier":::"memory");
  #undef DMA_K
  #undef DMA_V
  #undef CMASK
  #undef START
  #undef RESC
  #undef ROT
}
constexpr int ATTN_LDS_BYTES=LDS_BYTES;
struct AttnTensors { const bf16* P; bf16* O; };
struct AttnUnit { int bh; int qb; };
struct StaticOrder {
  int vcu;
  __device__ __forceinline__ explicit StaticOrder(int grid,int block):vcu((block%8)*(grid/8)+block/8){}
  __device__ __forceinline__ bool next(int i,AttnUnit&u)const{ if(i>=8)return false; const int s=4*(vcu&1)+(i>>1); u.bh=vcu>>1; u.qb=(i&1)?15-s:s; return true; }
  __device__ __forceinline__ void a_ready(const AttnUnit&)const{}
  __device__ __forceinline__ void done(const AttnUnit&)const{}
};
template<class Sched,int THRL=8> __device__ __forceinline__ void attn_phase(char*lds,const AttnTensors&T,const Sched&S){
  AttnUnit u;
  for(int i=0;S.next(i,u);++i){ S.a_ready(u);
    const int vh=u.bh&1, mp=(u.bh>>1)&1, h=(u.bh>>2)&3, b=u.bh>>4, hm=h*2+mp;
    attn_unit<THRL>(b, 1536+hm*64, 2048+hm*64, 2560+h*128+vh*64, hm*128+vh*64, u.qb, T.P, T.O, lds); S.done(u); }
}
#undef SBAR
#undef WAIT_BAR
}

namespace xattn {
using attn_body::bf16x8; using attn_body::s16x4; using attn_body::f32x16; using attn_body::u32x4; using attn_body::lds_cptr;
constexpr int SLOT = 32768;
#define XWAIT_BAR() asm volatile("s_waitcnt vmcnt(0) lgkmcnt(0)\n\ts_barrier":::"memory")
__device__ __forceinline__ int crow(int r,int hi){return (r&3)+8*(r>>2)+4*hi;}
__device__ __forceinline__ void xattn_unit(int tile, int head, const bf16_t* __restrict__ QC, const bf16_t* __restrict__ KVM, bf16_t* __restrict__ OC, char* shm, float* wsf) {
    const int tid = threadIdx.x, lane = tid & 63, r32 = lane & 31, hi = lane >> 5; const int wid = __builtin_amdgcn_readfirstlane(tid >> 6);
    const int row0 = tile * 256 + wid * 32, b = tile >> 4;
    const bf16_t* Kb = KVM + (size_t)(b * 256) * 2048 + head * 256; const bf16_t* Vb = Kb + 1024;
    const unsigned lds0 = (unsigned)(uintptr_t)shm;
    const lds_cptr shm3 = (lds_cptr)shm;
#pragma unroll
    for (int t = 0; t < 4; ++t)
#pragma unroll
        for (int i = 0; i < 4; ++i) { const int p = wid + 8 * i;
            attn_body::glds16(Kb + (size_t)(64 * t + lane) * 2048 + p * 8, (unsigned)__builtin_amdgcn_readfirstlane(lds0 + t * SLOT + p * 1024)); }
    f32x16 s[4][2];
    const bf16_t* qp = QC + (size_t)(row0 + r32) * 1024 + head * 256 + hi * 8;
#pragma unroll
    for (int dh = 0; dh < 2; ++dh) {
        bf16x8 qf[8];
#pragma unroll
        for (int ks = 0; ks < 8; ++ks) qf[ks] = *(const bf16x8*)(qp + dh * 128 + ks * 16);
        if (dh == 0) XWAIT_BAR();
#pragma unroll
        for (int t = 0; t < 4; ++t) {
            const lds_cptr kp = shm3 + t * SLOT + dh * 16384 + hi * 1024 + r32 * 16;
#pragma unroll
            for (int ks = 0; ks < 8; ++ks) {
                const bf16x8 b0 = *(const __attribute__((address_space(3))) bf16x8*)(kp + ks * 2048);
                const bf16x8 b1 = *(const __attribute__((address_space(3))) bf16x8*)(kp + ks * 2048 + 512);
                if (dh == 0 && ks == 0) { const f32x16 z = f32x16{}; s[t][0] = __builtin_amdgcn_mfma_f32_32x32x16_bf16(b0, qf[ks], z, 0, 0, 0); s[t][1] = __builtin_amdgcn_mfma_f32_32x32x16_bf16(b1, qf[ks], z, 0, 0, 0); }
                else { s[t][0] = __builtin_amdgcn_mfma_f32_32x32x16_bf16(b0, qf[ks], s[t][0], 0, 0, 0); s[t][1] = __builtin_amdgcn_mfma_f32_32x32x16_bf16(b1, qf[ks], s[t][1], 0, 0, 0); }
            }
        }
    }
    XWAIT_BAR();
#pragma unroll
    for (int t = 0; t < 4; ++t)
#pragma unroll
        for (int i = 0; i < 4; ++i) { const int p = wid + 8 * i;
            attn_body::glds16(Vb + (size_t)(64 * t + 16 * (p & 3) + (lane >> 2)) * 2048 + (p >> 2) * 32 + (lane & 3) * 8, (unsigned)__builtin_amdgcn_readfirstlane(lds0 + t * SLOT + p * 1024)); }
    float m = s[0][0][0];
#pragma unroll
    for (int t = 0; t < 4; ++t)
#pragma unroll
        for (int h2 = 0; h2 < 2; ++h2)
#pragma unroll
            for (int r = 0; r < 16; ++r) m = fmaxf(m, s[t][h2][r]);
    m = fmaxf(m, __shfl_xor(m, 32));
    float l = 0.f;
#pragma unroll
    for (int t = 0; t < 4; ++t)
#pragma unroll
        for (int h2 = 0; h2 < 2; ++h2)
#pragma unroll
            for (int r = 0; r < 16; ++r) { const float p = __builtin_amdgcn_exp2f(s[t][h2][r] - m); s[t][h2][r] = p; l += p; }
    l += __shfl_xor(l, 32);
    u32x4 pw[4][4];
#pragma unroll
    for (int t = 0; t < 4; ++t)
#pragma unroll
        for (int ks = 0; ks < 4; ++ks) { const int h2 = ks >> 1, o8 = (ks & 1) * 8;
            pw[t][ks] = (u32x4){attn_body::cvtpk_s(s[t][h2][o8 + 0], s[t][h2][o8 + 1]), attn_body::cvtpk_s(s[t][h2][o8 + 2], s[t][h2][o8 + 3]), attn_body::cvtpk_s(s[t][h2][o8 + 4], s[t][h2][o8 + 5]), attn_body::cvtpk_s(s[t][h2][o8 + 6], s[t][h2][o8 + 7])}; }
    if (hi == 0) wsf[r32] = l;
    XWAIT_BAR();
    f32x16 o[8];
#pragma unroll
    for (int d0 = 0; d0 < 8; ++d0) o[d0] = f32x16{};
    const lds_cptr vp0 = shm3 + ((lane >> 4) & 1) * 32 + (lane & 3) * 8 + (4 * hi + ((lane & 15) >> 2)) * 64;
#pragma unroll
    for (int t = 0; t < 4; ++t)
#pragma unroll
        for (int d0 = 0; d0 < 8; ++d0)
#pragma unroll
            for (int ks = 0; ks < 4; ++ks) {
                const s16x4 vl = attn_body::vtr(vp0 + t * SLOT + d0 * 4096 + ks * 1024), vh = attn_body::vtr(vp0 + t * SLOT + d0 * 4096 + ks * 1024 + 512);
                const bf16x8 vf = (bf16x8){vl[0], vl[1], vl[2], vl[3], vh[0], vh[1], vh[2], vh[3]};
                o[d0] = __builtin_amdgcn_mfma_f32_32x32x16_bf16(__builtin_bit_cast(bf16x8, pw[t][ks]), vf, o[d0], 0, 0, 0);
            }
    XWAIT_BAR();
    float rli[16];
#pragma unroll
    for (int r = 0; r < 16; ++r) rli[r] = __builtin_amdgcn_rcpf(wsf[crow(r, hi)]);
    bf16_t* op = OC + (size_t)row0 * 1024 + head * 256 + r32;
#pragma unroll
    for (int d0 = 0; d0 < 8; ++d0)
#pragma unroll
        for (int r = 0; r < 16; ++r) op[(size_t)crow(r, hi) * 1024 + d0 * 32] = f2bf(o[d0][r] * rli[r]);
    asm volatile("s_waitcnt lgkmcnt(0)" ::: "memory");
}
#undef XWAIT_BAR
}


namespace gla {
using attn_body::bf16x8; using attn_body::s16x4; using attn_body::f32x16; using attn_body::u32x4; using attn_body::lds_cptr;
typedef __attribute__((address_space(3))) char* lds_ptr;
typedef unsigned u32x2 __attribute__((ext_vector_type(2)));
constexpr int PITCH = 144;
constexpr int O_QD = 0, O_KI = 9216, O_KDT = 18432, O_V = 27648, O_DEC = 44032, BUF = 44544, O_SSX = 2 * BUF, LDS_USED = O_SSX + 1024;
#define GWAIT_BAR() asm volatile("s_waitcnt vmcnt(0) lgkmcnt(0)\n\ts_barrier":::"memory")
__device__ __forceinline__ int crow(int r,int hi){return (r&3)+8*(r>>2)+4*hi;}
__device__ __forceinline__ bf16x8 pack8f(const f32x16& v, int o) {
    u32x4 w = (u32x4){attn_body::cvtpk_s(v[o + 0], v[o + 1]), attn_body::cvtpk_s(v[o + 2], v[o + 3]), attn_body::cvtpk_s(v[o + 4], v[o + 5]), attn_body::cvtpk_s(v[o + 6], v[o + 7])};
    return __builtin_bit_cast(bf16x8, w);
}
template <bool PC>
__device__ __forceinline__ void gla_run(int rid, const bf16_t* __restrict__ PROJ, const float* __restrict__ GA, const float* __restrict__ w2, const float* __restrict__ b2,
                                        const float* __restrict__ wn, float* __restrict__ AGG, float* __restrict__ DRUN, bf16_t* __restrict__ MIXED, char* shm) {
    const int tid = threadIdx.x, lane = tid & 63, r32 = lane & 31, hi = lane >> 5; const int wid = __builtin_amdgcn_readfirstlane(tid >> 6);
    const int th = wid >> 2, db = wid & 3;
    const int j = rid & 7, h = (rid >> 3) & 3, b = rid >> 5;
    const size_t tb = (size_t)b * SEQ + (size_t)j * 512;
    const unsigned lds0 = (unsigned)(uintptr_t)shm; const lds_ptr shm3 = (lds_ptr)shm;
    const float* w2p_ = w2 + h * 64 + 8 * wid; const float* b2p_ = b2 + h * 64 + 8 * wid;
    const int pl = (lane & ~12) | ((lane & 4) << 1) | ((lane & 8) >> 1);
    const int cpos0 = 16 * (wid >> 1) + 4 * (wid & 1);
    f32x16 S0 = f32x16{}, S1 = f32x16{};
    float gsum[8];
#pragma unroll
    for (int c = 0; c < 8; ++c) gsum[c] = 0.f;
    if (PC) {
        for (int i = 0; i < j; ++i) {
            const float* ag = AGG + (size_t)(rid - j + i) * 8192 + 32 * db + r32; const float* dr = DRUN + (rid - j + i) * 64;
#pragma unroll
            for (int r = 0; r < 16; ++r) { const int ch = crow(r, hi); S0[r] = S0[r] * dr[ch] + ag[ch * 128]; S1[r] = S1[r] * dr[32 + ch] + ag[(32 + ch) * 128]; }
        }
    }
    f32x4 ga0, ga1, ga2, ga3; bf16x8 rq, rk;
#define GLA_LOAD_RAW(n_) do { const size_t t_ = tb + (size_t)(n_) * 64 + lane; const f32x4* gp_ = (const f32x4*)(GA + t_ * 16); ga0 = gp_[0]; ga1 = gp_[1]; ga2 = gp_[2]; ga3 = gp_[3]; \
        if (PC) rq = *(const bf16x8*)(PROJ + t_ * PP + C_GQ + h * 64 + 8 * wid); rk = *(const bf16x8*)(PROJ + t_ * PP + C_GK + h * 64 + 8 * wid); } while (0)
#define GLA_DMA_V(n_, buf_) do { _Pragma("unroll") for (int i_ = 0; i_ < 2; ++i_) { const int p_ = 2 * wid + i_; \
        attn_body::glds16(PROJ + (tb + (size_t)(n_) * 64 + 16 * (p_ & 3) + (lane >> 2)) * PP + C_GV + h * 128 + (p_ >> 2) * 32 + (lane & 3) * 8, (unsigned)__builtin_amdgcn_readfirstlane(lds0 + (buf_) * BUF + O_V + p_ * 1024)); } } while (0)
    GLA_LOAD_RAW(0); GLA_DMA_V(0, 0);
    for (int n = 0; n < 8; ++n) {
        const int buf = n & 1; const lds_ptr B3 = shm3 + buf * BUF;
        float Gc[8];
        {   float z[8];
            const float* w2p = w2p_; const float* b2p = b2p_;
            asm volatile("" : "+s"(w2p), "+s"(b2p));
#pragma unroll
            for (int c = 0; c < 8; ++c) z[c] = b2p[c];
#pragma unroll
            for (int r = 0; r < 16; ++r) { const float g_ = (r < 4) ? ga0[r & 3] : (r < 8) ? ga1[r & 3] : (r < 12) ? ga2[r & 3] : ga3[r & 3];
#pragma unroll
                for (int c = 0; c < 8; ++c) z[c] += g_ * w2p[r * 256 + c]; }
#pragma unroll
            for (int c = 0; c < 8; ++c) Gc[c] = (fminf(z[c], 0.f) - __logf(1.f + __expf(-fabsf(z[c])))) * 0.0625f; }
#pragma unroll
        for (int off = 1; off < 64; off <<= 1)
#pragma unroll
            for (int c = 0; c < 8; ++c) { const float v = __shfl_up(Gc[c], off); if (lane >= off) Gc[c] += v; }
        float Gl[8];
#pragma unroll
        for (int c = 0; c < 8; ++c) { Gl[c] = __shfl(Gc[c], 63); gsum[c] += Gl[c]; }
        {   float kd[8], ki[8], qd[8];
#pragma unroll
            for (int c = 0; c < 8; ++c) { const float kf_ = bf2f((bf16_t)rk[c]); kd[c] = kf_ * __expf(Gl[c] - Gc[c]);
                if (PC) { ki[c] = kf_ * __expf(-Gc[c]); qd[c] = bf2f((bf16_t)rq[c]) * __expf(Gc[c]) * 0.125f; } }
            if (PC) {
                const lds_ptr rowq = B3 + O_QD + lane * PITCH + cpos0 * 2, rowk = B3 + O_KI + lane * PITCH + cpos0 * 2;
                *(__attribute__((address_space(3))) u32x2*)(rowq) = (u32x2){attn_body::cvtpk_s(qd[0], qd[1]), attn_body::cvtpk_s(qd[2], qd[3])};
                *(__attribute__((address_space(3))) u32x2*)(rowq + 16) = (u32x2){attn_body::cvtpk_s(qd[4], qd[5]), attn_body::cvtpk_s(qd[6], qd[7])};
                *(__attribute__((address_space(3))) u32x2*)(rowk) = (u32x2){attn_body::cvtpk_s(ki[0], ki[1]), attn_body::cvtpk_s(ki[2], ki[3])};
                *(__attribute__((address_space(3))) u32x2*)(rowk + 16) = (u32x2){attn_body::cvtpk_s(ki[4], ki[5]), attn_body::cvtpk_s(ki[6], ki[7])};
            }
#pragma unroll
            for (int c = 0; c < 8; ++c) *(__attribute__((address_space(3))) bf16_t*)(B3 + O_KDT + (8 * wid + c) * PITCH + pl * 2) = f2bf(kd[c]);
            if (lane == 63) {
#pragma unroll
                for (int c = 0; c < 8; ++c) ((__attribute__((address_space(3))) float*)(B3 + O_DEC))[8 * wid + c] = __expf(Gl[c]);
            }
        }
        GWAIT_BAR();
        if (n + 1 < 8) { GLA_LOAD_RAW(n + 1); GLA_DMA_V(n + 1, buf ^ 1); }
        const lds_cptr vp = (lds_cptr)B3 + O_V + db * 4096 + ((lane >> 4) & 1) * 32 + (lane & 3) * 8 + (4 * hi + ((lane & 15) >> 2)) * 64;
        bf16x8 vf[4];
#pragma unroll
        for (int ks = 0; ks < 4; ++ks) { const s16x4 vl = attn_body::vtr(vp + ks * 1024), vh = attn_body::vtr(vp + ks * 1024 + 512); vf[ks] = (bf16x8){vl[0], vl[1], vl[2], vl[3], vh[0], vh[1], vh[2], vh[3]}; }
        const __attribute__((address_space(3))) float* decp = (const __attribute__((address_space(3))) float*)(B3 + O_DEC);
        if (PC) {
            bf16x8 qf[4];
#pragma unroll
            for (int ks = 0; ks < 4; ++ks) qf[ks] = *(const __attribute__((address_space(3))) bf16x8*)(B3 + O_QD + (32 * th + r32) * PITCH + (16 * ks + 8 * hi) * 2);
            f32x16 o = f32x16{};
            o = __builtin_amdgcn_mfma_f32_32x32x16_bf16(pack8f(S0, 0), qf[0], o, 0, 0, 0);
            o = __builtin_amdgcn_mfma_f32_32x32x16_bf16(pack8f(S0, 8), qf[1], o, 0, 0, 0);
            o = __builtin_amdgcn_mfma_f32_32x32x16_bf16(pack8f(S1, 0), qf[2], o, 0, 0, 0);
            o = __builtin_amdgcn_mfma_f32_32x32x16_bf16(pack8f(S1, 8), qf[3], o, 0, 0, 0);
#pragma unroll
            for (int kh = 0; kh < 2; ++kh) {
                if (kh <= th) {
                    f32x16 X = f32x16{};
#pragma unroll
                    for (int ks = 0; ks < 4; ++ks) { const bf16x8 kif = *(const __attribute__((address_space(3))) bf16x8*)(B3 + O_KI + (32 * kh + r32) * PITCH + (16 * ks + 8 * hi) * 2);
                        X = __builtin_amdgcn_mfma_f32_32x32x16_bf16(kif, qf[ks], X, 0, 0, 0); }
                    if (kh == th) {
#pragma unroll
                        for (int r = 0; r < 16; ++r) X[r] = (crow(r, hi) <= r32) ? X[r] : 0.f;
                    }
                    o = __builtin_amdgcn_mfma_f32_32x32x16_bf16(vf[2 * kh], pack8f(X, 0), o, 0, 0, 0);
                    o = __builtin_amdgcn_mfma_f32_32x32x16_bf16(vf[2 * kh + 1], pack8f(X, 8), o, 0, 0, 0);
                }
            }
#pragma unroll
            for (int r = 0; r < 16; ++r) { S0[r] *= decp[crow(r, hi)]; S1[r] *= decp[32 + crow(r, hi)]; }
#pragma unroll
            for (int ks = 0; ks < 4; ++ks) {
                const bf16x8 k0 = *(const __attribute__((address_space(3))) bf16x8*)(B3 + O_KDT + r32 * PITCH + (16 * ks + 8 * hi) * 2);
                const bf16x8 k1 = *(const __attribute__((address_space(3))) bf16x8*)(B3 + O_KDT + (32 + r32) * PITCH + (16 * ks + 8 * hi) * 2);
                S0 = __builtin_amdgcn_mfma_f32_32x32x16_bf16(k0, vf[ks], S0, 0, 0, 0);
                S1 = __builtin_amdgcn_mfma_f32_32x32x16_bf16(k1, vf[ks], S1, 0, 0, 0);
            }
            float ss = 0.f;
#pragma unroll
            for (int r = 0; r < 16; ++r) ss += o[r] * o[r];
            ss += __shfl_xor(ss, 32);
            __attribute__((address_space(3))) float* ssx = (__attribute__((address_space(3))) float*)(shm3 + O_SSX);
            if (hi == 0) ssx[(th * 4 + db) * 32 + r32] = ss;
            asm volatile("s_waitcnt lgkmcnt(0)\n\ts_barrier" ::: "memory");
            const float tot = (ssx[(th * 4 + 0) * 32 + r32] + ssx[(th * 4 + 1) * 32 + r32]) + (ssx[(th * 4 + 2) * 32 + r32] + ssx[(th * 4 + 3) * 32 + r32]);
            const float rn = rsqrtf(tot * (1.f / 128.f) + EPS);
            const size_t t = tb + (size_t)n * 64 + 32 * th + r32;
#pragma unroll
            for (int r4 = 0; r4 < 4; ++r4) {
                const int dv0 = 32 * db + 8 * r4 + 4 * hi;
                const u32x2 gg = *(const u32x2*)(PROJ + t * PP + C_GG + h * 128 + dv0); const f32x4 wv = *(const f32x4*)(wn + dv0);
                const float g0 = __uint_as_float(gg.x << 16), g1 = __uint_as_float(gg.x & 0xffff0000u), g2 = __uint_as_float(gg.y << 16), g3 = __uint_as_float(gg.y & 0xffff0000u);
                u32x2 ov; ov.x = attn_body::cvtpk_s(o[4 * r4 + 0] * rn * wv[0] * silu(g0), o[4 * r4 + 1] * rn * wv[1] * silu(g1));
                ov.y = attn_body::cvtpk_s(o[4 * r4 + 2] * rn * wv[2] * silu(g2), o[4 * r4 + 3] * rn * wv[3] * silu(g3));
                *(u32x2*)(MIXED + t * D + h * 128 + dv0) = ov;
            }
        } else {
#pragma unroll
            for (int r = 0; r < 16; ++r) S0[r] *= decp[32 * th + crow(r, hi)];
#pragma unroll
            for (int ks = 0; ks < 4; ++ks) {
                const bf16x8 k0 = *(const __attribute__((address_space(3))) bf16x8*)(B3 + O_KDT + (32 * th + r32) * PITCH + (16 * ks + 8 * hi) * 2);
                S0 = __builtin_amdgcn_mfma_f32_32x32x16_bf16(k0, vf[ks], S0, 0, 0, 0);
            }
        }
    }
    if (!PC) {
        float* ag = AGG + (size_t)rid * 8192 + 32 * db + r32;
#pragma unroll
        for (int r = 0; r < 16; ++r) ag[(32 * th + crow(r, hi)) * 128] = S0[r];
        if (lane == 0) {
#pragma unroll
            for (int c = 0; c < 8; ++c) DRUN[rid * 64 + 8 * wid + c] = __expf(gsum[c]);
        }
    }
    GWAIT_BAR();
#undef GLA_LOAD_RAW
#undef GLA_DMA_V
}
#undef GWAIT_BAR
}
#ifndef LAS
#define LAS __attribute__((address_space(3)))
#endif

namespace thin {
typedef unsigned v4u __attribute__((ext_vector_type(4)));
typedef unsigned v2u __attribute__((ext_vector_type(2)));
__device__ __forceinline__ unsigned pk2(float lo, float hi) { return (unsigned)f2bf(lo) | ((unsigned)f2bf(hi) << 16); }
template <int MODE>
__device__ __forceinline__ void transpose_item(const float* __restrict__ W, int K, int Nsrc, int nblk, bf16_t* __restrict__ WT, const float* __restrict__ kscale, LAS float* scr, int item, int lane) {
    const int kb = item / nblk, nb = item % nblk, k0 = 64 * kb, n0 = 32 * nb;
    const int n = n0 + (lane & 31); const int c = MODE == 1 ? win_src_col(n) : n;
#pragma unroll 8
    for (int i = 0; i < 32; ++i) { const int kk = 2 * i + (lane >> 5); float v = 0.f; if (c >= 0) { v = W[(size_t)(k0 + kk) * Nsrc + c]; if (kscale) v *= kscale[k0 + kk]; } scr[kk * 33 + (lane & 31)] = v; }
    asm volatile("s_waitcnt lgkmcnt(0)" ::: "memory");
    const int cch = lane & 7;
#pragma unroll
    for (int j = 0; j < 4; ++j) { const int nn = (lane >> 3) + 8 * j; const LAS float* q = scr + (8 * cch) * 33 + nn;
        v4u o; o.x = pk2(q[0 * 33], q[1 * 33]); o.y = pk2(q[2 * 33], q[3 * 33]); o.z = pk2(q[4 * 33], q[5 * 33]); o.w = pk2(q[6 * 33], q[7 * 33]);
        *(v4u*)(WT + (size_t)(n0 + nn) * K + k0 + 8 * cch) = o; }
    asm volatile("s_waitcnt lgkmcnt(0)" ::: "memory");
}
__device__ __forceinline__ void rms_row_to_bf16(const float* __restrict__ xrow, const float* __restrict__ w, bf16_t* __restrict__ orow, int lane) {
    const f32x4* xr = (const f32x4*)xrow + lane;
    f32x4 v[4]; float ss = 0.f;
#pragma unroll
    for (int j = 0; j < 4; ++j) { v[j] = xr[64 * j]; ss += (v[j].x * v[j].x + v[j].y * v[j].y) + (v[j].z * v[j].z + v[j].w * v[j].w); }
    const float r = rsqrtf(wave_sum(ss) * (1.f / D) + EPS);
    v2u* o8 = (v2u*)orow + lane;
#pragma unroll
    for (int j = 0; j < 4; ++j) { const f32x4 ww = ((const f32x4*)w)[lane + 64 * j]; v2u o; o.x = pk2(v[j].x * r * ww.x, v[j].y * r * ww.y); o.y = pk2(v[j].z * r * ww.z, v[j].w * r * ww.w); o8[64 * j] = o; }
}
__device__ __forceinline__ void rms_row2_to_bf16(const float* __restrict__ xa, const float* __restrict__ xb, const float* __restrict__ w, bf16_t* __restrict__ oa, bf16_t* __restrict__ ob, int lane) {
    const f32x4* pa = (const f32x4*)xa + lane; const f32x4* pb = (const f32x4*)xb + lane;
    f32x4 va[4], vb[4]; float sa = 0.f, sb = 0.f;
#pragma unroll
    for (int j = 0; j < 4; ++j) { va[j] = pa[64 * j]; vb[j] = pb[64 * j]; }
#pragma unroll
    for (int j = 0; j < 4; ++j) { sa += (va[j].x * va[j].x + va[j].y * va[j].y) + (va[j].z * va[j].z + va[j].w * va[j].w); sb += (vb[j].x * vb[j].x + vb[j].y * vb[j].y) + (vb[j].z * vb[j].z + vb[j].w * vb[j].w); }
    const float ra = rsqrtf(wave_sum(sa) * (1.f / D) + EPS), rb = rsqrtf(wave_sum(sb) * (1.f / D) + EPS);
    v2u* qa = (v2u*)oa + lane; v2u* qb = (v2u*)ob + lane;
#pragma unroll
    for (int j = 0; j < 4; ++j) { const f32x4 ww = ((const f32x4*)w)[lane + 64 * j]; v2u o;
        o.x = pk2(va[j].x * ra * ww.x, va[j].y * ra * ww.y); o.y = pk2(va[j].z * ra * ww.z, va[j].w * ra * ww.w); qa[64 * j] = o;
        o.x = pk2(vb[j].x * rb * ww.x, vb[j].y * rb * ww.y); o.y = pk2(vb[j].z * rb * ww.z, vb[j].w * rb * ww.w); qb[64 * j] = o; }
}
}
constexpr int NWAVES = 8;
constexpr int RING_BYTES = 131072;
constexpr int LDSCTL_OFF = RING_BYTES, MISC_OFF = LDSCTL_OFF + 320;
constexpr int LDS_BYTES = 147456;
constexpr int CW_BAR = 4096;
constexpr size_t CTL_ZERO_BYTES = 64 * 1024;
#define GAS __attribute__((address_space(1)))
typedef unsigned short bf16;
typedef unsigned v4u __attribute__((ext_vector_type(4)));
typedef float f32x4 __attribute__((ext_vector_type(4)));
typedef short bf16x8 __attribute__((ext_vector_type(8)));
typedef GAS unsigned gu32;
typedef GAS unsigned long long gu64;
#define RLX_AGENT __ATOMIC_RELAXED, __HIP_MEMORY_SCOPE_AGENT
#define LDS_WAIT() asm volatile("s_waitcnt lgkmcnt(0)" ::: "memory")
#define VM_WAIT() asm volatile("s_waitcnt vmcnt(0)" ::: "memory")
__device__ __forceinline__ unsigned long long rt() { return __builtin_amdgcn_s_memrealtime(); }
__device__ __forceinline__ unsigned pk2(float lo, float hi) { return (unsigned)f2bf(lo) | ((unsigned)f2bf(hi) << 16); }

#define XB_TMO      128
#define XB_XCNT(j)  (256  + 64 * (j))
#define XB_XSUB(j)  (1280 + 64 * (j))
#define XB_XGEN(j)  (2304 + 64 * (j))
#define XB_TOP      3328
#define XB_TOPGEN   3392
#define XCD_BAR_WORDS 3456
#define XB_SPIN_CAP (1u << 18)

__device__ __forceinline__ unsigned xb_ld(unsigned* p)              { return __hip_atomic_load(p, __ATOMIC_RELAXED, __HIP_MEMORY_SCOPE_AGENT); }
__device__ __forceinline__ unsigned xb_add(unsigned* p, unsigned v) { return __hip_atomic_fetch_add(p, v, __ATOMIC_RELAXED, __HIP_MEMORY_SCOPE_AGENT); }
__device__ __forceinline__ unsigned xb_xcc_id() { return (unsigned)__builtin_amdgcn_s_getreg((3 << 11) | 20) & 0xFu; }
#define XB_SPIN(cond, bar) do { unsigned _sp = 0; while (cond) { __builtin_amdgcn_s_sleep(1); \
    if ((++_sp & 255u) == 0u) { if (xb_ld(&(bar)[XB_TMO])) break; if (_sp > XB_SPIN_CAP) { atomicAdd(&(bar)[XB_TMO], 1u); break; } } } } while (0)

struct XcdBarrier {
    unsigned* bar; unsigned x;
    volatile LAS unsigned* st;
};

__device__ __forceinline__ XcdBarrier xcd_barrier_post(unsigned* bar, volatile LAS unsigned* st) {
    XcdBarrier b; b.bar = bar; b.x = xb_xcc_id(); b.st = st;
    if (threadIdx.x == 0) (void)xb_add(&bar[XB_XCNT(b.x)], 1u);
    return b;
}
__device__ __forceinline__ void xcd_barrier_complete(unsigned* bar, unsigned x, unsigned& nloc, unsigned& nx) {
    const unsigned G = gridDim.x * gridDim.y * gridDim.z;
    unsigned sum, cnt, mine, sp = 0u;
    for (;;) {
        sum = 0u; cnt = 0u; mine = 0u;
#pragma unroll
        for (unsigned j = 0; j < 16; ++j) { const unsigned c = xb_ld(&bar[XB_XCNT(j)]); sum += c; cnt += (c > 0u) ? 1u : 0u; mine = (j == x) ? c : mine; }
        if (sum == G) break;
        __builtin_amdgcn_s_sleep(1);
        if ((++sp & 255u) == 0u) { if (xb_ld(&bar[XB_TMO])) break; if (sp > XB_SPIN_CAP) { atomicAdd(&bar[XB_TMO], 1u); break; } }
    }
    nloc = mine > 0u ? mine : 1u; nx = cnt > 0u ? cnt : 1u;
}

__device__ __forceinline__ void xcd_barrier(const XcdBarrier& b) {
    asm volatile("s_waitcnt vmcnt(0)" ::: "memory");
    __syncthreads();
    if (threadIdx.x == 0) {
        unsigned* bar = b.bar;
        __builtin_amdgcn_s_waitcnt(0);
        unsigned nloc = b.st[0], nx = b.st[1];
        if (nloc == 0u) { xcd_barrier_complete(bar, b.x, nloc, nx); b.st[0] = nloc; b.st[1] = nx; }
        const unsigned old = xb_add(&bar[XB_XSUB(b.x)], 1u);
        const unsigned gen = old / nloc;
        if (old + 1u == (gen + 1u) * nloc) {
            __builtin_amdgcn_fence(__ATOMIC_RELEASE, "agent");
            asm volatile("s_waitcnt vmcnt(0)" ::: "memory");
            const unsigned og = xb_add(&bar[XB_TOP], 1u);
            const unsigned tg = og / nx;
            if (og + 1u == (tg + 1u) * nx) xb_add(&bar[XB_TOPGEN], 1u);
            else XB_SPIN(xb_ld(&bar[XB_TOPGEN]) == tg, bar);
            __builtin_amdgcn_fence(__ATOMIC_ACQUIRE, "agent");
            xb_add(&bar[XB_XGEN(b.x)], 1u);
            asm volatile("s_waitcnt vmcnt(0)" ::: "memory");
        } else {
            XB_SPIN(xb_ld(&bar[XB_XGEN(b.x)]) == gen, bar);
            __builtin_amdgcn_fence(__ATOMIC_ACQUIRE, "agent");
            asm volatile("s_waitcnt vmcnt(0)" ::: "memory");
        }
    }
    __syncthreads();
}

#ifndef PHMASK
#define PHMASK 0xffff
#endif
struct Args { const void* in[20]; float* out; unsigned char* ws; int ph_lo, ph_hi, sub, pad; };
enum Phase { PH_PRO = 0, PH_INPROJ = 1, PH_MIX = 4, PH_FIN = 9, PH_ATTN = 2, PH_OUTPROJ = 5, PH_CQ = 6, PH_XATTN = 7, PH_CO = 8, PH_END = 10 };
constexpr int LDS_WSCR = RING_BYTES + 1024;

__global__ void __launch_bounds__(NWAVES * 64, 2) mk_fwd(Args args) {
    extern __shared__ __attribute__((aligned(16))) unsigned char lds[];
    LAS unsigned char* L = (LAS unsigned char*)lds;
    const int tid = threadIdx.x;
    unsigned char* ws = args.ws;
    for (int u = tid; u < (LDS_BYTES - LDSCTL_OFF) / 4; u += NWAVES * 64) ((LAS unsigned*)(L + LDSCTL_OFF))[u] = 0u;
    __syncthreads();
    const int G = gridDim.x;
    XcdBarrier bar = xcd_barrier_post((unsigned*)(ws + WS_CTL) + CW_BAR, (volatile LAS unsigned*)(L + MISC_OFF) + 8);
#define WSP(T_, off) ((T_*)(ws + (off)))
    const int lo = args.ph_lo, hi = args.ph_hi;
#define IN(k) (lo <= (k) && (k) < hi && ((PHMASK >> (k)) & 1))
#define SEAM(k) do { if ((k) + 1 < hi) xcd_barrier(bar); } while (0)
    if (IN(PH_PRO)) {
        const int wave = __builtin_amdgcn_readfirstlane(tid >> 6), lane = tid & 63;
        const int gw = (int)blockIdx.x * NWAVES + wave, NGW = G * NWAVES;
        LAS float* scr = (LAS float*)(L + wave * 16384);
        constexpr int I_IN = 16 * (NP / 32), I_SQ = 16 * (D / 32), I_KV = 16 * (2 * D / 32);
        for (int it = gw; it < I_IN + 3 * I_SQ + I_KV; it += NGW) {
            int r = it;
            if (r < I_IN) { thin::transpose_item<1>((const float*)args.in[4], D, D_IN, NP / 32, WSP(bf16_t, WS_WIN), nullptr, scr, r, lane); continue; } r -= I_IN;
            if (r < I_SQ) { thin::transpose_item<0>((const float*)args.in[13], D, D, D / 32, WSP(bf16_t, WS_WOUT), nullptr, scr, r, lane); continue; } r -= I_SQ;
            if (r < I_SQ) { thin::transpose_item<0>((const float*)args.in[16], D, D, D / 32, WSP(bf16_t, WS_WCQ), (const float*)args.in[14], scr, r, lane); continue; } r -= I_SQ;
            if (r < I_SQ) { thin::transpose_item<0>((const float*)args.in[18], D, D, D / 32, WSP(bf16_t, WS_WCO), nullptr, scr, r, lane); continue; } r -= I_SQ;
            thin::transpose_item<0>((const float*)args.in[17], D, 2 * D, 2 * D / 32, WSP(bf16_t, WS_WCKV), nullptr, scr, r, lane);
        }
        for (int m = gw; m < T; m += 2 * NGW) thin::rms_row2_to_bf16((const float*)args.in[0] + (size_t)m * D, (const float*)args.in[0] + (size_t)(m + NGW) * D, (const float*)args.in[3], WSP(bf16_t, WS_XN) + (size_t)m * D, WSP(bf16_t, WS_XN) + (size_t)(m + NGW) * D, lane);
        for (int m = gw; m < TM; m += NGW) thin::rms_row_to_bf16((const float*)args.in[1] + (size_t)m * D, (const float*)args.in[15], WSP(bf16_t, WS_MEMN) + (size_t)m * D, lane);
        { const int gt = (int)blockIdx.x * (NWAVES * 64) + tid, NGT = G * NWAVES * 64;
          float* cs = WSP(float, WS_ROPE); float* sn = cs + T * 8; float* rss = WSP(float, WS_MISC); const int* pos = (const int*)args.in[2];
          for (int i = gt; i < T * 8; i += NGT) {
              const int t = i >> 3, j = i & 7;
              double f = 1.0;
              f = (j == 1) ? 0.19392274474868576 : f; f = (j == 2) ? 0.03760603093086393 : f; f = (j == 3) ? 0.007292664737217109 : f; f = (j == 4) ? 0.001414213562373095 : f;
              f = (j == 5) ? 0.0002742481756762073 : f; f = (j == 6) ? 5.318295896944988e-05 : f; f = (j == 7) ? 1.031338537721246e-05 : f;
              float c, sv; sincos_d((double)pos[t] * f, c, sv); cs[i] = c; sn[i] = sv;
          }
          for (int i = gt; i < 2 * T; i += NGT) rss[i] = 0.f;
          if (gt == 0) { const float* q1 = (const float*)args.in[8]; const float* k1 = (const float*)args.in[9]; const float* q2 = (const float*)args.in[10]; const float* k2 = (const float*)args.in[11];
              float a = 0.f, b = 0.f; for (int u = 0; u < 64; ++u) { a += q1[u] * k1[u]; b += q2[u] * k2[u]; } rss[2 * T] = expf(a) - expf(b) + 0.2f; } }
        SEAM(PH_PRO);
    }
    if (IN(PH_INPROJ)) {
        { pg8::Gemm g{WSP(bf16_t, WS_XN), WSP(bf16_t, WS_WIN), T, NP, D}; pg8::StaticOrder S; S.init(T, NP, G, (int)blockIdx.x);
          pg8::EpiInProj E{WSP(bf16_t, WS_PROJ), WSP(float, WS_GA), WSP(float, WS_ROPE), WSP(float, WS_ROPE) + T * 8};
          pg8::gemm_phase<pg8::EpiInProj, pg8::StaticOrder, true, true>(L, g, S, E); }
#ifndef NO_KVM
        { pg8::Gemm g{WSP(bf16_t, WS_MEMN), WSP(bf16_t, WS_WCKV), TM, 2 * D, D}; pg8::StaticOrder S; S.init(TM, 2 * D, G, (int)blockIdx.x);
          pg8::EpiBf16<0> E{WSP(bf16_t, WS_KVM), 2 * D, nullptr, 0, 0, 1.f};
          pg8::gemm_phase<pg8::EpiBf16<0>, pg8::StaticOrder, true, true>(L, g, S, E); }
#endif
        SEAM(PH_INPROJ);
    }
    if (IN(PH_ATTN)) {
        if (args.sub & 1) { const int vcu = (G % 8 == 0) ? ((int)blockIdx.x % 8) * (G / 8) + (int)blockIdx.x / 8 : (int)blockIdx.x;
          for (int rid = vcu; rid < 256; rid += G)
              gla::gla_run<false>(rid, WSP(bf16_t, WS_PROJ), WSP(float, WS_GA), (const float*)args.in[5], (const float*)args.in[6], (const float*)args.in[7], WSP(float, WS_KVC), WSP(float, WS_ST), WSP(bf16_t, WS_MIXED), (char*)lds); }
        const attn_body::AttnTensors AT{WSP(const attn_body::bf16, WS_PROJ), WSP(attn_body::bf16, WS_OD)};
        const attn_body::StaticOrder S(G, (int)blockIdx.x);
        if (args.sub & 2) attn_body::attn_phase<attn_body::StaticOrder>((char*)lds, AT, S);
        SEAM(PH_ATTN);
    }
    if (IN(PH_MIX)) {
        const int wave = __builtin_amdgcn_readfirstlane(tid >> 6), lane = tid & 63;
        const int gw = (int)blockIdx.x * NWAVES + wave, NGW = G * NWAVES;
        if (args.sub & 1) { const int vcu = (G % 8 == 0) ? ((int)blockIdx.x % 8) * (G / 8) + (int)blockIdx.x / 8 : (int)blockIdx.x;
          for (int rid = vcu; rid < 256; rid += G)
              gla::gla_run<true>(rid, WSP(bf16_t, WS_PROJ), WSP(float, WS_GA), (const float*)args.in[5], (const float*)args.in[6], (const float*)args.in[7], WSP(float, WS_KVC), WSP(float, WS_ST), WSP(bf16_t, WS_MIXED), (char*)lds); }
        const bf16_t* od = WSP(bf16_t, WS_OD); const bf16_t* proj = WSP(bf16_t, WS_PROJ); bf16_t* mixed = WSP(bf16_t, WS_MIXED);
        const float lm = WSP(float, WS_MISC)[2 * T]; const float* w = (const float*)args.in[12];
        const int hh = lane >> 4, e0 = (lane & 15) * 8;
        f32x4 wa = *(const f32x4*)(w + e0) * 0.8f, wb = *(const f32x4*)(w + e0 + 4) * 0.8f;
        if (args.sub & 2) for (int t = gw; t < T; t += NGW) {
            const pg8::u32x4 a1 = *(const pg8::u32x4*)(od + (size_t)t * D + (2 * hh) * 128 + e0), a2 = *(const pg8::u32x4*)(od + (size_t)t * D + (2 * hh + 1) * 128 + e0);
            const pg8::u32x4 gg = *(const pg8::u32x4*)(proj + (size_t)t * PP + C_DG + hh * 128 + e0);
            float d[8], g[8]; float ss = 0.f;
#pragma unroll
            for (int i = 0; i < 4; ++i) { const unsigned u1 = a1[i], u2 = a2[i], ug = gg[i];
                d[2 * i] = __uint_as_float(u1 << 16) - lm * __uint_as_float(u2 << 16); d[2 * i + 1] = __uint_as_float(u1 & 0xffff0000u) - lm * __uint_as_float(u2 & 0xffff0000u);
                g[2 * i] = __uint_as_float(ug << 16); g[2 * i + 1] = __uint_as_float(ug & 0xffff0000u); ss += d[2 * i] * d[2 * i] + d[2 * i + 1] * d[2 * i + 1]; }
            ss += __shfl_xor(ss, 1); ss += __shfl_xor(ss, 2); ss += __shfl_xor(ss, 4); ss += __shfl_xor(ss, 8);
            const float r = rsqrtf(ss * (1.f / 128) + EPS);
            pg8::u32x4 o;
            o.x = thin::pk2(d[0] * r * wa[0] * silu(g[0]), d[1] * r * wa[1] * silu(g[1])); o.y = thin::pk2(d[2] * r * wa[2] * silu(g[2]), d[3] * r * wa[3] * silu(g[3]));
            o.z = thin::pk2(d[4] * r * wb[0] * silu(g[4]), d[5] * r * wb[1] * silu(g[5])); o.w = thin::pk2(d[6] * r * wb[2] * silu(g[6]), d[7] * r * wb[3] * silu(g[7]));
            *(pg8::u32x4*)(mixed + (size_t)t * D + 512 + hh * 128 + e0) = o;
        }
        SEAM(PH_MIX);
    }
    if (IN(PH_OUTPROJ)) {
        pg8::Gemm g{WSP(bf16_t, WS_MIXED), WSP(bf16_t, WS_WOUT), T, D, D}; pg8::StaticOrder S; S.init(T, D, G, (int)blockIdx.x);
        pg8::EpiOutProj E{(const float*)args.in[0], args.out, WSP(bf16_t, WS_X1B), WSP(float, WS_MISC)};
        pg8::gemm_phase<pg8::EpiOutProj, pg8::StaticOrder, true, true>(L, g, S, E);
        SEAM(PH_OUTPROJ);
    }
    if (IN(PH_CQ)) {
        pg8::Gemm g{WSP(bf16_t, WS_X1B), WSP(bf16_t, WS_WCQ), T, D, D}; pg8::StaticOrder S; S.init(T, D, G, (int)blockIdx.x);
        pg8::EpiCq E{WSP(bf16_t, WS_QC), WSP(float, WS_MISC)};
        pg8::gemm_phase<pg8::EpiCq, pg8::StaticOrder, true, true>(L, g, S, E);
        SEAM(PH_CQ);
    }
    if (IN(PH_XATTN)) {
        const int vcu = (G % 8 == 0) ? ((int)blockIdx.x % 8) * (G / 8) + (int)blockIdx.x / 8 : (int)blockIdx.x;
        float* wsf = (float*)(lds + LDS_WSCR) + (tid >> 6) * 64;
        for (int id = vcu; id < 512; id += G) xattn::xattn_unit(id >> 2, id & 3, WSP(bf16_t, WS_QC), WSP(bf16_t, WS_KVM), WSP(bf16_t, WS_OC), (char*)lds, wsf);
        SEAM(PH_XATTN);
    }
    if (IN(PH_CO)) {
        pg8::Gemm g{WSP(bf16_t, WS_OC), WSP(bf16_t, WS_WCO), T, D, D}; pg8::StaticOrder S; S.init(T, D, G, (int)blockIdx.x);
        pg8::EpiCo E{WSP(bf16_t, WS_X1B), args.out, WSP(float, WS_MISC) + T};
        pg8::gemm_phase<pg8::EpiCo, pg8::StaticOrder, true, true>(L, g, S, E);
        SEAM(PH_CO);
    }
    if (IN(PH_FIN)) {
        const int wave = __builtin_amdgcn_readfirstlane(tid >> 6), lane = tid & 63;
        const int gw = (int)blockIdx.x * NWAVES + wave, NGW = G * NWAVES;
        const float* rss2 = WSP(float, WS_MISC) + T; const float* w = (const float*)args.in[19];
        f32x4 ww[4];
#pragma unroll
        for (int j = 0; j < 4; ++j) ww[j] = ((const f32x4*)w)[lane + 64 * j];
        for (int m = gw; m < T; m += NGW) {
            const float r = rsqrtf(rss2[m] * (1.f / D) + EPS);
            f32x4* xr = (f32x4*)(args.out + (size_t)m * D);
#pragma unroll
            for (int j = 0; j < 4; ++j) { f32x4 v = xr[lane + 64 * j]; v = v * ww[j] * r; xr[lane + 64 * j] = v; }
        }
    }
#undef IN
#undef SEAM
}

extern "C" void kernel_launch(void* const* d_in, const int* in_sizes, int n_in, void* d_out, int out_size, void* d_ws, size_t ws_size, hipStream_t stream) {
    if (n_in != 20 || in_sizes[0] != T * D || out_size != T * D || ws_size < WS_END) { fprintf(stderr, "kernel_launch: unexpected shapes / workspace (%d inputs, ws %zu)\n", n_in, ws_size); return; }
    const float* x = (const float*)d_in[0]; const float* mem = (const float*)d_in[1]; const int* pos = (const int*)d_in[2];
    const float* norm_mix_w = (const float*)d_in[3]; const float* w_in = (const float*)d_in[4]; const float* w_alpha2 = (const float*)d_in[5];
    const float* b_alpha2 = (const float*)d_in[6]; const float* gla_norm_w = (const float*)d_in[7];
    const float* lq1 = (const float*)d_in[8]; const float* lk1 = (const float*)d_in[9]; const float* lq2 = (const float*)d_in[10]; const float* lk2 = (const float*)d_in[11];
    const float* diff_norm_w = (const float*)d_in[12]; const float* w_out = (const float*)d_in[13]; const float* norm_cross_w = (const float*)d_in[14];
    const float* norm_mem_w = (const float*)d_in[15]; const float* w_cq = (const float*)d_in[16]; const float* w_ckv = (const float*)d_in[17];
    const float* w_co = (const float*)d_in[18]; const float* final_norm_w = (const float*)d_in[19];
    float* out = (float*)d_out; unsigned char* ws = (unsigned char*)d_ws;
    bf16_t* WIN = (bf16_t*)(ws + WS_WIN); bf16_t* WOUT = (bf16_t*)(ws + WS_WOUT); bf16_t* WCQ = (bf16_t*)(ws + WS_WCQ); bf16_t* WCO = (bf16_t*)(ws + WS_WCO); bf16_t* WCKV = (bf16_t*)(ws + WS_WCKV);
    bf16_t* MEMN = (bf16_t*)(ws + WS_MEMN); bf16_t* KVM = (bf16_t*)(ws + WS_KVM); float* GA = (float*)(ws + WS_GA);
    float* CS = (float*)(ws + WS_ROPE); float* SN = CS + T * 8; float* RSS = (float*)(ws + WS_MISC); float* RSS2 = RSS + T; float* LAM = RSS + 2 * T;
    bf16_t* XN = (bf16_t*)(ws + WS_XN); bf16_t* MIXED = (bf16_t*)(ws + WS_MIXED); bf16_t* PROJ = (bf16_t*)(ws + WS_PROJ);
    bf16_t* X1B = (bf16_t*)(ws + WS_X1B); bf16_t* QC = (bf16_t*)(ws + WS_QC); bf16_t* OC = (bf16_t*)(ws + WS_OC); bf16_t* OD = (bf16_t*)(ws + WS_OD);
    float* GO = (float*)(ws + WS_KVC); float* G = (float*)(ws + WS_ST);

    auto nb = [](size_t n, int b) { return (unsigned)((n + b - 1) / b); };
    static int grid = 0;
    if (grid == 0) {
        int dev = 0, cus = 0;
        if (hipGetDevice(&dev) != hipSuccess || hipDeviceGetAttribute(&cus, hipDeviceAttributeMultiprocessorCount, dev) != hipSuccess) { fprintf(stderr, "kernel_launch: device query failed\n"); grid = -1; return; }
        if (hipFuncSetAttribute((const void*)mk_fwd, hipFuncAttributeMaxDynamicSharedMemorySize, LDS_BYTES) != hipSuccess) { fprintf(stderr, "kernel_launch: hipFuncSetAttribute failed\n"); grid = -1; return; }
        grid = cus;
        if (grid != 256) fprintf(stderr, "kernel_launch: %d CUs (expected 256)\n", grid);
    }
    if (grid < 0) return;
    (void)hipMemsetAsync((char*)d_ws + WS_CTL, 0, CTL_ZERO_BYTES, stream);
    Args a{};
    for (int i = 0; i < 20; ++i) a.in[i] = d_in[i];
    a.out = out; a.ws = ws; a.sub = 3;
#define MK(p) do { a.ph_lo = (p); a.ph_hi = (p) + 1; hipLaunchKernelGGL(mk_fwd, dim3(grid), dim3(NWAVES * 64), LDS_BYTES, stream, a); } while (0)
#ifdef MULTI_LAUNCH
    MK(PH_PRO); MK(PH_INPROJ);
#ifdef REP_PH
    if (REP_PH <= PH_INPROJ) { a.sub = REP_SUB; for (int rep_ = 0; rep_ < REP_N; ++rep_) MK(REP_PH); a.sub = 3; }
#endif
    MK(PH_ATTN); MK(PH_MIX); MK(PH_OUTPROJ); MK(PH_CQ); MK(PH_XATTN);
#ifdef REP_PH
    if (REP_PH > PH_INPROJ) { a.sub = REP_SUB; for (int rep_ = 0; rep_ < REP_N; ++rep_) MK(REP_PH); a.sub = 3; }
#endif
    MK(PH_CO); MK(PH_FIN);
#else
    a.ph_lo = 0; a.ph_hi = PH_END;
    hipLaunchKernelGGL(mk_fwd, dim3(grid), dim3(NWAVES * 64), LDS_BYTES, stream, a);
#endif
}
```

```cpp
#include <hip/hip_runtime.h>
#include <cstdio>
#include <cstdint>

typedef unsigned short bf16_t;
typedef short bf16x8 __attribute__((ext_vector_type(8)));
typedef float f32x4 __attribute__((ext_vector_type(4)));

constexpr int BATCH = 8, SEQ = 4096, D = 1024, T = BATCH * SEQ;
constexpr int MEM_LEN = 256, TM = BATCH * MEM_LEN;
constexpr int D_IN = 3600, NP = 3840, PP = 3584;
constexpr float EPS = 1e-6f;
constexpr int C_GQ = 0, C_GK = 256, C_GV = 512, C_GG = 1024, C_DQ = 1536, C_DK = 2048, C_DV = 2560, C_DG = 3072, C_GA = 3584;

constexpr size_t MiB = 1u << 20;
constexpr size_t WS_CTL = 0;
constexpr size_t WS_WIN = 1 * MiB;
constexpr size_t WS_WOUT = 9 * MiB;
constexpr size_t WS_WCQ = 11 * MiB;
constexpr size_t WS_WCO = 13 * MiB;
constexpr size_t WS_WCKV = 15 * MiB;
constexpr size_t WS_MEMN = 20 * MiB;
constexpr size_t WS_KVM = 24 * MiB;
constexpr size_t WS_GA = 32 * MiB;
constexpr size_t WS_ROPE = 34 * MiB;
constexpr size_t WS_MISC = 36 * MiB;
constexpr size_t WS_XN = 40 * MiB;
constexpr size_t WS_MIXED = WS_XN;
constexpr size_t WS_PROJ = 104 * MiB;
constexpr size_t WS_X1B = WS_PROJ, WS_QC = WS_PROJ + 64 * MiB, WS_OC = WS_PROJ + 128 * MiB;
constexpr size_t WS_OD = 328 * MiB;
constexpr size_t WS_KVC = 392 * MiB;
constexpr size_t WS_ST = 456 * MiB;
constexpr size_t WS_END = 488 * MiB;

__device__ __forceinline__ bf16_t f2bf(float f) { unsigned u = __float_as_uint(f); return (bf16_t)((u + 0x7fffu + ((u >> 16) & 1u)) >> 16); }
__device__ __forceinline__ float bf2f(bf16_t h) { return __uint_as_float(((unsigned)h) << 16); }
__device__ __forceinline__ float wave_sum(float v) {
#pragma unroll
    for (int o = 1; o < 64; o <<= 1) v += __shfl_xor(v, o);
    return v;
}
__device__ __forceinline__ float silu(float x) { return x / (1.f + __expf(-x)); }

__device__ __forceinline__ int win_src_col(int n) { return n < 1536 ? n : (n < 3584 ? n + 16 : (n < 3600 ? n - 3584 + 1536 : -1)); }
__global__ void k_prep_w(const float* __restrict__ W, int K, int Nsrc, bf16_t* __restrict__ Wt, int Nout, const float* __restrict__ kscale, int mode) {
    const size_t i = (size_t)blockIdx.x * blockDim.x + threadIdx.x;
    if (i >= (size_t)Nout * K) return;
    const int n = (int)(i / K), k = (int)(i % K);
    const int c = mode == 1 ? win_src_col(n) : n;
    float v = 0.f;
    if (c >= 0) { v = W[(size_t)k * Nsrc + c]; if (kscale) v *= kscale[k]; }
    Wt[i] = f2bf(v);
}
__global__ void k_rmsnorm_rows(const float* __restrict__ x, const float* __restrict__ w, bf16_t* __restrict__ out, int rows) {
    const int row = blockIdx.x * (blockDim.x / 64) + (threadIdx.x >> 6), lane = threadIdx.x & 63;
    if (row >= rows) return;
    const f32x4* xr = (const f32x4*)(x + (size_t)row * D);
    f32x4 v[4]; float s = 0.f;
#pragma unroll
    for (int j = 0; j < 4; ++j) { v[j] = xr[lane + 64 * j]; s += v[j].x * v[j].x + v[j].y * v[j].y + v[j].z * v[j].z + v[j].w * v[j].w; }
    const float r = rsqrtf(wave_sum(s) * (1.f / D) + EPS);
#pragma unroll
    for (int j = 0; j < 4; ++j) {
        const f32x4 ww = ((const f32x4*)w)[lane + 64 * j];
        bf16_t* o = out + (size_t)row * D + 4 * (lane + 64 * j);
        o[0] = f2bf(v[j].x * r * ww.x); o[1] = f2bf(v[j].y * r * ww.y); o[2] = f2bf(v[j].z * r * ww.z); o[3] = f2bf(v[j].w * r * ww.w);
    }
}
__device__ __forceinline__ void sincos_d(double a, float& c, float& s) {
    const double q = rint(a * 0.63661977236758134308);
    double r = fma(-q, 1.5707963267948966, a); r = fma(-q, 6.123233995736766e-17, r);
    const double r2 = r * r;
    double sp = r * (1.0 + r2 * (-1.0 / 6 + r2 * (1.0 / 120 + r2 * (-1.0 / 5040 + r2 * (1.0 / 362880 + r2 * (-1.0 / 39916800 + r2 * (1.0 / 6227020800.0)))))));
    double cp = 1.0 + r2 * (-0.5 + r2 * (1.0 / 24 + r2 * (-1.0 / 720 + r2 * (1.0 / 40320 + r2 * (-1.0 / 3628800 + r2 * (1.0 / 479001600.0 + r2 * (-1.0 / 87178291200.0)))))));
    const int qi = ((int)(long long)q) & 3;
    double cc = (qi == 0) ? cp : (qi == 1) ? -sp : (qi == 2) ? -cp : sp;
    double ss = (qi == 0) ? sp : (qi == 1) ? cp : (qi == 2) ? -sp : -cp;
    c = (float)cc; s = (float)ss;
}
__global__ void k_rope_tab(const int* __restrict__ pos, float* __restrict__ cs, float* __restrict__ sn, float* __restrict__ lam,
                           const float* q1, const float* k1, const float* q2, const float* k2, float* rss) {
    const int i = blockIdx.x * blockDim.x + threadIdx.x;
    if (i < T * 8) {
        const int t = i >> 3, j = i & 7;
        const double invf[8] = {1.0, 0.19392274474868576, 0.03760603093086393, 0.007292664737217109, 0.001414213562373095, 0.0002742481756762073, 5.318295896944988e-05, 1.031338537721246e-05};
        double f = invf[0];
#pragma unroll
        for (int u = 1; u < 8; ++u) f = (j == u) ? invf[u] : f;
        float c, s; sincos_d((double)pos[t] * f, c, s);
        cs[i] = c; sn[i] = s;
    }
    if (i < 2 * T) rss[i] = 0.f;
    if (i == 0) {
        float a = 0.f, b = 0.f;
        for (int u = 0; u < 64; ++u) { a += q1[u] * k1[u]; b += q2[u] * k2[u]; }
        lam[0] = expf(a) - expf(b) + 0.2f;
    }
}

template <class Epi>
__global__ void __launch_bounds__(256) k_gemm(const bf16_t* __restrict__ A, const bf16_t* __restrict__ Bt, int M, int N, int K, Epi epi) {
    const int lane = threadIdx.x & 63, wid = threadIdx.x >> 6, wr = wid >> 1, wc = wid & 1;
    const int m0 = blockIdx.y * 64 + wr * 32, n0 = blockIdx.x * 64 + wc * 32;
    const int fr = lane & 15, fq = lane >> 4;
    f32x4 acc[2][2];
#pragma unroll
    for (int i = 0; i < 2; ++i)
#pragma unroll
        for (int j = 0; j < 2; ++j) acc[i][j] = (f32x4){0.f, 0.f, 0.f, 0.f};
    const bf16_t* ap = A + (size_t)(m0 + fr) * K + 8 * fq;
    const bf16_t* bp = Bt + (size_t)(n0 + fr) * K + 8 * fq;
    for (int k0 = 0; k0 < K; k0 += 32) {
        bf16x8 a[2], b[2];
#pragma unroll
        for (int i = 0; i < 2; ++i) { a[i] = *(const bf16x8*)(ap + (size_t)i * 16 * K + k0); b[i] = *(const bf16x8*)(bp + (size_t)i * 16 * K + k0); }
#pragma unroll
        for (int i = 0; i < 2; ++i)
#pragma unroll
            for (int j = 0; j < 2; ++j) acc[i][j] = __builtin_amdgcn_mfma_f32_16x16x32_bf16(a[i], b[j], acc[i][j], 0, 0, 0);
    }
#pragma unroll
    for (int i = 0; i < 2; ++i)
#pragma unroll
        for (int j = 0; j < 2; ++j)
#pragma unroll
            for (int r = 0; r < 4; ++r) epi(m0 + i * 16 + fq * 4 + r, n0 + j * 16 + fr, acc[i][j][r]);
}
struct EpiInProj { bf16_t* proj; float* ga;
    __device__ __forceinline__ void operator()(int m, int n, float v) const { if (n < PP) proj[(size_t)m * PP + n] = f2bf(v); else if (n < PP + 16) ga[m * 16 + n - PP] = v; } };
struct EpiBf16Plain { bf16_t* o; int ld;
    __device__ __forceinline__ void operator()(int m, int n, float v) const { o[(size_t)m * ld + n] = f2bf(v); } };
struct EpiOutProj { const float* x; float* x1; bf16_t* x1b; float* rss;
    __device__ __forceinline__ void operator()(int m, int n, float v) const { const size_t i = (size_t)m * D + n; const float y = x[i] + v; x1[i] = y; x1b[i] = f2bf(y); atomicAdd(rss + m, y * y); } };
struct EpiCq { bf16_t* qc; const float* rss;
    __device__ __forceinline__ void operator()(int m, int n, float v) const { qc[(size_t)m * D + n] = f2bf(v * rsqrtf(rss[m] * (1.f / D) + EPS) * (0.0625f * 1.4426950408889634f)); } };
struct EpiCo { float* x12; float* rss2;
    __device__ __forceinline__ void operator()(int m, int n, float v) const { const size_t i = (size_t)m * D + n; const float y = x12[i] + v; x12[i] = y; atomicAdd(rss2 + m, y * y); } };

__global__ void k_rope(bf16_t* __restrict__ proj, const float* __restrict__ cs, const float* __restrict__ sn) {
    const int i = blockIdx.x * blockDim.x + threadIdx.x;
    if (i >= T * 128) return;
    const int j = i & 7, hm = (i >> 3) & 7, wh = (i >> 6) & 1, t = i >> 7;
    bf16_t* b = proj + (size_t)t * PP + (wh ? C_DK : C_DQ) + hm * 64;
    const float r1 = bf2f(b[j]), r2 = bf2f(b[j + 8]), c = cs[t * 8 + j], s = sn[t * 8 + j];
    b[j] = f2bf(r1 * c - r2 * s); b[j + 8] = f2bf(r2 * c + r1 * s);
}

__global__ void k_gla_gate(const float* __restrict__ ga, const float* __restrict__ w2, const float* __restrict__ b2, float* __restrict__ G) {
    const int i = blockIdx.x * blockDim.x + threadIdx.x;
    if (i >= T * 256) return;
    const int c = i & 255, t = i >> 8;
    float z = b2[c];
#pragma unroll
    for (int r = 0; r < 16; ++r) z += ga[t * 16 + r] * w2[r * 256 + c];
    const float ls = fminf(z, 0.f) - log1pf(expf(-fabsf(z)));
    G[i] = ls * (1.f / 16.f);
}
__global__ void __launch_bounds__(128) k_gla_rec(const bf16_t* __restrict__ proj, const float* __restrict__ G, float* __restrict__ GO) {
    const int e = threadIdx.x, h = blockIdx.x & 3, b = blockIdx.x >> 2;
    float S[64];
#pragma unroll
    for (int c = 0; c < 64; ++c) S[c] = 0.f;
    for (int s = 0; s < SEQ; ++s) {
        const size_t t = (size_t)b * SEQ + s;
        const bf16x8* q8 = (const bf16x8*)(proj + t * PP + C_GQ + h * 64);
        const bf16x8* k8 = (const bf16x8*)(proj + t * PP + C_GK + h * 64);
        const float v = bf2f(proj[t * PP + C_GV + h * 128 + e]);
        const f32x4* g4 = (const f32x4*)(G + t * 256 + h * 64);
        float o = 0.f;
#pragma unroll
        for (int c8 = 0; c8 < 8; ++c8) {
            const bf16x8 qq = q8[c8], kk = k8[c8]; const f32x4 ga = g4[2 * c8], gb = g4[2 * c8 + 1];
#pragma unroll
            for (int j = 0; j < 8; ++j) { const int c = c8 * 8 + j; const float g = j < 4 ? ga[j] : gb[j - 4];
                S[c] = __expf(g) * S[c] + bf2f((bf16_t)kk[j]) * v; o += bf2f((bf16_t)qq[j]) * S[c]; }
        }
        GO[t * 512 + h * 128 + e] = o * 0.125f;
    }
}
__global__ void k_gla_out(const float* __restrict__ GO, const bf16_t* __restrict__ proj, const float* __restrict__ w, bf16_t* __restrict__ mixed) {
    const int gw = blockIdx.x * (blockDim.x / 64) + (threadIdx.x >> 6), lane = threadIdx.x & 63;
    if (gw >= T * 4) return;
    const int h = gw & 3; const size_t t = gw >> 2;
    const float o0 = GO[t * 512 + h * 128 + lane], o1 = GO[t * 512 + h * 128 + 64 + lane];
    const float r = rsqrtf(wave_sum(o0 * o0 + o1 * o1) * (1.f / 128) + EPS);
    const float g0 = bf2f(proj[t * PP + C_GG + h * 128 + lane]), g1 = bf2f(proj[t * PP + C_GG + h * 128 + 64 + lane]);
    mixed[t * D + h * 128 + lane] = f2bf(o0 * r * w[lane] * silu(g0));
    mixed[t * D + h * 128 + 64 + lane] = f2bf(o1 * r * w[64 + lane] * silu(g1));
}

__global__ void __launch_bounds__(256) k_diff_attn(const bf16_t* __restrict__ proj, bf16_t* __restrict__ od) {
    const int tid = threadIdx.x, qtr = tid & 3, rl = tid >> 2;
    const int hm = blockIdx.x & 7, chunk = (blockIdx.x >> 3) & 63, b = blockIdx.x >> 9;
    const int h = hm >> 1;
    const size_t t = (size_t)b * SEQ + chunk * 64 + rl;
    float q[64];
    { const bf16x8* qp = (const bf16x8*)(proj + t * PP + C_DQ + hm * 64);
#pragma unroll
      for (int c = 0; c < 8; ++c) { const bf16x8 qq = qp[c];
#pragma unroll
          for (int j = 0; j < 8; ++j) q[c * 8 + j] = bf2f((bf16_t)qq[j]); } }
    float o[32];
#pragma unroll
    for (int i = 0; i < 32; ++i) o[i] = 0.f;
    float m = -INFINITY, l = 0.f;
    const int nk = (chunk + 1) * 64;
    for (int j = 0; j < nk; ++j) {
        const size_t tk = (size_t)b * SEQ + j;
        const bf16x8* kp = (const bf16x8*)(proj + tk * PP + C_DK + hm * 64);
        float s = 0.f;
#pragma unroll
        for (int c = 0; c < 8; ++c) { const bf16x8 kk = kp[c];
#pragma unroll
            for (int j = 0; j < 8; ++j) s += q[c * 8 + j] * bf2f((bf16_t)kk[j]); }
        const float mn = fmaxf(m, s), al = exp2f(m - mn), p = exp2f(s - mn);
        l = l * al + p; m = mn;
        const bf16x8* vp = (const bf16x8*)(proj + tk * PP + C_DV + h * 128 + qtr * 32);
#pragma unroll
        for (int c = 0; c < 4; ++c) { const bf16x8 vv = vp[c];
#pragma unroll
            for (int j = 0; j < 8; ++j) o[c * 8 + j] = o[c * 8 + j] * al + p * bf2f((bf16_t)vv[j]); }
    }
    const float rl_ = 1.f / l;
#pragma unroll
    for (int i = 0; i < 32; ++i) od[t * D + hm * 128 + qtr * 32 + i] = f2bf(o[i] * rl_);
}
__global__ void k_diff_out(const bf16_t* __restrict__ od, const bf16_t* __restrict__ proj, const float* __restrict__ w, const float* __restrict__ lam, bf16_t* __restrict__ mixed) {
    const int gw = blockIdx.x * (blockDim.x / 64) + (threadIdx.x >> 6), lane = threadIdx.x & 63;
    if (gw >= T * 4) return;
    const int h = gw & 3; const size_t t = gw >> 2;
    const float lm = lam[0];
    const bf16_t* o1 = od + t * D + (2 * h) * 128; const bf16_t* o2 = o1 + 128;
    const float d0 = bf2f(o1[lane]) - lm * bf2f(o2[lane]), d1 = bf2f(o1[64 + lane]) - lm * bf2f(o2[64 + lane]);
    const float r = rsqrtf(wave_sum(d0 * d0 + d1 * d1) * (1.f / 128) + EPS);
    const float g0 = bf2f(proj[t * PP + C_DG + h * 128 + lane]), g1 = bf2f(proj[t * PP + C_DG + h * 128 + 64 + lane]);
    mixed[t * D + 512 + h * 128 + lane] = f2bf(d0 * r * w[lane] * 0.8f * silu(g0));
    mixed[t * D + 512 + h * 128 + 64 + lane] = f2bf(d1 * r * w[64 + lane] * 0.8f * silu(g1));
}

__global__ void __launch_bounds__(256) k_cross_attn(const bf16_t* __restrict__ qc, const bf16_t* __restrict__ kvm, bf16_t* __restrict__ oc) {
    __shared__ float sp[16][257];
    __shared__ float sl[16];
    const int tid = threadIdx.x, head = blockIdx.x & 3, tile = blockIdx.x >> 2;
    const size_t t0 = (size_t)tile * 16; const int b = (int)(t0 / SEQ);
    const bf16_t* kp = kvm + (size_t)(b * MEM_LEN + tid) * 2048 + head * 256;
    float acc[16];
#pragma unroll
    for (int r = 0; r < 16; ++r) acc[r] = 0.f;
    for (int d = 0; d < 256; ++d) {
        const float kv = bf2f(kp[d]);
#pragma unroll
        for (int r = 0; r < 16; ++r) acc[r] += kv * bf2f(qc[(t0 + r) * D + head * 256 + d]);
    }
#pragma unroll
    for (int r = 0; r < 16; ++r) sp[r][tid] = acc[r];
    __syncthreads();
    { const int w = tid >> 6, lane = tid & 63;
      for (int r = w * 4; r < w * 4 + 4; ++r) {
          float mx = -INFINITY;
          for (int j = lane; j < 256; j += 64) mx = fmaxf(mx, sp[r][j]);
#pragma unroll
          for (int o = 1; o < 64; o <<= 1) mx = fmaxf(mx, __shfl_xor(mx, o));
          float sum = 0.f;
          for (int j = lane; j < 256; j += 64) { const float p = exp2f(sp[r][j] - mx); sp[r][j] = p; sum += p; }
          sum = wave_sum(sum);
          if (lane == 0) sl[r] = sum;
      } }
    __syncthreads();
#pragma unroll
    for (int r = 0; r < 16; ++r) acc[r] = 0.f;
    const bf16_t* vp = kvm + (size_t)(b * MEM_LEN) * 2048 + 1024 + head * 256 + tid;
    for (int j = 0; j < 256; ++j) {
        const float v = bf2f(vp[(size_t)j * 2048]);
#pragma unroll
        for (int r = 0; r < 16; ++r) acc[r] += sp[r][j] * v;
    }
#pragma unroll
    for (int r = 0; r < 16; ++r) oc[(t0 + r) * D + head * 256 + tid] = f2bf(acc[r] / sl[r]);
}
__global__ void k_final_norm(float* __restrict__ x2, const float* __restrict__ rss2, const float* __restrict__ w) {
    const int row = blockIdx.x * (blockDim.x / 64) + (threadIdx.x >> 6), lane = threadIdx.x & 63;
    if (row >= T) return;
    const float r = rsqrtf(rss2[row] * (1.f / D) + EPS);
    f32x4* xr = (f32x4*)(x2 + (size_t)row * D);
#pragma unroll
    for (int j = 0; j < 4; ++j) { f32x4 v = xr[lane + 64 * j]; const f32x4 ww = ((const f32x4*)w)[lane + 64 * j]; v.x *= r * ww.x; v.y *= r * ww.y; v.z *= r * ww.z; v.w *= r * ww.w; xr[lane + 64 * j] = v; }
}


namespace pg8 {
#define PG8_LAS __attribute__((address_space(3)))
typedef unsigned short bf16_t;
typedef short bf16x8 __attribute__((ext_vector_type(8)));
typedef float f32x4 __attribute__((ext_vector_type(4)));
typedef unsigned u32x4 __attribute__((ext_vector_type(4)));
constexpr int BM = 256, BK = 64, HALF = 128, HTB = HALF * BK * 2  , STAGE_BYTES = 8 * HTB, NXCD = 8, WGM = 8;

__host__ __device__ __forceinline__ int lds_byte(int r, int c) { const int st = (r >> 4) * 2 + (c >> 5), rr = r & 15, cc = c & 31, ob = rr * 64 + cc * 2; return st * 1024 + (ob ^ (((ob >> 9) & 1) << 5)); }
__host__ __device__ __forceinline__ void stage_rc(int b, int& R, int& C) { const int st = b / 1024, sb = b % 1024, swz = sb ^ (((sb >> 9) & 1) << 5); R = (st >> 1) * 16 + swz / 64; C = (st & 1) * 32 + (swz % 64) / 2; }
__host__ __device__ __forceinline__ int perm32(int rho) { const int n = rho >> 4, i = rho & 15; return 8 * (i >> 2) + 4 * n + (i & 3); }

struct Unit { int pm, pn; };
struct Gemm { const bf16_t* A; const bf16_t* Bt; int M, N, K; };

struct StaticOrder {
    int nM, nN, nwg, G, c;
    __host__ __device__ void init(int M, int N, int G_, int c_) { nM = M / BM; nN = N / BM; nwg = nM * nN; G = G_; c = c_; }
    __host__ __device__ bool next(int i, Unit& u) const {
        const long L = (long)i * G + c; if (L >= nwg) return false;
        int wgid = (int)L; { const int q = nwg / NXCD, r = nwg % NXCD, xcd = wgid % NXCD, off = wgid / NXCD; wgid = (xcd < r ? xcd * (q + 1) : r * (q + 1) + (xcd - r) * q) + off; }
        const int nig = WGM * nN, gid = wgid / nig, fm = gid * WGM, gsz = (nM - fm) < WGM ? (nM - fm) : WGM;
        u.pm = fm + ((wgid % nig) % gsz); u.pn = (wgid % nig) / gsz; return true;
    }
    __device__ __forceinline__ void a_ready(const Unit&) const {}
    __device__ __forceinline__ void done(const Unit&) const {}
};

__device__ __forceinline__ unsigned cvt_pk_bf16(float lo, float hi) { unsigned r; asm volatile("v_cvt_pk_bf16_f32 %0, %1, %2" : "=v"(r) : "v"(lo), "v"(hi)); return r; }
typedef float f32x2 __attribute__((ext_vector_type(2)));
__device__ __forceinline__ f32x2 gelu_pk(f32x2 v) {
    const f32x2 av = __builtin_elementwise_abs(v), d = av * 0.2316418882f + 1.0f;
    f32x2 t; t.x = __builtin_amdgcn_rcpf(d.x); t.y = __builtin_amdgcn_rcpf(d.y);
    f32x2 q = t * 0.5307027145f + (-0.7265760135f); q = q * t + 0.7107068705f; q = q * t + (-0.142248368f); q = q * t + 0.127414796f; q = q * t;
    const f32x2 s = (v * v) * (-0.72134752044f);
    f32x2 e; e.x = __builtin_amdgcn_exp2f(s.x); e.y = __builtin_amdgcn_exp2f(s.y);
    const f32x2 m = v * (q * e), r = v - m;
    f32x2 o; o.x = v.x < 0.f ? m.x : r.x; o.y = v.y < 0.f ? m.y : r.y; return o;
}

template <int ACT  > struct EpiBf16 {
    static constexpr bool PERM = true, AFTER_DRAIN = false; static_assert(ACT == 0 || ACT == 1, "EpiBf16: ACT is 0 (none) or 1 (gelu_pk)");
    bf16_t* O; int ldc; const float* bias; int split_cols; size_t split_stride; float scale0;
    __device__ __forceinline__ void operator()(const f32x4 (&acc)[2][2][4][2], const Unit& u, int wr, int wc, int fr, int fq) const {
        asm volatile("" : "+v"(fr), "+v"(fq));
        const int row0 = u.pm * BM + wr * 64 + fr; int colt = u.pn * BM; bf16_t* base = O;
        float sc = 1.f; if (split_cols) { const int t = colt / split_cols; base += (size_t)t * split_stride; colt -= t * split_cols; if (t == 0) sc = scale0; }
        const int col0 = colt + wc * 32 + 8 * fq, bcol0 = u.pn * BM + wc * 32 + 8 * fq;
        f32x4 bv[2][2];
#pragma unroll
        for (int bj = 0; bj < 2; ++bj)
#pragma unroll
            for (int n = 0; n < 2; ++n) bv[bj][n] = bias ? *(const f32x4*)(bias + bcol0 + bj * HALF + 4 * n) : (f32x4){0.f, 0.f, 0.f, 0.f};
#pragma unroll
        for (int ai = 0; ai < 2; ++ai)
#pragma unroll
            for (int m = 0; m < 4; ++m) { bf16_t* rowp = base + (size_t)(row0 + ai * HALF + m * 16) * ldc + col0;
#pragma unroll
                for (int bj = 0; bj < 2; ++bj) { f32x4 v0 = acc[ai][bj][m][0] + bv[bj][0], v1 = acc[ai][bj][m][1] + bv[bj][1];
                    if (ACT == 1) { f32x2 a = gelu_pk((f32x2){v0[0], v0[1]}), b = gelu_pk((f32x2){v0[2], v0[3]}), c = gelu_pk((f32x2){v1[0], v1[1]}), d = gelu_pk((f32x2){v1[2], v1[3]});
                        v0 = (f32x4){a.x, a.y, b.x, b.y}; v1 = (f32x4){c.x, c.y, d.x, d.y}; }
                    v0 = v0 * sc; v1 = v1 * sc; u32x4 w; w.x = cvt_pk_bf16(v0[0], v0[1]); w.y = cvt_pk_bf16(v0[2], v0[3]); w.z = cvt_pk_bf16(v1[0], v1[1]); w.w = cvt_pk_bf16(v1[2], v1[3]);
                    *(u32x4*)(rowp + bj * HALF) = w; } }
    }
};

constexpr float QC2 = 0.125f * 1.4426950408889634f;
constexpr float QC3 = 0.0625f * 1.4426950408889634f;
constexpr int PPITCH = 3584;
__device__ __forceinline__ u32x4 pack8(const f32x4& v0, const f32x4& v1) { u32x4 w; w.x = cvt_pk_bf16(v0[0], v0[1]); w.y = cvt_pk_bf16(v0[2], v0[3]); w.z = cvt_pk_bf16(v1[0], v1[1]); w.w = cvt_pk_bf16(v1[2], v1[3]); return w; }
struct EpiInProj {
    static constexpr bool PERM = true, AFTER_DRAIN = false;
    bf16_t* proj; float* ga; const float* cs; const float* sn;
    __device__ __forceinline__ void operator()(const f32x4 (&acc)[2][2][4][2], const Unit& u, int wr, int wc, int fr, int fq) const {
        asm volatile("" : "+v"(fr), "+v"(fq));
        const int row0 = u.pm * BM + wr * 64 + fr;
        if (u.pn == 14) {
            if (wc == 0 && fq < 2) {
#pragma unroll
                for (int ai = 0; ai < 2; ++ai)
#pragma unroll
                    for (int m = 0; m < 4; ++m) { float* g = ga + (size_t)(row0 + ai * HALF + m * 16) * 16 + 8 * fq; *(f32x4*)g = acc[ai][0][m][0]; *(f32x4*)(g + 4) = acc[ai][0][m][1]; }
            }
            return;
        }
#ifdef NO_ROPE
        const bool rope = false;
#else
        const bool rope = (u.pn >= 6) && (u.pn <= 9) && ((wc & 1) == 0);
#endif
        const float sc = (u.pn == 6 || u.pn == 7) ? QC2 : 1.f;
        const float sg = (fq == 0) ? -1.f : 1.f;
        const bool rl = fq < 2;
        bf16_t* base = proj + u.pn * BM + wc * 32 + 8 * fq;
#pragma unroll
        for (int ai = 0; ai < 2; ++ai)
#pragma unroll
            for (int m = 0; m < 4; ++m) {
                const int row = row0 + ai * HALF + m * 16;
                f32x4 c0 = (f32x4){1.f, 1.f, 1.f, 1.f}, c1 = c0, s0 = (f32x4){0.f, 0.f, 0.f, 0.f}, s1 = s0;
                if (rope) { c0 = *(const f32x4*)(cs + (size_t)row * 8); c1 = *(const f32x4*)(cs + (size_t)row * 8 + 4); s0 = *(const f32x4*)(sn + (size_t)row * 8); s1 = *(const f32x4*)(sn + (size_t)row * 8 + 4); }
#pragma unroll
                for (int bj = 0; bj < 2; ++bj) {
                    f32x4 v0 = acc[ai][bj][m][0], v1 = acc[ai][bj][m][1];
                    if (rope) {
                        f32x4 p0, p1;
#pragma unroll
                        for (int i = 0; i < 4; ++i) { p0[i] = __shfl_xor(v0[i], 16); p1[i] = __shfl_xor(v1[i], 16); }
                        if (rl) { v0 = v0 * c0 + (p0 * s0) * sg; v1 = v1 * c1 + (p1 * s1) * sg; }
                    }
                    v0 = v0 * sc; v1 = v1 * sc;
                    *(u32x4*)(base + (size_t)row * PPITCH + bj * HALF) = pack8(v0, v1);
                }
                asm volatile("" ::: "memory");
            }
    }
};
struct EpiOutProj {
    static constexpr bool PERM = true, AFTER_DRAIN = false;
    const float* x; float* x1; bf16_t* x1b; float* rss;
    __device__ __forceinline__ void operator()(const f32x4 (&acc)[2][2][4][2], const Unit& u, int wr, int wc, int fr, int fq) const {
        asm volatile("" : "+v"(fr), "+v"(fq));
        const int row0 = u.pm * BM + wr * 64 + fr, col0 = u.pn * BM + wc * 32 + 8 * fq;
#pragma unroll
        for (int ai = 0; ai < 2; ++ai)
#pragma unroll
            for (int m = 0; m < 4; ++m) {
                const int row = row0 + ai * HALF + m * 16; const size_t off = (size_t)row * 1024 + col0; float ss = 0.f;
#pragma unroll
                for (int bj = 0; bj < 2; ++bj) {
                    const f32x4 v0 = acc[ai][bj][m][0] + *(const f32x4*)(x + off + bj * HALF), v1 = acc[ai][bj][m][1] + *(const f32x4*)(x + off + bj * HALF + 4);
                    *(u32x4*)(x1b + off + bj * HALF) = pack8(v0, v1);
                    ss += (v0[0] * v0[0] + v0[1] * v0[1]) + (v0[2] * v0[2] + v0[3] * v0[3]) + (v1[0] * v1[0] + v1[1] * v1[1]) + (v1[2] * v1[2] + v1[3] * v1[3]);
                }
                ss += __shfl_xor(ss, 16); ss += __shfl_xor(ss, 32);
                if (fq == 0) atomicAdd(rss + row, ss);
                asm volatile("" ::: "memory");
            }
    }
};
struct EpiCq {
    static constexpr bool PERM = true, AFTER_DRAIN = false;
    bf16_t* qc; const float* rss;
    __device__ __forceinline__ void operator()(const f32x4 (&acc)[2][2][4][2], const Unit& u, int wr, int wc, int fr, int fq) const {
        asm volatile("" : "+v"(fr), "+v"(fq));
        const int row0 = u.pm * BM + wr * 64 + fr, col0 = u.pn * BM + wc * 32 + 8 * fq;
#pragma unroll
        for (int ai = 0; ai < 2; ++ai)
#pragma unroll
            for (int m = 0; m < 4; ++m) {
                const int row = row0 + ai * HALF + m * 16; const float r = rsqrtf(rss[row] * (1.f / 1024.f) + 1e-6f) * QC3;
#pragma unroll
                for (int bj = 0; bj < 2; ++bj) *(u32x4*)(qc + (size_t)row * 1024 + col0 + bj * HALF) = pack8(acc[ai][bj][m][0] * r, acc[ai][bj][m][1] * r);
            }
    }
};
struct EpiCo {
    static constexpr bool PERM = true, AFTER_DRAIN = false;
    const bf16_t* x1b; float* x12; float* rss2;
    __device__ __forceinline__ void operator()(const f32x4 (&acc)[2][2][4][2], const Unit& u, int wr, int wc, int fr, int fq) const {
        asm volatile("" : "+v"(fr), "+v"(fq));
        const int row0 = u.pm * BM + wr * 64 + fr, col0 = u.pn * BM + wc * 32 + 8 * fq;
#pragma unroll
        for (int ai = 0; ai < 2; ++ai)
#pragma unroll
            for (int m = 0; m < 4; ++m) {
                const int row = row0 + ai * HALF + m * 16; const size_t off = (size_t)row * 1024 + col0; float ss = 0.f;
#pragma unroll
                for (int bj = 0; bj < 2; ++bj) {
                    const u32x4 xr = *(const u32x4*)(x1b + off + bj * HALF);
                    const f32x4 r0 = (f32x4){__uint_as_float(xr.x << 16), __uint_as_float(xr.x & 0xffff0000u), __uint_as_float(xr.y << 16), __uint_as_float(xr.y & 0xffff0000u)};
                    const f32x4 r1 = (f32x4){__uint_as_float(xr.z << 16), __uint_as_float(xr.z & 0xffff0000u), __uint_as_float(xr.w << 16), __uint_as_float(xr.w & 0xffff0000u)};
                    const f32x4 v0 = acc[ai][bj][m][0] + r0, v1 = acc[ai][bj][m][1] + r1;
                    *(f32x4*)(x12 + off + bj * HALF) = v0; *(f32x4*)(x12 + off + bj * HALF + 4) = v1;
                    ss += (v0[0] * v0[0] + v0[1] * v0[1]) + (v0[2] * v0[2] + v0[3] * v0[3]) + (v1[0] * v1[0] + v1[1] * v1[1]) + (v1[2] * v1[2] + v1[3] * v1[3]);
                }
                ss += __shfl_xor(ss, 16); ss += __shfl_xor(ss, 32);
                if (fq == 0) atomicAdd(rss2 + row, ss);
                asm volatile("" ::: "memory");
            }
    }
};
template <class Epi, class Sched, bool ALIGN_EPI = false, bool SP2 = false>
__device__ __forceinline__ void gemm_phase(PG8_LAS unsigned char* lds, const Gemm g, const Sched& S, const Epi& E) {
    const int tid = threadIdx.x, wid = __builtin_amdgcn_readfirstlane(tid >> 6), lane = tid & 63, wr = wid >> 2, wc = wid & 3, fr = lane & 15, fq = lane >> 4;
    const int K = g.K, nt = K / BK;
    unsigned voffA[2], voffB[2];
#pragma unroll
    for (int i = 0; i < 2; ++i) { int R, C; stage_rc(tid * 16 + i * 8192, R, C); const int Rb = Epi::PERM ? ((R & ~31) + perm32(R & 31)) : R;
        voffA[i] = (unsigned)(R * K + C) * 2u; voffB[i] = (unsigned)(Rb * K + C) * 2u; }
    const size_t kstep = (size_t)(BK * 2);
    const size_t hstep = (size_t)HALF * K * 2;
    const size_t tstep = 2 * hstep;
    const unsigned ldsw = (unsigned)wid * 1024u;
    const int aoff = lds_byte(wr * 64 + fr, fq * 8), boff = lds_byte(wc * 32 + fr, fq * 8);
#define PG8_SA(b, h) (((b) * 2 + (h)) * HTB)
#define PG8_SB(b, h) ((4 + (b) * 2 + (h)) * HTB)
#define PG8_STAGE(bufoff, gbase, voff) do { _Pragma("unroll") for (int _i = 0; _i < 2; ++_i) \
        __builtin_amdgcn_global_load_lds((const unsigned*)((const char*)(gbase) + (voff)[_i]), (PG8_LAS unsigned*)(lds + (bufoff) + ldsw + _i * 8192), 16, 0, 0); } while (0)
#define PG8_LDA(dst, b, h) do { _Pragma("unroll") for (int m = 0; m < 4; ++m) _Pragma("unroll") for (int k = 0; k < 2; ++k) dst[m][k] = *(const PG8_LAS bf16x8*)(lds + PG8_SA(b, h) + aoff + m * 2048 + k * 1024); } while (0)
#define PG8_LDB(dst, b, h) do { _Pragma("unroll") for (int n = 0; n < 2; ++n) _Pragma("unroll") for (int k = 0; k < 2; ++k) dst[n][k] = *(const PG8_LAS bf16x8*)(lds + PG8_SB(b, h) + boff + n * 2048 + k * 1024); } while (0)
#define PG8_MMA(ai, bj, At, Bt) do { __builtin_amdgcn_s_setprio(1); _Pragma("unroll") for (int m = 0; m < 4; ++m) _Pragma("unroll") for (int n = 0; n < 2; ++n) _Pragma("unroll") for (int k = 0; k < 2; ++k) \
        acc[ai][bj][m][n] = __builtin_amdgcn_mfma_f32_16x16x32_bf16(Bt[n][k], At[m][k], acc[ai][bj][m][n], 0, 0, 0); __builtin_amdgcn_s_setprio(0); } while (0)
#define PG8_WAIT_V(n) asm volatile("s_waitcnt vmcnt(" #n ")" ::: "memory")
#define PG8_WAIT_L(n) asm volatile("s_waitcnt lgkmcnt(" #n ")" ::: "memory")
#define PG8_BAR __builtin_amdgcn_s_barrier()
#define PG8_SCHED __builtin_amdgcn_sched_barrier(0)
    Unit cur, nxt; int ui = 0;
    if (!S.next(0, cur)) return;
    f32x4 acc[2][2][4][2];
#pragma unroll
    for (int a = 0; a < 2; ++a)
#pragma unroll
        for (int b = 0; b < 2; ++b)
#pragma unroll
            for (int m = 0; m < 4; ++m)
#pragma unroll
                for (int n = 0; n < 2; ++n) acc[a][b][m][n] = (f32x4){0.f, 0.f, 0.f, 0.f};
    bf16x8 At[4][2], B0[2][2], B1[2][2];
    const char* cA = (const char*)g.A + (size_t)cur.pm * tstep; const char* cB = (const char*)g.Bt + (size_t)cur.pn * tstep;
    S.a_ready(cur);
    if constexpr (SP2) {
        PG8_STAGE(PG8_SB(0, 0), cB, voffB); PG8_STAGE(PG8_SB(0, 1), cB + hstep, voffB); PG8_STAGE(PG8_SA(0, 0), cA, voffA); PG8_STAGE(PG8_SA(0, 1), cA + hstep, voffA);
        if (wr == 1) PG8_BAR;
        PG8_WAIT_V(2); PG8_BAR;
        PG8_STAGE(PG8_SB(1, 0), cB + kstep, voffB); PG8_STAGE(PG8_SA(1, 0), cA + kstep, voffA); PG8_STAGE(PG8_SB(1, 1), cB + hstep + kstep, voffB);
        PG8_WAIT_V(6); PG8_BAR;
    } else {
        PG8_STAGE(PG8_SB(0, 0), cB, voffB); PG8_STAGE(PG8_SA(0, 0), cA, voffA); PG8_STAGE(PG8_SB(0, 1), cB + hstep, voffB); PG8_STAGE(PG8_SA(0, 1), cA + hstep, voffA);
        if (wr == 1) PG8_BAR;
        PG8_WAIT_V(4); PG8_BAR;
        PG8_STAGE(PG8_SB(1, 0), cB + kstep, voffB); PG8_STAGE(PG8_SA(1, 0), cA + kstep, voffA); PG8_STAGE(PG8_SB(1, 1), cB + hstep + kstep, voffB);
        PG8_WAIT_V(6); PG8_BAR;
    }
    for (;;) {
        const bool has_next = S.next(ui + 1, nxt);
        const char* nA = has_next ? (const char*)g.A + (size_t)nxt.pm * tstep : cA; const char* nB = has_next ? (const char*)g.Bt + (size_t)nxt.pn * tstep : cB;
        for (int t = 0; t < nt; t += 2) {
            const bool last = (t == nt - 2);
            const char* a1 = cA + (size_t)(t + 1) * kstep;
            const char* a2 = last ? nA : cA + (size_t)(t + 2) * kstep; const char* b2 = last ? nB : cB + (size_t)(t + 2) * kstep;
            const char* a3 = a2 + kstep; const char* b3 = b2 + kstep;
            if (last && has_next) S.a_ready(nxt);
            if constexpr (SP2) {
            PG8_LDB(B0, 0, 0); PG8_LDB(B1, 0, 1); PG8_SCHED; PG8_LDA(At, 0, 0); PG8_STAGE(PG8_SA(1, 1), a1 + hstep, voffA);
            PG8_WAIT_V(8); PG8_WAIT_L(0); PG8_BAR; PG8_MMA(0, 0, At, B0); PG8_MMA(0, 1, At, B1); PG8_BAR; PG8_SCHED;
            PG8_LDA(At, 0, 1); PG8_STAGE(PG8_SB(0, 0), b2, voffB); PG8_STAGE(PG8_SB(0, 1), b2 + hstep, voffB); PG8_STAGE(PG8_SA(0, 0), a2, voffA);
            PG8_WAIT_V(8); PG8_WAIT_L(0); PG8_BAR; PG8_MMA(1, 0, At, B0); PG8_MMA(1, 1, At, B1); PG8_BAR; PG8_SCHED;
            PG8_LDB(B0, 1, 0); PG8_LDB(B1, 1, 1); PG8_SCHED; PG8_LDA(At, 1, 0); PG8_STAGE(PG8_SA(0, 1), a2 + hstep, voffA);
            PG8_WAIT_V(8); PG8_WAIT_L(0); PG8_BAR; PG8_MMA(0, 0, At, B0); PG8_MMA(0, 1, At, B1); PG8_BAR; PG8_SCHED;
            PG8_LDA(At, 1, 1); PG8_STAGE(PG8_SB(1, 0), b3, voffB); PG8_STAGE(PG8_SB(1, 1), b3 + hstep, voffB); PG8_STAGE(PG8_SA(1, 0), a3, voffA);
            PG8_WAIT_V(8); PG8_WAIT_L(0); PG8_BAR; PG8_MMA(1, 0, At, B0); PG8_MMA(1, 1, At, B1); PG8_BAR; PG8_SCHED;
            } else {
            PG8_LDB(B0, 0, 0); PG8_SCHED; PG8_LDA(At, 0, 0); PG8_STAGE(PG8_SA(1, 1), a1 + hstep, voffA);
            PG8_WAIT_L(8); PG8_BAR; PG8_WAIT_L(0); PG8_MMA(0, 0, At, B0); PG8_BAR; PG8_SCHED;
            PG8_LDB(B1, 0, 1); PG8_STAGE(PG8_SB(0, 0), b2, voffB);
            PG8_BAR; PG8_WAIT_L(0); PG8_MMA(0, 1, At, B1); PG8_BAR;
            PG8_LDA(At, 0, 1); PG8_STAGE(PG8_SA(0, 0), a2, voffA);
            PG8_BAR; PG8_WAIT_L(0); PG8_MMA(1, 0, At, B0); PG8_BAR; PG8_SCHED;
            PG8_STAGE(PG8_SB(0, 1), b2 + hstep, voffB);
            PG8_WAIT_V(6); PG8_BAR; PG8_MMA(1, 1, At, B1); PG8_BAR;
            PG8_LDB(B0, 1, 0); PG8_SCHED; PG8_LDA(At, 1, 0); PG8_STAGE(PG8_SA(0, 1), a2 + hstep, voffA);
            PG8_WAIT_L(8); PG8_BAR; PG8_WAIT_L(0); PG8_MMA(0, 0, At, B0); PG8_BAR; PG8_SCHED;
            PG8_LDB(B1, 1, 1); PG8_STAGE(PG8_SB(1, 0), b3, voffB);
            PG8_BAR; PG8_WAIT_L(0); PG8_MMA(0, 1, At, B1); PG8_BAR;
            PG8_LDA(At, 1, 1); PG8_STAGE(PG8_SA(1, 0), a3, voffA);
            PG8_BAR; PG8_WAIT_L(0); PG8_MMA(1, 0, At, B0); PG8_BAR; PG8_SCHED;
            PG8_STAGE(PG8_SB(1, 1), b3 + hstep, voffB);
            PG8_WAIT_V(6); PG8_BAR; PG8_MMA(1, 1, At, B1); PG8_BAR;
            }
        }
        if constexpr (ALIGN_EPI) { if (wr == 0) PG8_BAR; }
        if constexpr (!Epi::AFTER_DRAIN) { E(acc, cur, wr, wc, fr, fq); S.done(cur); }
        if (!has_next) break;
#pragma unroll
        for (int a = 0; a < 2; ++a)
#pragma unroll
            for (int b = 0; b < 2; ++b)
#pragma unroll
                for (int m = 0; m < 4; ++m)
#pragma unroll
                    for (int n = 0; n < 2; ++n) acc[a][b][m][n] = (f32x4){0.f, 0.f, 0.f, 0.f};
        cur = nxt; cA = nA; cB = nB; ++ui;
        if constexpr (ALIGN_EPI) { if (wr == 1) PG8_BAR; }
    }
    PG8_WAIT_V(0);
    if constexpr (!ALIGN_EPI) { if (wr == 0) PG8_BAR; }
    PG8_BAR;
    if constexpr (Epi::AFTER_DRAIN) { E.fused(acc, cur, wr, wc, fr, fq, lds, wid, lane); S.done(cur); }
#undef PG8_SA
#undef PG8_SB
#undef PG8_STAGE
#undef PG8_LDA
#undef PG8_LDB
#undef PG8_MMA
#undef PG8_WAIT_V
#undef PG8_WAIT_L
#undef PG8_BAR
#undef PG8_SCHED
}
}

#ifndef PG8_SP2
#define PG8_SP2 true
#endif
#ifndef PG8_ALIGN
#define PG8_ALIGN true
#endif

#include <hip/hip_bf16.h>
#include <cmath>
namespace attn_body {
using bf16=__hip_bfloat16;
using bf16x8=__attribute__((ext_vector_type(8)))short;
using s16x4=__attribute__((ext_vector_type(4)))short;
using f32x16=__attribute__((ext_vector_type(16)))float;
using u32x4=__attribute__((ext_vector_type(4)))unsigned;
constexpr int SEQ=4096,D=64,PQ=3584,PO=1024;
constexpr int NW=8,QBLK=32,QB=QBLK*NW,KVBLK=64,NQB=SEQ/QB;
constexpr int ATTN_UNIT_ROWS=QB;
__device__ __forceinline__ int crow(int r,int hi){return (r&3)+8*(r>>2)+4*hi;}
#define SBAR() __builtin_amdgcn_sched_barrier(0)
__device__ __forceinline__ void cmask(f32x16&p0,f32x16&p1,int jb,int qrel,int hi){
  const float NEG=-INFINITY;
  if(jb>(qrel>>6)){
  #pragma unroll
  for(int r=0;r<16;++r){p0[r]=NEG;p1[r]=NEG;}}
}

constexpr int NSLOT=3, SLOTB=8192;
constexpr int LDS_K=0, LDS_V=NSLOT*SLOTB, LDS_WS=2*NSLOT*SLOTB, LDS_OST=LDS_WS+NW*64*4, LDS_BYTES=LDS_OST+NW*4096;
constexpr float C2=0.125f*1.4426950408889634f;
__device__ __forceinline__ void glds16(const void*gsrc,unsigned lds_dst){unsigned keep;
  asm volatile("s_mov_b32 %0, m0\n\ts_mov_b32 m0, %2\n\ts_nop 0\n\tglobal_load_lds_dwordx4 %1, off\n\ts_mov_b32 m0, %0":"=&s"(keep):"v"(gsrc),"s"(lds_dst):"memory");}
__device__ __forceinline__ float max3f(float a,float b,float c){float r;asm("v_max3_f32 %0, %1, %2, %3":"=v"(r):"v"(a),"v"(b),"v"(c));return r;}
__device__ __forceinline__ float max2f(float a,float b){float r;asm("v_max_f32_e32 %0, %1, %2":"=v"(r):"v"(a),"v"(b));return r;}
__device__ __forceinline__ float fadd_s(float a,float b){float r;asm("v_add_f32_e32 %0, %1, %2":"=v"(r):"v"(a),"v"(b));return r;}
__device__ __forceinline__ float fsub_s(float a,float b){float r;asm("v_sub_f32_e32 %0, %1, %2":"=v"(r):"v"(a),"v"(b));return r;}
typedef float f32x2_t __attribute__((ext_vector_type(2))); typedef __bf16 bf16x2_t __attribute__((ext_vector_type(2)));
__device__ __forceinline__ unsigned cvtpk_s(float lo,float hi){f32x2_t v={lo,hi};bf16x2_t b=__builtin_convertvector(v,bf16x2_t);return __builtin_bit_cast(unsigned,b);}
#define WAIT_BAR(N) asm volatile("s_waitcnt vmcnt(" #N ") lgkmcnt(0)\n\ts_barrier":::"memory")

__device__ __forceinline__ void qkt(f32x16&p0,f32x16&p1,const char*Kslot,const bf16x8*qr,const f32x16&negm,int r32,int hi){
  const char*kb=Kslot+hi*1024+r32*16;
  #pragma unroll
  for(int d0=0;d0<4;++d0){
    const bf16x8 b0=*reinterpret_cast<const bf16x8*>(kb+d0*2048);
    const bf16x8 b1=*reinterpret_cast<const bf16x8*>(kb+d0*2048+512);
    if(d0==0){p0=__builtin_amdgcn_mfma_f32_32x32x16_bf16(b0,qr[0],negm,0,0,0);p1=__builtin_amdgcn_mfma_f32_32x32x16_bf16(b1,qr[0],negm,0,0,0);}
    else{p0=__builtin_amdgcn_mfma_f32_32x32x16_bf16(b0,qr[d0],p0,0,0,0);p1=__builtin_amdgcn_mfma_f32_32x32x16_bf16(b1,qr[d0],p1,0,0,0);}}
}
typedef __attribute__((address_space(3))) const char* lds_cptr;
typedef short v4i16_t __attribute__((ext_vector_type(4)));
__device__ __forceinline__ void kload8(bf16x8*kf,lds_cptr kp){
  kf[0]=*(const __attribute__((address_space(3))) bf16x8*)(kp);      kf[1]=*(const __attribute__((address_space(3))) bf16x8*)(kp+512);
  kf[2]=*(const __attribute__((address_space(3))) bf16x8*)(kp+2048); kf[3]=*(const __attribute__((address_space(3))) bf16x8*)(kp+2560);
  kf[4]=*(const __attribute__((address_space(3))) bf16x8*)(kp+4096); kf[5]=*(const __attribute__((address_space(3))) bf16x8*)(kp+4608);
  kf[6]=*(const __attribute__((address_space(3))) bf16x8*)(kp+6144); kf[7]=*(const __attribute__((address_space(3))) bf16x8*)(kp+6656);
}
__device__ __forceinline__ void kload2(bf16x8*kf,lds_cptr kp,int j){ kf[2*j]=*(const __attribute__((address_space(3))) bf16x8*)(kp+j*2048); kf[2*j+1]=*(const __attribute__((address_space(3))) bf16x8*)(kp+j*2048+512); }
__device__ __forceinline__ s16x4 vtr(lds_cptr p){ return __builtin_bit_cast(s16x4,__builtin_amdgcn_ds_read_tr16_b64_v4i16((__attribute__((address_space(3))) v4i16_t*)p)); }
__device__ __forceinline__ float rowmax(const f32x16&p0,const f32x16&p1){
  float a=max3f(p0[0],p0[1],p1[0]),b=max3f(p0[2],p0[3],p1[1]);a=max3f(a,p1[2],p1[3]);
  #pragma unroll
  for(int r=4;r<16;r+=4){a=max3f(a,p0[r],p0[r+1]);b=max3f(b,p0[r+2],p0[r+3]);a=max3f(a,p1[r],p1[r+1]);b=max3f(b,p1[r+2],p1[r+3]);}
  const float m=max2f(a,b);
  auto rr=__builtin_amdgcn_permlane32_swap(__float_as_uint(m),__float_as_uint(m),false,false);
  return max2f(__uint_as_float(rr[0]),__uint_as_float(rr[1]));
}
__device__ __forceinline__ void pv(f32x16*o,int vb,bf16x8 pa0,bf16x8 pa1,bf16x8 pa2,bf16x8 pa3){
  #pragma unroll
  for(int d0=0;d0<2;++d0){s16x4 lo[4],hi[4];
    #pragma unroll
    for(int ks=0;ks<4;++ks){
      asm volatile("ds_read_b64_tr_b16 %0,%1 offset:%c2":"=&v"(lo[ks]):"v"(vb),"i"(d0*4096+ks*1024):"memory");
      asm volatile("ds_read_b64_tr_b16 %0,%1 offset:%c2":"=&v"(hi[ks]):"v"(vb),"i"(d0*4096+ks*1024+512):"memory");}
    asm volatile("s_waitcnt lgkmcnt(0)":::"memory");SBAR();
    #define PK(k) (bf16x8){lo[k][0],lo[k][1],lo[k][2],lo[k][3],hi[k][0],hi[k][1],hi[k][2],hi[k][3]}
    o[d0]=__builtin_amdgcn_mfma_f32_32x32x16_bf16(pa0,PK(0),o[d0],0,0,0);
    o[d0]=__builtin_amdgcn_mfma_f32_32x32x16_bf16(pa1,PK(1),o[d0],0,0,0);
    o[d0]=__builtin_amdgcn_mfma_f32_32x32x16_bf16(pa2,PK(2),o[d0],0,0,0);
    o[d0]=__builtin_amdgcn_mfma_f32_32x32x16_bf16(pa3,PK(3),o[d0],0,0,0);
    #undef PK
  }
}

#ifndef ATTN_STORE16
#define ATTN_STORE16(p,v) (*(u32x4*)(p)=(v))
#endif
template<int THRL> __device__ __forceinline__ void attn_unit(int b,int qcol,int kcol,int vcol,int ocol,int qb,const bf16*__restrict__ P,bf16*O,char*shm){
  const int tid=threadIdx.x,lane=tid&63,r32=lane&31,hi=lane>>5; const int wid=__builtin_amdgcn_readfirstlane(tid>>6);
  const long rowbase=(long)b*SEQ; const int q0=qb*QB;
  const bf16*Qw=P+(rowbase+q0+wid*QBLK)*PQ+qcol;
  const bf16*Kh=P+rowbase*PQ+kcol,*Vh=P+rowbase*PQ+vcol;
  const unsigned lds0=(unsigned)(uintptr_t)shm;
  float*wsf=(float*)(shm+LDS_WS)+wid*64;
  const bf16*ksrc=Kh+(long)lane*PQ+wid*8;
  const bf16*vsrc=Vh+(long)(16*(wid&3)+(lane>>2))*PQ+(wid>>2)*32+(lane&3)*8;
  const unsigned kdst=lds0+LDS_K+wid*1024, vdst=lds0+LDS_V+wid*1024;
  #define DMA_K(t,slot) glds16(ksrc+(long)(t)*KVBLK*PQ,(unsigned)__builtin_amdgcn_readfirstlane(kdst+(slot)))
  #define DMA_V(t,slot) glds16(vsrc+(long)(t)*KVBLK*PQ,(unsigned)__builtin_amdgcn_readfirstlane(vdst+(slot)))
  const int vb0=(int)(lds0+LDS_V)+((lane>>4)&1)*32+(lane&3)*8+(4*hi+((lane&15)>>2))*64;
  const char*Kbase=shm+LDS_K; bf16x8 kf[8];
  const lds_cptr shm3=(lds_cptr)shm; const lds_cptr kp0=shm3+LDS_K+hi*1024+r32*16; const lds_cptr vp0=shm3+LDS_V+((lane>>4)&1)*32+(lane&3)*8+(4*hi+((lane&15)>>2))*64;
  const int NT=(q0+QB)/KVBLK;
  DMA_K(0,0);DMA_V(0,0);DMA_K(1,SLOTB);
  bf16x8 qr[4];
  #pragma unroll
  for(int d0=0;d0<4;++d0)qr[d0]=*reinterpret_cast<const bf16x8*>(&Qw[(long)r32*PQ+d0*16+hi*8]);
  float mhat=0.f,l_reg=0.f;f32x16 o[2];o[0]=f32x16{};o[1]=f32x16{};f32x16 negm=f32x16{};asm volatile("":"+v"(negm));
  const int qrel=wid*QBLK+r32;
  #define CMASK(P0,P1,t) do{int jb_=(t)-(NT-4); if(jb_>=0)cmask(P0,P1,jb_,qrel,hi);}while(0)
  bool resc=false;
  #define START(P0,P1) do{ const float rm=rowmax(P0,P1); resc=false; \
    { const float dl=rm; mhat=fadd_s(mhat,dl); \
      _Pragma("unroll") for(int r=0;r<16;++r){P0[r]=fsub_s(P0[r],dl);P1[r]=fsub_s(P1[r],dl);} \
      _Pragma("unroll") for(int r=0;r<16;++r)negm[r]=-mhat; asm volatile("":"+v"(negm)); } \
    _Pragma("unroll") for(int r=0;r<16;++r)P0[r]=__builtin_amdgcn_exp2f(P0[r]); }while(0)
  #define RESC() do{ if(resc){ asm volatile("s_waitcnt lgkmcnt(0)":::"memory"); \
      _Pragma("unroll") for(int d_=0;d_<2;++d_) _Pragma("unroll") for(int r=0;r<16;++r)o[d_][r]*=wsf[crow(r,hi)]; } }while(0)
  f32x16 pA0,pA1,pB0,pB1;
  int sl_prev=0,sl_cur=0,sl_next=SLOTB;
  #define ROT() do{sl_prev=sl_cur;sl_cur=sl_next;sl_next=(sl_next==(NSLOT-1)*SLOTB)?0:sl_next+SLOTB;}while(0)
  DMA_K(2,2*SLOTB);
  WAIT_BAR(3);
  qkt(pA0,pA1,Kbase,qr,negm,r32,hi);asm volatile("s_nop 15\n\ts_nop 7":"+v"(pA0),"+v"(pA1));CMASK(pA0,pA1,0);
  START(pA0,pA1);
  _Pragma("unroll") for(int r=0;r<16;++r)pA1[r]=__builtin_amdgcn_exp2f(pA1[r]);
  WAIT_BAR(0);
  DMA_K(3,0);DMA_V(1,SLOTB);
  ROT();
  kload8(kf,kp0+sl_cur);
  WAIT_BAR(2);
  s16x4 vlo[8],vhi[8]; u32x4 pw0,pw1,pw2,pw3;
  #define PKW(P,B) cvtpk_s(P[B],P[B+1])
  #define PAF(k) __builtin_bit_cast(bf16x8,pw##k)
  #define VFR(i) (bf16x8){vlo[i][0],vlo[i][1],vlo[i][2],vlo[i][3],vhi[i][0],vhi[i][1],vhi[i][2],vhi[i][3]}
  #define PIN(x) asm volatile("":"+v"(x))
  #define MX3(a,b,c) __builtin_fmaxf(__builtin_fmaxf((a),(b)),(c))
  #define GAPA(MF,A0,A1,A2,A3,W0,W1,PW) do{ MF; sacc+=A0; sacc+=A1; sacc+=A2; sacc+=A3; PIN(sacc); W0; W1; PIN(PW); SBAR(); }while(0)
  #define EX(v) __builtin_amdgcn_exp2f(v)
  #define GAPB(MF,X,B) do{ MF; X[B]=EX(X[B]); X[B+1]=EX(X[B+1]); X[B+2]=EX(X[B+2]); X[B+3]=EX(X[B+3]); PIN(X); SBAR(); }while(0)
  #define VRD(i) do{ vlo[i]=vtr(vp_+(((i)>>2)*4096+((i)&3)*1024)); vhi[i]=vtr(vp_+(((i)>>2)*4096+((i)&3)*1024+512)); }while(0)
  #define KRD(G,j) do{ if(G){ kload2(kf,kp0+sl_next,j); SBAR(); } }while(0)
  #define STEP(C0,C1,P0,P1,t,GK,GV,GL) do{ SBAR(); \
    const lds_cptr vp_=vp0+sl_prev; \
    VRD(0); SBAR(); float sacc=(P0[0]+P0[1]); \
    GAPA(C0=__builtin_amdgcn_mfma_f32_32x32x16_bf16(kf[0],qr[0],negm,0,0,0), P0[2],P0[3],P0[4],P0[5],     pw0[0]=PKW(P0,0), pw0[1]=PKW(P0,2), pw0); \
    VRD(4); SBAR(); GAPA(C1=__builtin_amdgcn_mfma_f32_32x32x16_bf16(kf[1],qr[0],negm,0,0,0), P0[6],P0[7],P0[8],P0[9],     pw0[2]=PKW(P0,4), pw0[3]=PKW(P0,6), pw0); \
    VRD(1); SBAR(); GAPA(C0=__builtin_amdgcn_mfma_f32_32x32x16_bf16(kf[2],qr[1],C0,0,0,0),   P0[10],P0[11],P0[12],P0[13], pw1[0]=PKW(P0,8), pw1[1]=PKW(P0,10), pw1); \
    VRD(5); SBAR(); GAPA(C1=__builtin_amdgcn_mfma_f32_32x32x16_bf16(kf[3],qr[1],C1,0,0,0),   P0[14],P0[15],P1[0],P1[1],   pw1[2]=PKW(P0,12),pw1[3]=PKW(P0,14), pw1); \
    VRD(2); SBAR(); GAPA(C0=__builtin_amdgcn_mfma_f32_32x32x16_bf16(kf[4],qr[2],C0,0,0,0),   P1[2],P1[3],P1[4],P1[5],     pw2[0]=PKW(P1,0), pw2[1]=PKW(P1,2), pw2); \
    VRD(6); SBAR(); GAPA(C1=__builtin_amdgcn_mfma_f32_32x32x16_bf16(kf[5],qr[2],C1,0,0,0),   P1[6],P1[7],P1[8],P1[9],     pw2[2]=PKW(P1,4), pw2[3]=PKW(P1,6), pw2); \
    VRD(3); SBAR(); GAPA(C0=__builtin_amdgcn_mfma_f32_32x32x16_bf16(kf[6],qr[3],C0,0,0,0),   P1[10],P1[11],P1[12],P1[13], pw3[0]=PKW(P1,8), pw3[1]=PKW(P1,10), pw3); \
    VRD(7); SBAR(); GAPA(C1=__builtin_amdgcn_mfma_f32_32x32x16_bf16(kf[7],qr[3],C1,0,0,0),   P1[14],P1[15],0.f,0.f,       pw3[2]=PKW(P1,12),pw3[3]=PKW(P1,14), pw3); \
    l_reg+=sacc; \
    if(GK){DMA_K((t)+3,sl_cur);} if(GV){DMA_V((t)+1,sl_next);} \
    CMASK(C0,C1,t); \
    { float a=MX3(C0[0],C0[1],C1[0]),b=MX3(C0[2],C0[3],C1[1]); a=MX3(a,C1[2],C1[3]); \
      _Pragma("unroll") for(int r=4;r<16;r+=4){a=MX3(a,C0[r],C0[r+1]);b=MX3(b,C0[r+2],C0[r+3]);a=MX3(a,C1[r],C1[r+1]);b=MX3(b,C1[r+2],C1[r+3]);} \
      float rm=__builtin_fmaxf(a,b); { auto rr=__builtin_amdgcn_permlane32_swap(__float_as_uint(rm),__float_as_uint(rm),false,false); rm=__builtin_fmaxf(__uint_as_float(rr[0]),__uint_as_float(rr[1])); } \
      resc=false; \
      if(__builtin_expect(__any(rm>(float)THRL),0)){ const float dl=__builtin_fmaxf(rm,0.f); mhat+=dl; \
        _Pragma("unroll") for(int r=0;r<16;++r){C0[r]-=dl;C1[r]-=dl;} \
        _Pragma("unroll") for(int r=0;r<16;++r)negm[r]=-mhat; asm volatile("":"+v"(negm)); \
        const float f=__builtin_amdgcn_exp2f(-dl); l_reg*=f; if(hi==0)wsf[r32]=f; resc=true; } } \
    SBAR(); \
    GAPB(o[0]=__builtin_amdgcn_mfma_f32_32x32x16_bf16(PAF(0),VFR(0),o[0],0,0,0), C0,0); \
    GAPB(o[1]=__builtin_amdgcn_mfma_f32_32x32x16_bf16(PAF(0),VFR(4),o[1],0,0,0), C0,4); \
    KRD(GL,0); GAPB(o[0]=__builtin_amdgcn_mfma_f32_32x32x16_bf16(PAF(1),VFR(1),o[0],0,0,0), C0,8); \
    KRD(GL,1); GAPB(o[1]=__builtin_amdgcn_mfma_f32_32x32x16_bf16(PAF(1),VFR(5),o[1],0,0,0), C0,12); \
    KRD(GL,2); GAPB(o[0]=__builtin_amdgcn_mfma_f32_32x32x16_bf16(PAF(2),VFR(2),o[0],0,0,0), C1,0); \
    KRD(GL,3); GAPB(o[1]=__builtin_amdgcn_mfma_f32_32x32x16_bf16(PAF(2),VFR(6),o[1],0,0,0), C1,4); \
    GAPB(o[0]=__builtin_amdgcn_mfma_f32_32x32x16_bf16(PAF(3),VFR(3),o[0],0,0,0), C1,8); \
    GAPB(o[1]=__builtin_amdgcn_mfma_f32_32x32x16_bf16(PAF(3),VFR(7),o[1],0,0,0), C1,12); \
    }while(0)
  int t=1;
  #undef CMASK
  #define CMASK(P0,P1,t) do{}while(0)
  for(;t+5<NT;t+=2){
    STEP(pB0,pB1,pA0,pA1,t,true,true,true);     WAIT_BAR(2); RESC(); ROT();
    STEP(pA0,pA1,pB0,pB1,t+1,true,true,true);   WAIT_BAR(2); RESC(); ROT();
  }
  #undef CMASK
  #define CMASK(P0,P1,t) do{int jb_=(t)-(NT-4); if(jb_>=0)cmask(P0,P1,jb_,qrel,hi);}while(0)
  #define ENDW(tt) do{ if((tt)+3<NT){WAIT_BAR(2);} else if((tt)+2<NT){WAIT_BAR(1);} else {WAIT_BAR(0);} }while(0)
  for(;t+1<NT;t+=2){
    STEP(pB0,pB1,pA0,pA1,t,(t+3<NT),(t+1<NT),(t+1<NT));       ENDW(t);   RESC(); ROT();
    STEP(pA0,pA1,pB0,pB1,t+1,(t+4<NT),(t+2<NT),(t+2<NT));     ENDW(t+1); RESC(); ROT();
  }
  STEP(pB0,pB1,pA0,pA1,NT-1,false,false,false); RESC();
  { float sacc=pB0[0]+pB0[1]; _Pragma("unroll") for(int r=2;r<16;++r)sacc+=pB0[r]; _Pragma("unroll") for(int r=0;r<16;++r)sacc+=pB1[r]; l_reg+=sacc;
    pw0=(u32x4){PKW(pB0,0),PKW(pB0,2),PKW(pB0,4),PKW(pB0,6)};pw1=(u32x4){PKW(pB0,8),PKW(pB0,10),PKW(pB0,12),PKW(pB0,14)};pw2=(u32x4){PKW(pB1,0),PKW(pB1,2),PKW(pB1,4),PKW(pB1,6)};pw3=(u32x4){PKW(pB1,8),PKW(pB1,10),PKW(pB1,12),PKW(pB1,14)};
    SBAR(); pv(o,vb0+sl_cur,PAF(0),PAF(1),PAF(2),PAF(3)); }
  #undef PKW
  #undef PAF
  #undef VFR
  #undef PIN
  #undef MX3
  #undef GAPA
  #undef GAPB
  #undef EX
  #undef VRD
  #undef KRD
  #undef STEP
  #undef ENDW
  {auto rr=__builtin_amdgcn_permlane32_swap(__float_as_uint(l_reg),__float_as_uint(l_reg),false,false);l_reg=__uint_as_float(rr[0])+__uint_as_float(rr[1]);}
  if(hi==0)wsf[32+r32]=l_reg;asm volatile("s_waitcnt lgkmcnt(0)":::"memory");
  float rli[16];
  #pragma unroll
  for(int r=0;r<16;++r)rli[r]=__builtin_amdgcn_rcpf(wsf[32+crow(r,hi)]);
  bf16*Ow=O+(rowbase+q0+wid*QBLK)*PO+ocol;
  { bf16*stg=(bf16*)(shm+LDS_OST)+wid*2048;
    #pragma unroll
    for(int r=0;r<16;++r){const int orow=crow(r,hi);
      #pragma unroll
      for(int d0=0;d0<2;++d0)stg[orow*64+d0*32+r32]=__float2bfloat16(o[d0][r]*rli[r]);}
    asm volatile("s_waitcnt lgkmcnt(0)":::"memory");
    #pragma unroll
    for(int i=0;i<4;++i){const int row=i*8+(lane>>3),ch=lane&7; const u32x4 v=*(const u32x4*)(stg+row*64+ch*8); ATTN_STORE16(Ow+(long)row*PO+ch*8,v);} }
  asm volatile("s_waitcnt lgkmcnt(0)\n\ts_barrier":::"memory");
  #undef DMA_K
  #undef DMA_V
  #undef CMASK
  #undef START
  #undef RESC
  #undef ROT
}
constexpr int ATTN_LDS_BYTES=LDS_BYTES;
struct AttnTensors { const bf16* P; bf16* O; };
struct AttnUnit { int bh; int qb; };
struct StaticOrder {
  int vcu;
  __device__ __forceinline__ explicit StaticOrder(int grid,int block):vcu((block%8)*(grid/8)+block/8){}
  __device__ __forceinline__ bool next(int i,AttnUnit&u)const{ if(i>=8)return false; const int s=4*(vcu&1)+(i>>1); u.bh=vcu>>1; u.qb=(i&1)?15-s:s; return true; }
  __device__ __forceinline__ void a_ready(const AttnUnit&)const{}
  __device__ __forceinline__ void done(const AttnUnit&)const{}
};
template<class Sched,int THRL=8> __device__ __forceinline__ void attn_phase(char*lds,const AttnTensors&T,const Sched&S){
  AttnUnit u;
  for(int i=0;S.next(i,u);++i){ S.a_ready(u);
    const int vh=u.bh&1, mp=(u.bh>>1)&1, h=(u.bh>>2)&3, b=u.bh>>4, hm=h*2+mp;
    attn_unit<THRL>(b, 1536+hm*64, 2048+hm*64, 2560+h*128+vh*64, hm*128+vh*64, u.qb, T.P, T.O, lds); S.done(u); }
}
#undef SBAR
#undef WAIT_BAR
}

namespace xattn {
using attn_body::bf16x8; using attn_body::s16x4; using attn_body::f32x16; using attn_body::u32x4; using attn_body::lds_cptr;
constexpr int SLOT = 32768;
#define XWAIT_BAR() asm volatile("s_waitcnt vmcnt(0) lgkmcnt(0)\n\ts_barrier":::"memory")
__device__ __forceinline__ int crow(int r,int hi){return (r&3)+8*(r>>2)+4*hi;}
__device__ __forceinline__ void xattn_unit(int tile, int head, const bf16_t* __restrict__ QC, const bf16_t* __restrict__ KVM, bf16_t* __restrict__ OC, char* shm, float* wsf) {
    const int tid = threadIdx.x, lane = tid & 63, r32 = lane & 31, hi = lane >> 5; const int wid = __builtin_amdgcn_readfirstlane(tid >> 6);
    const int row0 = tile * 256 + wid * 32, b = tile >> 4;
    const bf16_t* Kb = KVM + (size_t)(b * 256) * 2048 + head * 256; const bf16_t* Vb = Kb + 1024;
    const unsigned lds0 = (unsigned)(uintptr_t)shm;
    const lds_cptr shm3 = (lds_cptr)shm;
#pragma unroll
    for (int t = 0; t < 4; ++t)
#pragma unroll
        for (int i = 0; i < 4; ++i) { const int p = wid + 8 * i;
            attn_body::glds16(Kb + (size_t)(64 * t + lane) * 2048 + p * 8, (unsigned)__builtin_amdgcn_readfirstlane(lds0 + t * SLOT + p * 1024)); }
    f32x16 s[4][2];
    const bf16_t* qp = QC + (size_t)(row0 + r32) * 1024 + head * 256 + hi * 8;
#pragma unroll
    for (int dh = 0; dh < 2; ++dh) {
        bf16x8 qf[8];
#pragma unroll
        for (int ks = 0; ks < 8; ++ks) qf[ks] = *(const bf16x8*)(qp + dh * 128 + ks * 16);
        if (dh == 0) XWAIT_BAR();
#pragma unroll
        for (int t = 0; t < 4; ++t) {
            const lds_cptr kp = shm3 + t * SLOT + dh * 16384 + hi * 1024 + r32 * 16;
#pragma unroll
            for (int ks = 0; ks < 8; ++ks) {
                const bf16x8 b0 = *(const __attribute__((address_space(3))) bf16x8*)(kp + ks * 2048);
                const bf16x8 b1 = *(const __attribute__((address_space(3))) bf16x8*)(kp + ks * 2048 + 512);
                if (dh == 0 && ks == 0) { const f32x16 z = f32x16{}; s[t][0] = __builtin_amdgcn_mfma_f32_32x32x16_bf16(b0, qf[ks], z, 0, 0, 0); s[t][1] = __builtin_amdgcn_mfma_f32_32x32x16_bf16(b1, qf[ks], z, 0, 0, 0); }
                else { s[t][0] = __builtin_amdgcn_mfma_f32_32x32x16_bf16(b0, qf[ks], s[t][0], 0, 0, 0); s[t][1] = __builtin_amdgcn_mfma_f32_32x32x16_bf16(b1, qf[ks], s[t][1], 0, 0, 0); }
            }
        }
    }
    XWAIT_BAR();
#pragma unroll
    for (int t = 0; t < 4; ++t)
#pragma unroll
        for (int i = 0; i < 4; ++i) { const int p = wid + 8 * i;
            attn_body::glds16(Vb + (size_t)(64 * t + 16 * (p & 3) + (lane >> 2)) * 2048 + (p >> 2) * 32 + (lane & 3) * 8, (unsigned)__builtin_amdgcn_readfirstlane(lds0 + t * SLOT + p * 1024)); }
    float m = s[0][0][0];
#pragma unroll
    for (int t = 0; t < 4; ++t)
#pragma unroll
        for (int h2 = 0; h2 < 2; ++h2)
#pragma unroll
            for (int r = 0; r < 16; ++r) m = fmaxf(m, s[t][h2][r]);
    m = fmaxf(m, __shfl_xor(m, 32));
    float l = 0.f;
#pragma unroll
    for (int t = 0; t < 4; ++t)
#pragma unroll
        for (int h2 = 0; h2 < 2; ++h2)
#pragma unroll
            for (int r = 0; r < 16; ++r) { const float p = __builtin_amdgcn_exp2f(s[t][h2][r] - m); s[t][h2][r] = p; l += p; }
    l += __shfl_xor(l, 32);
    u32x4 pw[4][4];
#pragma unroll
    for (int t = 0; t < 4; ++t)
#pragma unroll
        for (int ks = 0; ks < 4; ++ks) { const int h2 = ks >> 1, o8 = (ks & 1) * 8;
            pw[t][ks] = (u32x4){attn_body::cvtpk_s(s[t][h2][o8 + 0], s[t][h2][o8 + 1]), attn_body::cvtpk_s(s[t][h2][o8 + 2], s[t][h2][o8 + 3]), attn_body::cvtpk_s(s[t][h2][o8 + 4], s[t][h2][o8 + 5]), attn_body::cvtpk_s(s[t][h2][o8 + 6], s[t][h2][o8 + 7])}; }
    if (hi == 0) wsf[r32] = l;
    XWAIT_BAR();
    f32x16 o[8];
#pragma unroll
    for (int d0 = 0; d0 < 8; ++d0) o[d0] = f32x16{};
    const lds_cptr vp0 = shm3 + ((lane >> 4) & 1) * 32 + (lane & 3) * 8 + (4 * hi + ((lane & 15) >> 2)) * 64;
#pragma unroll
    for (int t = 0; t < 4; ++t)
#pragma unroll
        for (int d0 = 0; d0 < 8; ++d0)
#pragma unroll
            for (int ks = 0; ks < 4; ++ks) {
                const s16x4 vl = attn_body::vtr(vp0 + t * SLOT + d0 * 4096 + ks * 1024), vh = attn_body::vtr(vp0 + t * SLOT + d0 * 4096 + ks * 1024 + 512);
                const bf16x8 vf = (bf16x8){vl[0], vl[1], vl[2], vl[3], vh[0], vh[1], vh[2], vh[3]};
                o[d0] = __builtin_amdgcn_mfma_f32_32x32x16_bf16(__builtin_bit_cast(bf16x8, pw[t][ks]), vf, o[d0], 0, 0, 0);
            }
    XWAIT_BAR();
    float rli[16];
#pragma unroll
    for (int r = 0; r < 16; ++r) rli[r] = __builtin_amdgcn_rcpf(wsf[crow(r, hi)]);
    bf16_t* op = OC + (size_t)row0 * 1024 + head * 256 + r32;
#pragma unroll
    for (int d0 = 0; d0 < 8; ++d0)
#pragma unroll
        for (int r = 0; r < 16; ++r) op[(size_t)crow(r, hi) * 1024 + d0 * 32] = f2bf(o[d0][r] * rli[r]);
    asm volatile("s_waitcnt lgkmcnt(0)" ::: "memory");
}
#undef XWAIT_BAR
}


namespace gla {
using attn_body::bf16x8; using attn_body::s16x4; using attn_body::f32x16; using attn_body::u32x4; using attn_body::lds_cptr;
typedef __attribute__((address_space(3))) char* lds_ptr;
typedef unsigned u32x2 __attribute__((ext_vector_type(2)));
constexpr int PITCH = 144;
constexpr int O_QD = 0, O_KI = 9216, O_KDT = 18432, O_V = 27648, O_DEC = 44032, BUF = 44544, O_SSX = 2 * BUF, O_W2 = O_SSX + 1024, LDS_USED = O_W2 + 4096 + 256;
#define GWAIT_BAR() asm volatile("s_waitcnt vmcnt(0) lgkmcnt(0)\n\ts_barrier":::"memory")
__device__ __forceinline__ int crow(int r,int hi){return (r&3)+8*(r>>2)+4*hi;}
__device__ __forceinline__ bf16x8 pack8f(const f32x16& v, int o) {
    u32x4 w = (u32x4){attn_body::cvtpk_s(v[o + 0], v[o + 1]), attn_body::cvtpk_s(v[o + 2], v[o + 3]), attn_body::cvtpk_s(v[o + 4], v[o + 5]), attn_body::cvtpk_s(v[o + 6], v[o + 7])};
    return __builtin_bit_cast(bf16x8, w);
}
template <bool PC>
__device__ __forceinline__ void gla_run(int rid, const bf16_t* __restrict__ PROJ, const float* __restrict__ GA, const float* __restrict__ w2, const float* __restrict__ b2,
                                        const float* __restrict__ wn, float* __restrict__ AGG, float* __restrict__ DRUN, bf16_t* __restrict__ MIXED, char* shm) {
    const int tid = threadIdx.x, lane = tid & 63, r32 = lane & 31, hi = lane >> 5; const int wid = __builtin_amdgcn_readfirstlane(tid >> 6);
    const int th = wid >> 2, db = wid & 3;
    const int j = rid & 7, h = (rid >> 3) & 3, b = rid >> 5;
    const size_t tb = (size_t)b * SEQ + (size_t)j * 512;
    const unsigned lds0 = (unsigned)(uintptr_t)shm; const lds_ptr shm3 = (lds_ptr)shm;
    {
        __attribute__((address_space(3))) float* wl = (__attribute__((address_space(3))) float*)(shm3 + O_W2);
        for (int i = tid; i < 1024; i += 512) wl[i] = w2[(i >> 6) * 256 + h * 64 + (i & 63)];
        if (tid < 64) wl[1024 + tid] = b2[h * 64 + tid];
        GWAIT_BAR();
    }
    const __attribute__((address_space(3))) f32x4* w2l = (const __attribute__((address_space(3))) f32x4*)(shm3 + O_W2) + 2 * wid;
    const int pl = (lane & ~12) | ((lane & 4) << 1) | ((lane & 8) >> 1);
    const int cpos0 = 16 * (wid >> 1) + 4 * (wid & 1);
    f32x16 S0 = f32x16{}, S1 = f32x16{};
    float gsum[8];
#pragma unroll
    for (int c = 0; c < 8; ++c) gsum[c] = 0.f;
    if (PC) {
        for (int i = 0; i < j; ++i) {
            const float* ag = AGG + (size_t)(rid - j + i) * 8192 + 32 * db + r32; const float* dr = DRUN + (rid - j + i) * 64;
#pragma unroll
            for (int r = 0; r < 16; ++r) { const int ch = crow(r, hi); S0[r] = S0[r] * dr[ch] + ag[ch * 128]; S1[r] = S1[r] * dr[32 + ch] + ag[(32 + ch) * 128]; }
        }
    }
    f32x4 ga0, ga1, ga2, ga3; bf16x8 rq, rk;
#define GLA_LOAD_RAW(n_) do { const size_t t_ = tb + (size_t)(n_) * 64 + lane; const f32x4* gp_ = (const f32x4*)(GA + t_ * 16); ga0 = gp_[0]; ga1 = gp_[1]; ga2 = gp_[2]; ga3 = gp_[3]; \
        if (PC) rq = *(const bf16x8*)(PROJ + t_ * PP + C_GQ + h * 64 + 8 * wid); rk = *(const bf16x8*)(PROJ + t_ * PP + C_GK + h * 64 + 8 * wid); } while (0)
#define GLA_DMA_V(n_, buf_) do { _Pragma("unroll") for (int i_ = 0; i_ < 2; ++i_) { const int p_ = 2 * wid + i_; \
        attn_body::glds16(PROJ + (tb + (size_t)(n_) * 64 + 16 * (p_ & 3) + (lane >> 2)) * PP + C_GV + h * 128 + (p_ >> 2) * 32 + (lane & 3) * 8, (unsigned)__builtin_amdgcn_readfirstlane(lds0 + (buf_) * BUF + O_V + p_ * 1024)); } } while (0)
    GLA_LOAD_RAW(0); GLA_DMA_V(0, 0);
    for (int n = 0; n < 8; ++n) {
        const int buf = n & 1; const lds_ptr B3 = shm3 + buf * BUF;
        float Gc[8];
        {   float z[8];
            { const f32x4 ba = w2l[256], bb = w2l[257];
#pragma unroll
              for (int c = 0; c < 4; ++c) { z[c] = ba[c]; z[4 + c] = bb[c]; } }
#pragma unroll
            for (int r = 0; r < 16; ++r) { const float g_ = (r < 4) ? ga0[r & 3] : (r < 8) ? ga1[r & 3] : (r < 12) ? ga2[r & 3] : ga3[r & 3];
                const f32x4 wa = w2l[16 * r], wb = w2l[16 * r + 1];
#pragma unroll
                for (int c = 0; c < 4; ++c) { z[c] += g_ * wa[c]; z[4 + c] += g_ * wb[c]; } }
#pragma unroll
            for (int c = 0; c < 8; ++c) Gc[c] = (fminf(z[c], 0.f) - __logf(1.f + __expf(-fabsf(z[c])))) * 0.0625f; }
#pragma unroll
        for (int off = 1; off < 64; off <<= 1)
#pragma unroll
            for (int c = 0; c < 8; ++c) { const float v = __shfl_up(Gc[c], off); if (lane >= off) Gc[c] += v; }
        float Gl[8];
#pragma unroll
        for (int c = 0; c < 8; ++c) { Gl[c] = __shfl(Gc[c], 63); gsum[c] += Gl[c]; }
        {   float kd[8], ki[8], qd[8];
#pragma unroll
            for (int c = 0; c < 8; ++c) { const float kf_ = bf2f((bf16_t)rk[c]); kd[c] = kf_ * __expf(Gl[c] - Gc[c]);
                if (PC) { ki[c] = kf_ * __expf(-Gc[c]); qd[c] = bf2f((bf16_t)rq[c]) * __expf(Gc[c]) * 0.125f; } }
            if (PC) {
                const lds_ptr rowq = B3 + O_QD + lane * PITCH + cpos0 * 2, rowk = B3 + O_KI + lane * PITCH + cpos0 * 2;
                *(__attribute__((address_space(3))) u32x2*)(rowq) = (u32x2){attn_body::cvtpk_s(qd[0], qd[1]), attn_body::cvtpk_s(qd[2], qd[3])};
                *(__attribute__((address_space(3))) u32x2*)(rowq + 16) = (u32x2){attn_body::cvtpk_s(qd[4], qd[5]), attn_body::cvtpk_s(qd[6], qd[7])};
                *(__attribute__((address_space(3))) u32x2*)(rowk) = (u32x2){attn_body::cvtpk_s(ki[0], ki[1]), attn_body::cvtpk_s(ki[2], ki[3])};
                *(__attribute__((address_space(3))) u32x2*)(rowk + 16) = (u32x2){attn_body::cvtpk_s(ki[4], ki[5]), attn_body::cvtpk_s(ki[6], ki[7])};
            }
#pragma unroll
            for (int c = 0; c < 8; ++c) *(__attribute__((address_space(3))) bf16_t*)(B3 + O_KDT + (8 * wid + c) * PITCH + pl * 2) = f2bf(kd[c]);
            if (lane == 63) {
#pragma unroll
                for (int c = 0; c < 8; ++c) ((__attribute__((address_space(3))) float*)(B3 + O_DEC))[8 * wid + c] = __expf(Gl[c]);
            }
        }
        GWAIT_BAR();
        if (n + 1 < 8) { GLA_LOAD_RAW(n + 1); GLA_DMA_V(n + 1, buf ^ 1); }
        const lds_cptr vp = (lds_cptr)B3 + O_V + db * 4096 + ((lane >> 4) & 1) * 32 + (lane & 3) * 8 + (4 * hi + ((lane & 15) >> 2)) * 64;
        bf16x8 vf[4];
#pragma unroll
        for (int ks = 0; ks < 4; ++ks) { const s16x4 vl = attn_body::vtr(vp + ks * 1024), vh = attn_body::vtr(vp + ks * 1024 + 512); vf[ks] = (bf16x8){vl[0], vl[1], vl[2], vl[3], vh[0], vh[1], vh[2], vh[3]}; }
        const __attribute__((address_space(3))) float* decp = (const __attribute__((address_space(3))) float*)(B3 + O_DEC);
        if (PC) {
            bf16x8 qf[4];
#pragma unroll
            for (int ks = 0; ks < 4; ++ks) qf[ks] = *(const __attribute__((address_space(3))) bf16x8*)(B3 + O_QD + (32 * th + r32) * PITCH + (16 * ks + 8 * hi) * 2);
            f32x16 o = f32x16{};
            o = __builtin_amdgcn_mfma_f32_32x32x16_bf16(pack8f(S0, 0), qf[0], o, 0, 0, 0);
            o = __builtin_amdgcn_mfma_f32_32x32x16_bf16(pack8f(S0, 8), qf[1], o, 0, 0, 0);
            o = __builtin_amdgcn_mfma_f32_32x32x16_bf16(pack8f(S1, 0), qf[2], o, 0, 0, 0);
            o = __builtin_amdgcn_mfma_f32_32x32x16_bf16(pack8f(S1, 8), qf[3], o, 0, 0, 0);
#pragma unroll
            for (int kh = 0; kh < 2; ++kh) {
                if (kh <= th) {
                    f32x16 X = f32x16{};
#pragma unroll
                    for (int ks = 0; ks < 4; ++ks) { const bf16x8 kif = *(const __attribute__((address_space(3))) bf16x8*)(B3 + O_KI + (32 * kh + r32) * PITCH + (16 * ks + 8 * hi) * 2);
                        X = __builtin_amdgcn_mfma_f32_32x32x16_bf16(kif, qf[ks], X, 0, 0, 0); }
                    if (kh == th) {
#pragma unroll
                        for (int r = 0; r < 16; ++r) X[r] = (crow(r, hi) <= r32) ? X[r] : 0.f;
                    }
                    o = __builtin_amdgcn_mfma_f32_32x32x16_bf16(vf[2 * kh], pack8f(X, 0), o, 0, 0, 0);
                    o = __builtin_amdgcn_mfma_f32_32x32x16_bf16(vf[2 * kh + 1], pack8f(X, 8), o, 0, 0, 0);
                }
            }
#pragma unroll
            for (int r = 0; r < 16; ++r) { S0[r] *= decp[crow(r, hi)]; S1[r] *= decp[32 + crow(r, hi)]; }
#pragma unroll
            for (int ks = 0; ks < 4; ++ks) {
                const bf16x8 k0 = *(const __attribute__((address_space(3))) bf16x8*)(B3 + O_KDT + r32 * PITCH + (16 * ks + 8 * hi) * 2);
                const bf16x8 k1 = *(const __attribute__((address_space(3))) bf16x8*)(B3 + O_KDT + (32 + r32) * PITCH + (16 * ks + 8 * hi) * 2);
                S0 = __builtin_amdgcn_mfma_f32_32x32x16_bf16(k0, vf[ks], S0, 0, 0, 0);
                S1 = __builtin_amdgcn_mfma_f32_32x32x16_bf16(k1, vf[ks], S1, 0, 0, 0);
            }
            float ss = 0.f;
#pragma unroll
            for (int r = 0; r < 16; ++r) ss += o[r] * o[r];
            ss += __shfl_xor(ss, 32);
            __attribute__((address_space(3))) float* ssx = (__attribute__((address_space(3))) float*)(shm3 + O_SSX);
            if (hi == 0) ssx[(th * 4 + db) * 32 + r32] = ss;
            asm volatile("s_waitcnt lgkmcnt(0)\n\ts_barrier" ::: "memory");
            const float tot = (ssx[(th * 4 + 0) * 32 + r32] + ssx[(th * 4 + 1) * 32 + r32]) + (ssx[(th * 4 + 2) * 32 + r32] + ssx[(th * 4 + 3) * 32 + r32]);
            const float rn = rsqrtf(tot * (1.f / 128.f) + EPS);
            const size_t t = tb + (size_t)n * 64 + 32 * th + r32;
#pragma unroll
            for (int r4 = 0; r4 < 4; ++r4) {
                const int dv0 = 32 * db + 8 * r4 + 4 * hi;
                const u32x2 gg = *(const u32x2*)(PROJ + t * PP + C_GG + h * 128 + dv0); const f32x4 wv = *(const f32x4*)(wn + dv0);
                const float g0 = __uint_as_float(gg.x << 16), g1 = __uint_as_float(gg.x & 0xffff0000u), g2 = __uint_as_float(gg.y << 16), g3 = __uint_as_float(gg.y & 0xffff0000u);
                u32x2 ov; ov.x = attn_body::cvtpk_s(o[4 * r4 + 0] * rn * wv[0] * silu(g0), o[4 * r4 + 1] * rn * wv[1] * silu(g1));
                ov.y = attn_body::cvtpk_s(o[4 * r4 + 2] * rn * wv[2] * silu(g2), o[4 * r4 + 3] * rn * wv[3] * silu(g3));
                *(u32x2*)(MIXED + t * D + h * 128 + dv0) = ov;
            }
        } else {
#pragma unroll
            for (int r = 0; r < 16; ++r) S0[r] *= decp[32 * th + crow(r, hi)];
#pragma unroll
            for (int ks = 0; ks < 4; ++ks) {
                const bf16x8 k0 = *(const __attribute__((address_space(3))) bf16x8*)(B3 + O_KDT + (32 * th + r32) * PITCH + (16 * ks + 8 * hi) * 2);
                S0 = __builtin_amdgcn_mfma_f32_32x32x16_bf16(k0, vf[ks], S0, 0, 0, 0);
            }
        }
    }
    if (!PC) {
        float* ag = AGG + (size_t)rid * 8192 + 32 * db + r32;
#pragma unroll
        for (int r = 0; r < 16; ++r) ag[(32 * th + crow(r, hi)) * 128] = S0[r];
        if (lane == 0) {
#pragma unroll
            for (int c = 0; c < 8; ++c) DRUN[rid * 64 + 8 * wid + c] = __expf(gsum[c]);
        }
    }
    GWAIT_BAR();
#undef GLA_LOAD_RAW
#undef GLA_DMA_V
}
#undef GWAIT_BAR
}
#ifndef LAS
#define LAS __attribute__((address_space(3)))
#endif

namespace thin {
typedef unsigned v4u __attribute__((ext_vector_type(4)));
typedef unsigned v2u __attribute__((ext_vector_type(2)));
__device__ __forceinline__ unsigned pk2(float lo, float hi) { return (unsigned)f2bf(lo) | ((unsigned)f2bf(hi) << 16); }
template <int MODE>
__device__ __forceinline__ void transpose_item(const float* __restrict__ W, int K, int Nsrc, int nblk, bf16_t* __restrict__ WT, const float* __restrict__ kscale, LAS float* scr, int item, int lane) {
    const int kb = item / nblk, nb = item % nblk, k0 = 64 * kb, n0 = 32 * nb;
    const int n = n0 + (lane & 31); const int c = MODE == 1 ? win_src_col(n) : n;
#pragma unroll 8
    for (int i = 0; i < 32; ++i) { const int kk = 2 * i + (lane >> 5); float v = 0.f; if (c >= 0) { v = W[(size_t)(k0 + kk) * Nsrc + c]; if (kscale) v *= kscale[k0 + kk]; } scr[kk * 33 + (lane & 31)] = v; }
    asm volatile("s_waitcnt lgkmcnt(0)" ::: "memory");
    const int cch = lane & 7;
#pragma unroll
    for (int j = 0; j < 4; ++j) { const int nn = (lane >> 3) + 8 * j; const LAS float* q = scr + (8 * cch) * 33 + nn;
        v4u o; o.x = pk2(q[0 * 33], q[1 * 33]); o.y = pk2(q[2 * 33], q[3 * 33]); o.z = pk2(q[4 * 33], q[5 * 33]); o.w = pk2(q[6 * 33], q[7 * 33]);
        *(v4u*)(WT + (size_t)(n0 + nn) * K + k0 + 8 * cch) = o; }
    asm volatile("s_waitcnt lgkmcnt(0)" ::: "memory");
}
__device__ __forceinline__ void rms_row_to_bf16(const float* __restrict__ xrow, const float* __restrict__ w, bf16_t* __restrict__ orow, int lane) {
    const f32x4* xr = (const f32x4*)xrow + lane;
    f32x4 v[4]; float ss = 0.f;
#pragma unroll
    for (int j = 0; j < 4; ++j) { v[j] = xr[64 * j]; ss += (v[j].x * v[j].x + v[j].y * v[j].y) + (v[j].z * v[j].z + v[j].w * v[j].w); }
    const float r = rsqrtf(wave_sum(ss) * (1.f / D) + EPS);
    v2u* o8 = (v2u*)orow + lane;
#pragma unroll
    for (int j = 0; j < 4; ++j) { const f32x4 ww = ((const f32x4*)w)[lane + 64 * j]; v2u o; o.x = pk2(v[j].x * r * ww.x, v[j].y * r * ww.y); o.y = pk2(v[j].z * r * ww.z, v[j].w * r * ww.w); o8[64 * j] = o; }
}
__device__ __forceinline__ void rms_row2_to_bf16(const float* __restrict__ xa, const float* __restrict__ xb, const float* __restrict__ w, bf16_t* __restrict__ oa, bf16_t* __restrict__ ob, int lane) {
    const f32x4* pa = (const f32x4*)xa + lane; const f32x4* pb = (const f32x4*)xb + lane;
    f32x4 va[4], vb[4]; float sa = 0.f, sb = 0.f;
#pragma unroll
    for (int j = 0; j < 4; ++j) { va[j] = pa[64 * j]; vb[j] = pb[64 * j]; }
#pragma unroll
    for (int j = 0; j < 4; ++j) { sa += (va[j].x * va[j].x + va[j].y * va[j].y) + (va[j].z * va[j].z + va[j].w * va[j].w); sb += (vb[j].x * vb[j].x + vb[j].y * vb[j].y) + (vb[j].z * vb[j].z + vb[j].w * vb[j].w); }
    const float ra = rsqrtf(wave_sum(sa) * (1.f / D) + EPS), rb = rsqrtf(wave_sum(sb) * (1.f / D) + EPS);
    v2u* qa = (v2u*)oa + lane; v2u* qb = (v2u*)ob + lane;
#pragma unroll
    for (int j = 0; j < 4; ++j) { const f32x4 ww = ((const f32x4*)w)[lane + 64 * j]; v2u o;
        o.x = pk2(va[j].x * ra * ww.x, va[j].y * ra * ww.y); o.y = pk2(va[j].z * ra * ww.z, va[j].w * ra * ww.w); qa[64 * j] = o;
        o.x = pk2(vb[j].x * rb * ww.x, vb[j].y * rb * ww.y); o.y = pk2(vb[j].z * rb * ww.z, vb[j].w * rb * ww.w); qb[64 * j] = o; }
}
}
constexpr int NWAVES = 8;
constexpr int RING_BYTES = 131072;
constexpr int LDSCTL_OFF = RING_BYTES, MISC_OFF = LDSCTL_OFF + 320;
constexpr int LDS_BYTES = 147456;
constexpr int CW_BAR = 4096;
constexpr size_t CTL_ZERO_BYTES = 64 * 1024;
#define GAS __attribute__((address_space(1)))
typedef unsigned short bf16;
typedef unsigned v4u __attribute__((ext_vector_type(4)));
typedef float f32x4 __attribute__((ext_vector_type(4)));
typedef short bf16x8 __attribute__((ext_vector_type(8)));
typedef GAS unsigned gu32;
typedef GAS unsigned long long gu64;
#define RLX_AGENT __ATOMIC_RELAXED, __HIP_MEMORY_SCOPE_AGENT
#define LDS_WAIT() asm volatile("s_waitcnt lgkmcnt(0)" ::: "memory")
#define VM_WAIT() asm volatile("s_waitcnt vmcnt(0)" ::: "memory")
__device__ __forceinline__ unsigned long long rt() { return __builtin_amdgcn_s_memrealtime(); }
__device__ __forceinline__ unsigned pk2(float lo, float hi) { return (unsigned)f2bf(lo) | ((unsigned)f2bf(hi) << 16); }

#define XB_TMO      128
#define XB_XCNT(j)  (256  + 64 * (j))
#define XB_XSUB(j)  (1280 + 64 * (j))
#define XB_XGEN(j)  (2304 + 64 * (j))
#define XB_TOP      3328
#define XB_TOPGEN   3392
#define XCD_BAR_WORDS 3456
#define XB_SPIN_CAP (1u << 18)

__device__ __forceinline__ unsigned xb_ld(unsigned* p)              { return __hip_atomic_load(p, __ATOMIC_RELAXED, __HIP_MEMORY_SCOPE_AGENT); }
__device__ __forceinline__ unsigned xb_add(unsigned* p, unsigned v) { return __hip_atomic_fetch_add(p, v, __ATOMIC_RELAXED, __HIP_MEMORY_SCOPE_AGENT); }
__device__ __forceinline__ unsigned xb_xcc_id() { return (unsigned)__builtin_amdgcn_s_getreg((3 << 11) | 20) & 0xFu; }
#define XB_SPIN(cond, bar) do { unsigned _sp = 0; while (cond) { __builtin_amdgcn_s_sleep(1); \
    if ((++_sp & 255u) == 0u) { if (xb_ld(&(bar)[XB_TMO])) break; if (_sp > XB_SPIN_CAP) { atomicAdd(&(bar)[XB_TMO], 1u); break; } } } } while (0)

struct XcdBarrier {
    unsigned* bar; unsigned x;
    volatile LAS unsigned* st;
};

__device__ __forceinline__ XcdBarrier xcd_barrier_post(unsigned* bar, volatile LAS unsigned* st) {
    XcdBarrier b; b.bar = bar; b.x = xb_xcc_id(); b.st = st;
    if (threadIdx.x == 0) (void)xb_add(&bar[XB_XCNT(b.x)], 1u);
    return b;
}
__device__ __forceinline__ void xcd_barrier_complete(unsigned* bar, unsigned x, unsigned& nloc, unsigned& nx) {
    const unsigned G = gridDim.x * gridDim.y * gridDim.z;
    unsigned sum, cnt, mine, sp = 0u;
    for (;;) {
        sum = 0u; cnt = 0u; mine = 0u;
#pragma unroll
        for (unsigned j = 0; j < 16; ++j) { const unsigned c = xb_ld(&bar[XB_XCNT(j)]); sum += c; cnt += (c > 0u) ? 1u : 0u; mine = (j == x) ? c : mine; }
        if (sum == G) break;
        __builtin_amdgcn_s_sleep(1);
        if ((++sp & 255u) == 0u) { if (xb_ld(&bar[XB_TMO])) break; if (sp > XB_SPIN_CAP) { atomicAdd(&bar[XB_TMO], 1u); break; } }
    }
    nloc = mine > 0u ? mine : 1u; nx = cnt > 0u ? cnt : 1u;
}

__device__ __forceinline__ void xcd_barrier(const XcdBarrier& b) {
    asm volatile("s_waitcnt vmcnt(0)" ::: "memory");
    __syncthreads();
    if (threadIdx.x == 0) {
        unsigned* bar = b.bar;
        __builtin_amdgcn_s_waitcnt(0);
        unsigned nloc = b.st[0], nx = b.st[1];
        if (nloc == 0u) { xcd_barrier_complete(bar, b.x, nloc, nx); b.st[0] = nloc; b.st[1] = nx; }
        const unsigned old = xb_add(&bar[XB_XSUB(b.x)], 1u);
        const unsigned gen = old / nloc;
        if (old + 1u == (gen + 1u) * nloc) {
            __builtin_amdgcn_fence(__ATOMIC_RELEASE, "agent");
            asm volatile("s_waitcnt vmcnt(0)" ::: "memory");
            const unsigned og = xb_add(&bar[XB_TOP], 1u);
            const unsigned tg = og / nx;
            if (og + 1u == (tg + 1u) * nx) xb_add(&bar[XB_TOPGEN], 1u);
            else XB_SPIN(xb_ld(&bar[XB_TOPGEN]) == tg, bar);
            __builtin_amdgcn_fence(__ATOMIC_ACQUIRE, "agent");
            xb_add(&bar[XB_XGEN(b.x)], 1u);
            asm volatile("s_waitcnt vmcnt(0)" ::: "memory");
        } else {
            XB_SPIN(xb_ld(&bar[XB_XGEN(b.x)]) == gen, bar);
            __builtin_amdgcn_fence(__ATOMIC_ACQUIRE, "agent");
            asm volatile("s_waitcnt vmcnt(0)" ::: "memory");
        }
    }
    __syncthreads();
}

#ifndef PHMASK
#define PHMASK 0xffff
#endif
struct Args { const void* in[20]; float* out; unsigned char* ws; int ph_lo, ph_hi, sub, pad; };
enum Phase { PH_PRO = 0, PH_INPROJ = 1, PH_MIX = 4, PH_FIN = 9, PH_ATTN = 2, PH_OUTPROJ = 5, PH_CQ = 6, PH_XATTN = 7, PH_CO = 8, PH_END = 10 };
constexpr int LDS_WSCR = RING_BYTES + 1024;

__global__ void __launch_bounds__(NWAVES * 64, 2) mk_fwd(Args args) {
    extern __shared__ __attribute__((aligned(16))) unsigned char lds[];
    LAS unsigned char* L = (LAS unsigned char*)lds;
    const int tid = threadIdx.x;
    unsigned char* ws = args.ws;
    for (int u = tid; u < (LDS_BYTES - LDSCTL_OFF) / 4; u += NWAVES * 64) ((LAS unsigned*)(L + LDSCTL_OFF))[u] = 0u;
    __syncthreads();
    const int G = gridDim.x;
    XcdBarrier bar = xcd_barrier_post((unsigned*)(ws + WS_CTL) + CW_BAR, (volatile LAS unsigned*)(L + MISC_OFF) + 8);
#define WSP(T_, off) ((T_*)(ws + (off)))
    const int lo = args.ph_lo, hi = args.ph_hi;
#define IN(k) (lo <= (k) && (k) < hi && ((PHMASK >> (k)) & 1))
#define SEAM(k) do { if ((k) + 1 < hi) xcd_barrier(bar); } while (0)
    if (IN(PH_PRO)) {
        const int wave = __builtin_amdgcn_readfirstlane(tid >> 6), lane = tid & 63;
        const int gw = (int)blockIdx.x * NWAVES + wave, NGW = G * NWAVES;
        LAS float* scr = (LAS float*)(L + wave * 16384);
        constexpr int I_IN = 16 * (NP / 32), I_SQ = 16 * (D / 32), I_KV = 16 * (2 * D / 32);
        for (int it = gw; it < I_IN + 3 * I_SQ + I_KV; it += NGW) {
            int r = it;
            if (r < I_IN) { thin::transpose_item<1>((const float*)args.in[4], D, D_IN, NP / 32, WSP(bf16_t, WS_WIN), nullptr, scr, r, lane); continue; } r -= I_IN;
            if (r < I_SQ) { thin::transpose_item<0>((const float*)args.in[13], D, D, D / 32, WSP(bf16_t, WS_WOUT), nullptr, scr, r, lane); continue; } r -= I_SQ;
            if (r < I_SQ) { thin::transpose_item<0>((const float*)args.in[16], D, D, D / 32, WSP(bf16_t, WS_WCQ), (const float*)args.in[14], scr, r, lane); continue; } r -= I_SQ;
            if (r < I_SQ) { thin::transpose_item<0>((const float*)args.in[18], D, D, D / 32, WSP(bf16_t, WS_WCO), nullptr, scr, r, lane); continue; } r -= I_SQ;
            thin::transpose_item<0>((const float*)args.in[17], D, 2 * D, 2 * D / 32, WSP(bf16_t, WS_WCKV), nullptr, scr, r, lane);
        }
        for (int m = gw; m < T; m += 2 * NGW) thin::rms_row2_to_bf16((const float*)args.in[0] + (size_t)m * D, (const float*)args.in[0] + (size_t)(m + NGW) * D, (const float*)args.in[3], WSP(bf16_t, WS_XN) + (size_t)m * D, WSP(bf16_t, WS_XN) + (size_t)(m + NGW) * D, lane);
        for (int m = gw; m < TM; m += NGW) thin::rms_row_to_bf16((const float*)args.in[1] + (size_t)m * D, (const float*)args.in[15], WSP(bf16_t, WS_MEMN) + (size_t)m * D, lane);
        { const int gt = (int)blockIdx.x * (NWAVES * 64) + tid, NGT = G * NWAVES * 64;
          float* cs = WSP(float, WS_ROPE); float* sn = cs + T * 8; float* rss = WSP(float, WS_MISC); const int* pos = (const int*)args.in[2];
          for (int i = gt; i < T * 8; i += NGT) {
              const int t = i >> 3, j = i & 7;
              double f = 1.0;
              f = (j == 1) ? 0.19392274474868576 : f; f = (j == 2) ? 0.03760603093086393 : f; f = (j == 3) ? 0.007292664737217109 : f; f = (j == 4) ? 0.001414213562373095 : f;
              f = (j == 5) ? 0.0002742481756762073 : f; f = (j == 6) ? 5.318295896944988e-05 : f; f = (j == 7) ? 1.031338537721246e-05 : f;
              float c, sv; sincos_d((double)pos[t] * f, c, sv); cs[i] = c; sn[i] = sv;
          }
          for (int i = gt; i < 2 * T; i += NGT) rss[i] = 0.f;
          if (gt == 0) { const float* q1 = (const float*)args.in[8]; const float* k1 = (const float*)args.in[9]; const float* q2 = (const float*)args.in[10]; const float* k2 = (const float*)args.in[11];
              float a = 0.f, b = 0.f; for (int u = 0; u < 64; ++u) { a += q1[u] * k1[u]; b += q2[u] * k2[u]; } rss[2 * T] = expf(a) - expf(b) + 0.2f; } }
        SEAM(PH_PRO);
    }
    if (IN(PH_INPROJ)) {
        { pg8::Gemm g{WSP(bf16_t, WS_XN), WSP(bf16_t, WS_WIN), T, NP, D}; pg8::StaticOrder S; S.init(T, NP, G, (int)blockIdx.x);
          pg8::EpiInProj E{WSP(bf16_t, WS_PROJ), WSP(float, WS_GA), WSP(float, WS_ROPE), WSP(float, WS_ROPE) + T * 8};
          pg8::gemm_phase<pg8::EpiInProj, pg8::StaticOrder, true, true>(L, g, S, E); }
#ifndef NO_KVM
        { pg8::Gemm g{WSP(bf16_t, WS_MEMN), WSP(bf16_t, WS_WCKV), TM, 2 * D, D}; pg8::StaticOrder S; S.init(TM, 2 * D, G, (int)blockIdx.x);
          pg8::EpiBf16<0> E{WSP(bf16_t, WS_KVM), 2 * D, nullptr, 0, 0, 1.f};
          pg8::gemm_phase<pg8::EpiBf16<0>, pg8::StaticOrder, true, true>(L, g, S, E); }
#endif
        SEAM(PH_INPROJ);
    }
    if (IN(PH_ATTN)) {
        if (args.sub & 1) { const int vcu = (G % 8 == 0) ? ((int)blockIdx.x % 8) * (G / 8) + (int)blockIdx.x / 8 : (int)blockIdx.x;
          for (int rid = vcu; rid < 256; rid += G)
              gla::gla_run<false>(rid, WSP(bf16_t, WS_PROJ), WSP(float, WS_GA), (const float*)args.in[5], (const float*)args.in[6], (const float*)args.in[7], WSP(float, WS_KVC), WSP(float, WS_ST), WSP(bf16_t, WS_MIXED), (char*)lds); }
        const attn_body::AttnTensors AT{WSP(const attn_body::bf16, WS_PROJ), WSP(attn_body::bf16, WS_OD)};
        const attn_body::StaticOrder S(G, (int)blockIdx.x);
        if (args.sub & 2) attn_body::attn_phase<attn_body::StaticOrder>((char*)lds, AT, S);
        SEAM(PH_ATTN);
    }
    if (IN(PH_MIX)) {
        const int wave = __builtin_amdgcn_readfirstlane(tid >> 6), lane = tid & 63;
        const int gw = (int)blockIdx.x * NWAVES + wave, NGW = G * NWAVES;
        if (args.sub & 1) { const int vcu = (G % 8 == 0) ? ((int)blockIdx.x % 8) * (G / 8) + (int)blockIdx.x / 8 : (int)blockIdx.x;
          for (int rid = vcu; rid < 256; rid += G)
              gla::gla_run<true>(rid, WSP(bf16_t, WS_PROJ), WSP(float, WS_GA), (const float*)args.in[5], (const float*)args.in[6], (const float*)args.in[7], WSP(float, WS_KVC), WSP(float, WS_ST), WSP(bf16_t, WS_MIXED), (char*)lds); }
        const bf16_t* od = WSP(bf16_t, WS_OD); const bf16_t* proj = WSP(bf16_t, WS_PROJ); bf16_t* mixed = WSP(bf16_t, WS_MIXED);
        const float lm = WSP(float, WS_MISC)[2 * T]; const float* w = (const float*)args.in[12];
        const int hh = lane >> 4, e0 = (lane & 15) * 8;
        f32x4 wa = *(const f32x4*)(w + e0) * 0.8f, wb = *(const f32x4*)(w + e0 + 4) * 0.8f;
        if (args.sub & 2) for (int t = gw; t < T; t += NGW) {
            const pg8::u32x4 a1 = *(const pg8::u32x4*)(od + (size_t)t * D + (2 * hh) * 128 + e0), a2 = *(const pg8::u32x4*)(od + (size_t)t * D + (2 * hh + 1) * 128 + e0);
            const pg8::u32x4 gg = *(const pg8::u32x4*)(proj + (size_t)t * PP + C_DG + hh * 128 + e0);
            float d[8], g[8]; float ss = 0.f;
#pragma unroll
            for (int i = 0; i < 4; ++i) { const unsigned u1 = a1[i], u2 = a2[i], ug = gg[i];
                d[2 * i] = __uint_as_float(u1 << 16) - lm * __uint_as_float(u2 << 16); d[2 * i + 1] = __uint_as_float(u1 & 0xffff0000u) - lm * __uint_as_float(u2 & 0xffff0000u);
                g[2 * i] = __uint_as_float(ug << 16); g[2 * i + 1] = __uint_as_float(ug & 0xffff0000u); ss += d[2 * i] * d[2 * i] + d[2 * i + 1] * d[2 * i + 1]; }
            ss += __shfl_xor(ss, 1); ss += __shfl_xor(ss, 2); ss += __shfl_xor(ss, 4); ss += __shfl_xor(ss, 8);
            const float r = rsqrtf(ss * (1.f / 128) + EPS);
            pg8::u32x4 o;
            o.x = thin::pk2(d[0] * r * wa[0] * silu(g[0]), d[1] * r * wa[1] * silu(g[1])); o.y = thin::pk2(d[2] * r * wa[2] * silu(g[2]), d[3] * r * wa[3] * silu(g[3]));
            o.z = thin::pk2(d[4] * r * wb[0] * silu(g[4]), d[5] * r * wb[1] * silu(g[5])); o.w = thin::pk2(d[6] * r * wb[2] * silu(g[6]), d[7] * r * wb[3] * silu(g[7]));
            *(pg8::u32x4*)(mixed + (size_t)t * D + 512 + hh * 128 + e0) = o;
        }
        SEAM(PH_MIX);
    }
    if (IN(PH_OUTPROJ)) {
        pg8::Gemm g{WSP(bf16_t, WS_MIXED), WSP(bf16_t, WS_WOUT), T, D, D}; pg8::StaticOrder S; S.init(T, D, G, (int)blockIdx.x);
        pg8::EpiOutProj E{(const float*)args.in[0], args.out, WSP(bf16_t, WS_X1B), WSP(float, WS_MISC)};
        pg8::gemm_phase<pg8::EpiOutProj, pg8::StaticOrder, true, true>(L, g, S, E);
        SEAM(PH_OUTPROJ);
    }
    if (IN(PH_CQ)) {
        pg8::Gemm g{WSP(bf16_t, WS_X1B), WSP(bf16_t, WS_WCQ), T, D, D}; pg8::StaticOrder S; S.init(T, D, G, (int)blockIdx.x);
        pg8::EpiCq E{WSP(bf16_t, WS_QC), WSP(float, WS_MISC)};
        pg8::gemm_phase<pg8::EpiCq, pg8::StaticOrder, true, true>(L, g, S, E);
        SEAM(PH_CQ);
    }
    if (IN(PH_XATTN)) {
        const int vcu = (G % 8 == 0) ? ((int)blockIdx.x % 8) * (G / 8) + (int)blockIdx.x / 8 : (int)blockIdx.x;
        float* wsf = (float*)(lds + LDS_WSCR) + (tid >> 6) * 64;
        for (int id = vcu; id < 512; id += G) xattn::xattn_unit(id >> 2, id & 3, WSP(bf16_t, WS_QC), WSP(bf16_t, WS_KVM), WSP(bf16_t, WS_OC), (char*)lds, wsf);
        SEAM(PH_XATTN);
    }
    if (IN(PH_CO)) {
        pg8::Gemm g{WSP(bf16_t, WS_OC), WSP(bf16_t, WS_WCO), T, D, D}; pg8::StaticOrder S; S.init(T, D, G, (int)blockIdx.x);
        pg8::EpiCo E{WSP(bf16_t, WS_X1B), args.out, WSP(float, WS_MISC) + T};
        pg8::gemm_phase<pg8::EpiCo, pg8::StaticOrder, true, true>(L, g, S, E);
        SEAM(PH_CO);
    }
    if (IN(PH_FIN)) {
        const int wave = __builtin_amdgcn_readfirstlane(tid >> 6), lane = tid & 63;
        const int gw = (int)blockIdx.x * NWAVES + wave, NGW = G * NWAVES;
        const float* rss2 = WSP(float, WS_MISC) + T; const float* w = (const float*)args.in[19];
        f32x4 ww[4];
#pragma unroll
        for (int j = 0; j < 4; ++j) ww[j] = ((const f32x4*)w)[lane + 64 * j];
        for (int m = gw; m < T; m += NGW) {
            const float r = rsqrtf(rss2[m] * (1.f / D) + EPS);
            f32x4* xr = (f32x4*)(args.out + (size_t)m * D);
#pragma unroll
            for (int j = 0; j < 4; ++j) { f32x4 v = xr[lane + 64 * j]; v = v * ww[j] * r; xr[lane + 64 * j] = v; }
        }
    }
#undef IN
#undef SEAM
}

extern "C" void kernel_launch(void* const* d_in, const int* in_sizes, int n_in, void* d_out, int out_size, void* d_ws, size_t ws_size, hipStream_t stream) {
    if (n_in != 20 || in_sizes[0] != T * D || out_size != T * D || ws_size < WS_END) { fprintf(stderr, "kernel_launch: unexpected shapes / workspace (%d inputs, ws %zu)\n", n_in, ws_size); return; }
    const float* x = (const float*)d_in[0]; const float* mem = (const float*)d_in[1]; const int* pos = (const int*)d_in[2];
    const float* norm_mix_w = (const float*)d_in[3]; const float* w_in = (const float*)d_in[4]; const float* w_alpha2 = (const float*)d_in[5];
    const float* b_alpha2 = (const float*)d_in[6]; const float* gla_norm_w = (const float*)d_in[7];
    const float* lq1 = (const float*)d_in[8]; const float* lk1 = (const float*)d_in[9]; const float* lq2 = (const float*)d_in[10]; const float* lk2 = (const float*)d_in[11];
    const float* diff_norm_w = (const float*)d_in[12]; const float* w_out = (const float*)d_in[13]; const float* norm_cross_w = (const float*)d_in[14];
    const float* norm_mem_w = (const float*)d_in[15]; const float* w_cq = (const float*)d_in[16]; const float* w_ckv = (const float*)d_in[17];
    const float* w_co = (const float*)d_in[18]; const float* final_norm_w = (const float*)d_in[19];
    float* out = (float*)d_out; unsigned char* ws = (unsigned char*)d_ws;
    bf16_t* WIN = (bf16_t*)(ws + WS_WIN); bf16_t* WOUT = (bf16_t*)(ws + WS_WOUT); bf16_t* WCQ = (bf16_t*)(ws + WS_WCQ); bf16_t* WCO = (bf16_t*)(ws + WS_WCO); bf16_t* WCKV = (bf16_t*)(ws + WS_WCKV);
    bf16_t* MEMN = (bf16_t*)(ws + WS_MEMN); bf16_t* KVM = (bf16_t*)(ws + WS_KVM); float* GA = (float*)(ws + WS_GA);
    float* CS = (float*)(ws + WS_ROPE); float* SN = CS + T * 8; float* RSS = (float*)(ws + WS_MISC); float* RSS2 = RSS + T; float* LAM = RSS + 2 * T;
    bf16_t* XN = (bf16_t*)(ws + WS_XN); bf16_t* MIXED = (bf16_t*)(ws + WS_MIXED); bf16_t* PROJ = (bf16_t*)(ws + WS_PROJ);
    bf16_t* X1B = (bf16_t*)(ws + WS_X1B); bf16_t* QC = (bf16_t*)(ws + WS_QC); bf16_t* OC = (bf16_t*)(ws + WS_OC); bf16_t* OD = (bf16_t*)(ws + WS_OD);
    float* GO = (float*)(ws + WS_KVC); float* G = (float*)(ws + WS_ST);

    auto nb = [](size_t n, int b) { return (unsigned)((n + b - 1) / b); };
    static int grid = 0;
    if (grid == 0) {
        int dev = 0, cus = 0;
        if (hipGetDevice(&dev) != hipSuccess || hipDeviceGetAttribute(&cus, hipDeviceAttributeMultiprocessorCount, dev) != hipSuccess) { fprintf(stderr, "kernel_launch: device query failed\n"); grid = -1; return; }
        if (hipFuncSetAttribute((const void*)mk_fwd, hipFuncAttributeMaxDynamicSharedMemorySize, LDS_BYTES) != hipSuccess) { fprintf(stderr, "kernel_launch: hipFuncSetAttribute failed\n"); grid = -1; return; }
        grid = cus;
        if (grid != 256) fprintf(stderr, "kernel_launch: %d CUs (expected 256)\n", grid);
    }
    if (grid < 0) return;
    (void)hipMemsetAsync((char*)d_ws + WS_CTL, 0, CTL_ZERO_BYTES, stream);
    Args a{};
    for (int i = 0; i < 20; ++i) a.in[i] = d_in[i];
    a.out = out; a.ws = ws; a.sub = 3;
#define MK(p) do { a.ph_lo = (p); a.ph_hi = (p) + 1; hipLaunchKernelGGL(mk_fwd, dim3(grid), dim3(NWAVES * 64), LDS_BYTES, stream, a); } while (0)
#ifdef MULTI_LAUNCH
    MK(PH_PRO); MK(PH_INPROJ);
#ifdef REP_PH
    if (REP_PH <= PH_INPROJ) { a.sub = REP_SUB; for (int rep_ = 0; rep_ < REP_N; ++rep_) MK(REP_PH); a.sub = 3; }
#endif
    MK(PH_ATTN); MK(PH_MIX); MK(PH_OUTPROJ); MK(PH_CQ); MK(PH_XATTN);
#ifdef REP_PH
    if (REP_PH > PH_INPROJ) { a.sub = REP_SUB; for (int rep_ = 0; rep_ < REP_N; ++rep_) MK(REP_PH); a.sub = 3; }
#endif
    MK(PH_CO); MK(PH_FIN);
#else
    a.ph_lo = 0; a.ph_hi = PH_END;
    hipLaunchKernelGGL(mk_fwd, dim3(grid), dim3(NWAVES * 64), LDS_BYTES, stream, a);
#endif
}
```
